# Optimizing an MI355X kernel written in HIP

```python
import math
import jax
import jax.numpy as jnp
from jax import lax
import numpy as np

D_MODEL = 2048
BATCH = 32
SEQ = 256
DEPTH = 4
DEC_BATCH = 8
DEC_SEQ = 1024
PAST_LEN = 256

GRID_W = 64
EPS = 1e-6

HG_WIDTH = D_MODEL // 2
HG_DK = 128
HG_HEADS = HG_WIDTH // HG_DK
HG_DV = HG_WIDTH // HG_HEADS
HG_CHUNK = 32

AT_HD = 128
AT_Q_HEADS = (D_MODEL // 2) // AT_HD
AT_KV_HEADS = AT_Q_HEADS // 4
AT_GROUP = AT_Q_HEADS // AT_KV_HEADS
AT_WIDTH = AT_Q_HEADS * AT_HD
AT_KV_WIDTH = AT_KV_HEADS * AT_HD
Q_BLOCK = 128
ROPE_THETA = 10000.0
ROPE_AX = AT_HD // 2

S5_WIDTH = D_MODEL // 2
S5_GROUP_CH = 16
S5_GROUPS = S5_WIDTH // S5_GROUP_CH
S5_STATE = 64

IN_COLS = 5 * HG_WIDTH + 2 * AT_WIDTH + 2 * AT_KV_WIDTH + 2 * S5_WIDTH + 3 * D_MODEL

kernel_name = 'hybrid_hgrn2_gqa_s5_diffusion_step'


def rms_norm(x, w):
    xf = x.astype(jnp.float32)
    y = xf * lax.rsqrt(jnp.mean(xf * xf, axis=-1, keepdims=True) + EPS)
    return (y * w.astype(jnp.float32)).astype(x.dtype)


def split_columns(z):
    sizes = (HG_WIDTH,) * 5 + (AT_WIDTH, AT_KV_WIDTH, AT_KV_WIDTH, AT_WIDTH, S5_WIDTH, S5_WIDTH, 3 * D_MODEL)
    offsets = []
    acc = 0
    for s in sizes[:-1]:
        acc += s
        offsets.append(acc)
    return jnp.split(z, offsets, axis=-1)


def hgrn_lower_bounds(logits):
    p = jax.nn.softmax(logits.astype(jnp.float32), axis=1)
    cs = jnp.cumsum(p, axis=1)
    return cs - cs[:, :1]


def hgrn_forget(f_raw, lb):
    bsz, seq, _ = f_raw.shape
    lb = lb.astype(jnp.float32)
    f = lb + (1.0 - lb) * jax.nn.sigmoid(f_raw.astype(jnp.float32))
    shape = (bsz, seq, HG_HEADS, HG_DK)
    return jnp.log(f).reshape(shape), (1.0 - f).reshape(shape)


def hgrn_chunk_scan(q, k, v, log_f, s0):
    bsz, seq, nh, _ = q.shape
    dv = v.shape[-1]
    n_chunks = seq // HG_CHUNK

    def chunks(a):
        return a.astype(jnp.float32).reshape(bsz, n_chunks, HG_CHUNK, nh, a.shape[-1]).transpose(1, 0, 3, 2, 4)

    causal = jnp.tril(jnp.ones((HG_CHUNK, HG_CHUNK), dtype=bool))[:, :, None]

    def step(state, blk):
        qc, kc, vc, gc = blk
        b = jnp.cumsum(gc, axis=2)
        rel = b[:, :, :, None, :] - b[:, :, None, :, :]
        decay = jnp.exp(jnp.where(causal, rel, -jnp.inf))
        scores = jnp.einsum('bhtd,bhtsd,bhsd->bhts', qc, decay, kc)
        o = jnp.einsum('bhts,bhsv->bhtv', scores, vc) + jnp.einsum('bhtd,bhdv->bhtv', qc * jnp.exp(b), state)
        b_last = b[:, :, -1:, :]
        new_state = jnp.exp(b_last[:, :, 0, :])[..., None] * state + jnp.einsum(
            'bhsd,bhsv->bhdv', kc * jnp.exp(b_last - b), vc)
        return new_state, o

    s_final, o = lax.scan(step, s0.astype(jnp.float32), (chunks(q), chunks(k), chunks(v), chunks(log_f)))
    o = o.transpose(1, 0, 3, 2, 4).reshape(bsz, seq, nh, dv)
    return o, s_final


def hgrn_branch(q_raw, i_raw, ff_raw, fb_raw, g_raw, lb_f, lb_b, onorm_w, s0):
    bsz, seq, _ = q_raw.shape
    q = q_raw.reshape(bsz, seq, HG_HEADS, HG_DK)
    v = i_raw.reshape(bsz, seq, HG_HEADS, HG_DV)
    logf_f, k_f = hgrn_forget(ff_raw, lb_f)
    logf_b, k_b = hgrn_forget(fb_raw, lb_b)
    o_f, s_f = hgrn_chunk_scan(q, k_f, v, logf_f, s0[:, 0])
    o_b, s_b = hgrn_chunk_scan(jnp.flip(q, 1), jnp.flip(k_b, 1), jnp.flip(v, 1), jnp.flip(logf_b, 1), s0[:, 1])
    o = rms_norm(o_f + jnp.flip(o_b, 1), onorm_w).reshape(bsz, seq, HG_WIDTH).astype(q_raw.dtype)
    return o * jax.nn.silu(g_raw), jnp.stack([s_f, s_b], axis=1)


def axial_rope_tables(seq):
    rows = seq // GRID_W
    row = jnp.repeat(jnp.arange(rows, dtype=jnp.float32), GRID_W)
    col = jnp.tile(jnp.arange(GRID_W, dtype=jnp.float32), rows)
    half = ROPE_AX // 2
    inv = ROPE_THETA ** (-jnp.arange(half, dtype=jnp.float32) / half)
    ang_r = row[:, None] * inv
    ang_c = col[:, None] * inv
    return (jnp.cos(ang_r), jnp.sin(ang_r), jnp.cos(ang_c), jnp.sin(ang_c))


def rope_rotate(x, cos, sin):
    half = x.shape[-1] // 2
    x1, x2 = x[..., :half], x[..., half:]
    cos = cos[None, :, None, :]
    sin = sin[None, :, None, :]
    return jnp.concatenate([x1 * cos - x2 * sin, x2 * cos + x1 * sin], axis=-1)


def apply_axial_rope(x, tables):
    cos_r, sin_r, cos_c, sin_c = tables
    xf = x.astype(jnp.float32)
    y = jnp.concatenate([rope_rotate(xf[..., :ROPE_AX], cos_r, sin_r),
                         rope_rotate(xf[..., ROPE_AX:], cos_c, sin_c)], axis=-1)
    return y.astype(x.dtype)


def block_attention(q, k, v):
    bsz, tq = q.shape[:2]
    nb = tq // Q_BLOCK
    qb = q.reshape(bsz, nb, Q_BLOCK, AT_KV_HEADS, AT_GROUP, AT_HD).transpose(1, 0, 2, 3, 4, 5)
    scale = AT_HD ** -0.5

    def one_block(qblk):
        s = jnp.einsum('bqkgd,bskd->bkgqs', qblk, k).astype(jnp.float32) * scale
        p = jax.nn.softmax(s, axis=-1).astype(v.dtype)
        return jnp.einsum('bkgqs,bskd->bqkgd', p, v)

    o = lax.map(one_block, qb)
    return o.transpose(1, 0, 2, 3, 4, 5).reshape(bsz, tq, AT_WIDTH)


def cmul(ar, ai, br, bi):
    return ar * br - ai * bi, ar * bi + ai * br


def ssm_combine(e1, e2):
    a1r, a1i, b1r, b1i = e1
    a2r, a2i, b2r, b2i = e2
    ar, ai = cmul(a2r, a2i, a1r, a1i)
    br, bi = cmul(a2r, a2i, b1r, b1i)
    return ar, ai, br + b2r, bi + b2i


def s5_discretise(a_re, a_im, log_dt, b_re, b_im):
    a_re = a_re.astype(jnp.float32)
    a_im = a_im.astype(jnp.float32)
    dt = jnp.exp(log_dt.astype(jnp.float32))[:, None]
    mag = jnp.exp(a_re * dt)
    abar_re = mag * jnp.cos(a_im * dt)
    abar_im = mag * jnp.sin(a_im * dt)
    den = a_re * a_re + a_im * a_im
    num_re = abar_re - 1.0
    coef_re = (num_re * a_re + abar_im * a_im) / den
    coef_im = (abar_im * a_re - num_re * a_im) / den
    bbar_re, bbar_im = cmul(coef_re[..., None], coef_im[..., None],
                            b_re.astype(jnp.float32), b_im.astype(jnp.float32))
    return abar_re, abar_im, bbar_re, bbar_im


def s5_scan(u, abar_re, abar_im, bbar_re, bbar_im, s0_re, s0_im):
    bu_re = jnp.einsum('btgc,gpc->btgp', u, bbar_re)
    bu_im = jnp.einsum('btgc,gpc->btgp', u, bbar_im)
    shape = (1, u.shape[1]) + abar_re.shape
    a_re = jnp.broadcast_to(abar_re, shape)
    a_im = jnp.broadcast_to(abar_im, shape)
    cum_re, cum_im, s_re, s_im = lax.associative_scan(ssm_combine, (a_re, a_im, bu_re, bu_im), axis=1)
    init_re, init_im = cmul(cum_re, cum_im, s0_re[:, None].astype(jnp.float32), s0_im[:, None].astype(jnp.float32))
    return s_re + init_re, s_im + init_im


def s5_branch(u_raw, gate_raw, a_re, a_im, log_dt, b_re, b_im, c_re, c_im, d, w_glu, s0_re, s0_im):
    bsz, seq, _ = u_raw.shape
    u = u_raw.astype(jnp.float32).reshape(bsz, seq, S5_GROUPS, S5_GROUP_CH)
    fwd = s5_discretise(a_re[0], a_im[0], log_dt[0], b_re[0], b_im[0])
    bwd = s5_discretise(a_re[1], a_im[1], log_dt[1], b_re[1], b_im[1])
    sf_re, sf_im = s5_scan(u, *fwd, s0_re[:, 0], s0_im[:, 0])
    sb_re, sb_im = s5_scan(jnp.flip(u, 1), *bwd, s0_re[:, 1], s0_im[:, 1])
    final_re = jnp.stack([sf_re[:, -1], sb_re[:, -1]], axis=1)
    final_im = jnp.stack([sf_im[:, -1], sb_im[:, -1]], axis=1)
    s_re = sf_re + jnp.flip(sb_re, 1)
    s_im = sf_im + jnp.flip(sb_im, 1)
    y = jnp.einsum('btgp,gcp->btgc', s_re, c_re.astype(jnp.float32)) - jnp.einsum(
        'btgp,gcp->btgc', s_im, c_im.astype(jnp.float32))
    y = (y.reshape(bsz, seq, S5_WIDTH) + d.astype(jnp.float32) * u_raw.astype(jnp.float32)).astype(u_raw.dtype)
    y = jax.nn.gelu(y)
    y = y * jax.nn.sigmoid(y @ w_glu)
    return y * jax.nn.silu(gate_raw), final_re, final_im


def trunk_layer(x, mod, l, p, lower_bounds, hg_s0, s5_s0_re, s5_s0_im, ctx_k, ctx_v, rope):
    bsz, seq, _ = x.shape
    shift, scale, gate = jnp.split(mod, 3, axis=-1)
    h = rms_norm(x, p['norm_w'][l]) * (1 + scale[:, None, :]) + shift[:, None, :]
    (hg_q, hg_i, hg_ff, hg_fb, hg_g, at_q, at_k, at_v, at_g,
     s5_u, s5_g, merge_raw) = split_columns(h @ p['w_in'][l])

    o_hg, hg_state = hgrn_branch(hg_q, hg_i, hg_ff, hg_fb, hg_g, lower_bounds[0, l], lower_bounds[1, l],
                                 p['hg_onorm'][l], hg_s0)

    q = rms_norm(at_q.reshape(bsz, seq, AT_Q_HEADS, AT_HD), p['at_q_norm'][l])
    k = rms_norm(at_k.reshape(bsz, seq, AT_KV_HEADS, AT_HD), p['at_k_norm'][l])
    v = at_v.reshape(bsz, seq, AT_KV_HEADS, AT_HD)
    if ctx_k is None:
        o_at = block_attention(q, k, v)
    else:
        q_r = apply_axial_rope(q, rope)
        k_r = apply_axial_rope(k, rope)
        k_all = jnp.concatenate([ctx_k.astype(k.dtype), k_r], axis=1)
        v_all = jnp.concatenate([ctx_v.astype(v.dtype), v], axis=1)
        o_at = block_attention(q_r, k_all, v_all)
    o_at = o_at * jax.nn.silu(at_g)

    o_s5, s5_re, s5_im = s5_branch(s5_u, s5_g, p['s5_a_re'][l], p['s5_a_im'][l], p['s5_log_dt'][l],
                                   p['s5_b_re'][l], p['s5_b_im'][l], p['s5_c_re'][l], p['s5_c_im'][l],
                                   p['s5_d'][l], p['s5_w_glu'][l], s5_s0_re, s5_s0_im)

    g_hg, g_at, g_s5 = jnp.split(jax.nn.sigmoid(merge_raw), 3, axis=-1)
    merged = (g_hg * (o_hg @ p['w_br_hg'][l]) + g_at * (o_at @ p['w_br_at'][l])
              + g_s5 * (o_s5 @ p['w_br_s5'][l]))
    x = x + gate[:, None, :] * (merged @ p['w_out'][l])
    return x, (k, v, hg_state, s5_re, s5_im)


def setup_inputs(seed: int = 0) -> dict:
    key = jax.random.key(seed)
    ks = iter(jax.random.split(key, 40))

    def nrm(shape, s):
        return s * jax.random.normal(next(ks), shape, jnp.float32)

    G, P, CH = S5_GROUPS, S5_STATE, S5_GROUP_CH
    return {
        'x_prompt': nrm((BATCH, SEQ, D_MODEL), 1.0),
        'x_sample': nrm((DEC_BATCH, DEC_SEQ, D_MODEL), 1.0),
        'cache_k': nrm((DEC_BATCH, DEPTH, PAST_LEN, AT_KV_HEADS, AT_HD), 1.0),
        'cache_v': nrm((DEC_BATCH, DEPTH, PAST_LEN, AT_KV_HEADS, AT_HD), 1.0),
        'state_hgrn': nrm((DEC_BATCH, DEPTH, 2, HG_HEADS, HG_DK, HG_DV), 0.5),
        'state_s5_re': nrm((DEC_BATCH, DEPTH, 2, G, P), 0.5),
        'state_s5_im': nrm((DEC_BATCH, DEPTH, 2, G, P), 0.5),
        'c': nrm((DEC_BATCH, D_MODEL), 1.0),
        'c_ctx': nrm((D_MODEL,), 1.0),
        'norm_w': 1.0 + nrm((DEPTH, D_MODEL), 0.02),
        'w_mod': nrm((DEPTH, D_MODEL, 3 * D_MODEL), 0.5 * D_MODEL ** -0.5),
        'b_mod': nrm((DEPTH, 3 * D_MODEL), 0.02),
        'w_in': nrm((DEPTH, D_MODEL, IN_COLS), D_MODEL ** -0.5),
        'hg_lb_logits': nrm((2, DEPTH, HG_WIDTH), 0.1),
        'hg_onorm': 1.0 + nrm((DEPTH, HG_DV), 0.02),
        'at_q_norm': 1.0 + nrm((DEPTH, AT_HD), 0.02),
        'at_k_norm': 1.0 + nrm((DEPTH, AT_HD), 0.02),
        's5_a_re': -0.5 * jnp.exp(nrm((DEPTH, 2, G, P), 0.05)),
        's5_a_im': math.pi * jnp.arange(P, dtype=jnp.float32) + nrm((DEPTH, 2, G, P), 0.01),
        's5_log_dt': jax.random.uniform(next(ks), (DEPTH, 2, G), jnp.float32,
                                        minval=math.log(0.001), maxval=math.log(0.1)),
        's5_b_re': nrm((DEPTH, 2, G, P, CH), (2 * CH) ** -0.5),
        's5_b_im': nrm((DEPTH, 2, G, P, CH), (2 * CH) ** -0.5),
        's5_c_re': nrm((DEPTH, G, CH, P), (2 * P) ** -0.5),
        's5_c_im': nrm((DEPTH, G, CH, P), (2 * P) ** -0.5),
        's5_d': nrm((DEPTH, S5_WIDTH), 0.5),
        's5_w_glu': nrm((DEPTH, S5_WIDTH, S5_WIDTH), S5_WIDTH ** -0.5),
        'w_br_hg': nrm((DEPTH, HG_WIDTH, D_MODEL), HG_WIDTH ** -0.5),
        'w_br_at': nrm((DEPTH, AT_WIDTH, D_MODEL), AT_WIDTH ** -0.5),
        'w_br_s5': nrm((DEPTH, S5_WIDTH, D_MODEL), S5_WIDTH ** -0.5),
        'w_out': nrm((DEPTH, D_MODEL, D_MODEL), D_MODEL ** -0.5),
        'final_norm': 1.0 + nrm((D_MODEL,), 0.02),
    }


def reference(x_prompt, x_sample, cache_k, cache_v, state_hgrn, state_s5_re, state_s5_im, c, c_ctx,
              norm_w, w_mod, b_mod, w_in, hg_lb_logits, hg_onorm, at_q_norm, at_k_norm,
              s5_a_re, s5_a_im, s5_log_dt, s5_b_re, s5_b_im, s5_c_re, s5_c_im, s5_d, s5_w_glu,
              w_br_hg, w_br_at, w_br_s5, w_out, final_norm):
    p = {'norm_w': norm_w, 'w_in': w_in, 'hg_onorm': hg_onorm, 'at_q_norm': at_q_norm,
         'at_k_norm': at_k_norm, 's5_a_re': s5_a_re, 's5_a_im': s5_a_im, 's5_log_dt': s5_log_dt,
         's5_b_re': s5_b_re, 's5_b_im': s5_b_im, 's5_c_re': s5_c_re, 's5_c_im': s5_c_im,
         's5_d': s5_d, 's5_w_glu': s5_w_glu, 'w_br_hg': w_br_hg, 'w_br_at': w_br_at,
         'w_br_s5': w_br_s5, 'w_out': w_out}
    lower_bounds = hgrn_lower_bounds(hg_lb_logits)

    bsz_p = x_prompt.shape[0]
    hg_zero = jnp.zeros((bsz_p, 2, HG_HEADS, HG_DK, HG_DV), jnp.float32)
    s5_zero = jnp.zeros((bsz_p, 2, S5_GROUPS, S5_STATE), jnp.float32)
    c_ctx_silu = jax.nn.silu(c_ctx)[None, :]
    xp = x_prompt
    ks_l, vs_l, hs_l, sre_l, sim_l = [], [], [], [], []
    for l in range(DEPTH):
        mod = c_ctx_silu @ w_mod[l] + b_mod[l]
        xp, (k_l, v_l, h_l, sr_l, si_l) = trunk_layer(xp, mod, l, p, lower_bounds, hg_zero, s5_zero, s5_zero,
                                                      None, None, None)
        ks_l.append(k_l)
        vs_l.append(v_l)
        hs_l.append(h_l)
        sre_l.append(sr_l)
        sim_l.append(si_l)
    y_prompt = rms_norm(xp, final_norm)
    new_cache_k = jnp.stack(ks_l, axis=1)
    new_cache_v = jnp.stack(vs_l, axis=1)
    new_state_hgrn = jnp.stack(hs_l, axis=1)
    new_state_s5_re = jnp.stack(sre_l, axis=1)
    new_state_s5_im = jnp.stack(sim_l, axis=1)

    rope = axial_rope_tables(x_sample.shape[1])
    c_silu = jax.nn.silu(c)
    xs = x_sample
    for l in range(DEPTH):
        mod = c_silu @ w_mod[l] + b_mod[l]
        xs, _ = trunk_layer(xs, mod, l, p, lower_bounds, state_hgrn[:, l], state_s5_re[:, l], state_s5_im[:, l],
                            cache_k[:, l], cache_v[:, l], rope)
    y_sample = rms_norm(xs, final_norm)

    return (y_prompt, y_sample, new_cache_k, new_cache_v, new_state_hgrn, new_state_s5_re, new_state_s5_im)
```

```cpp
#ifndef HOST_SIM
#include <hip/hip_runtime.h>
#endif

#ifndef CFG_D
#define CFG_D 2048
#define CFG_BATCH 32
#define CFG_SEQ 256
#define CFG_DEPTH 4
#define CFG_DBATCH 8
#define CFG_DSEQ 1024
#define CFG_PAST 256
#endif
#ifndef N_LAUNCH_MODE
#define N_LAUNCH_MODE 1
#endif

constexpr int D = CFG_D, BATCH = CFG_BATCH, SEQ = CFG_SEQ, DEPTH = CFG_DEPTH, DBATCH = CFG_DBATCH, DSEQ = CFG_DSEQ, PAST = CFG_PAST;
constexpr int W = D / 2;
constexpr int HGH = W / 128;
constexpr int AQH = W / 128, AKVH = AQH / 4, KVW = AKVH * 128;
constexpr int S5G = W / 16, S5P = 64;
constexpr int C_HQ = 0, C_HI = W, C_FF = 2 * W, C_FB = 3 * W, C_HGG = 4 * W, C_AQ = 5 * W, C_AK = 6 * W, C_AV = 6 * W + KVW, C_AG = 6 * W + 2 * KVW,
              C_SU = 7 * W + 2 * KVW, C_SG = 8 * W + 2 * KVW, C_MG = 9 * W + 2 * KVW, INC = C_MG + 3 * D;
constexpr int MP = BATCH * SEQ, MS = DBATCH * DSEQ, M = MP + MS;
constexpr int KVLEN = PAST + DSEQ;
constexpr int NMODR = 1 + DBATCH;
constexpr float EPS = 1e-6f;
static_assert(INC % 256 == 0 && MP % 256 == 0 && MS % 256 == 0 && W % 256 == 0, "tile shapes");

typedef _Float16 h16;
typedef h16 h16x8 __attribute__((ext_vector_type(8)));
typedef h16 h16x4 __attribute__((ext_vector_type(4)));
typedef h16 h16x2 __attribute__((ext_vector_type(2)));
typedef float f32x4 __attribute__((ext_vector_type(4)));
typedef float f32x2 __attribute__((ext_vector_type(2)));

constexpr size_t al256(size_t x) { return (x + 255) & ~(size_t)255; }
constexpr size_t WS_BAR = 0;
constexpr size_t WS_MOD = 16384;
constexpr size_t WS_LB = al256(WS_MOD + (size_t)DEPTH * NMODR * 3 * D * 4);
constexpr size_t WS_ABAR = al256(WS_LB + (size_t)2 * DEPTH * W * 4);
constexpr size_t WS_BBAR = al256(WS_ABAR + (size_t)DEPTH * 2 * S5G * S5P * 8);
constexpr size_t WS_WIN = al256(WS_BBAR + (size_t)DEPTH * 2 * S5G * S5P * 32 * 4);
constexpr size_t WS_WGLU = al256(WS_WIN + (size_t)DEPTH * INC * D * 2);
constexpr size_t WS_WBR = al256(WS_WGLU + (size_t)DEPTH * W * W * 2);
constexpr size_t WS_WOUT = al256(WS_WBR + (size_t)DEPTH * 3 * D * W * 2);
constexpr size_t WS_X = al256(WS_WOUT + (size_t)DEPTH * D * D * 2);
constexpr size_t WS_H = al256(WS_X + (size_t)M * D * 4);
constexpr size_t WS_Z = al256(WS_H + (size_t)M * D * 2);
constexpr size_t WS_LOGF = al256(WS_Z + (size_t)M * INC * 2);
constexpr size_t WS_AQ2 = al256(WS_LOGF + (size_t)M * 2 * W * 4);
constexpr size_t WS_KBC = al256(WS_AQ2 + (size_t)M * W * 2);
constexpr size_t WS_VBC = al256(WS_KBC + (size_t)MP * KVW * 2);
constexpr size_t WS_KBS = al256(WS_VBC + (size_t)MP * KVW * 2);
constexpr size_t WS_VBS = al256(WS_KBS + (size_t)DBATCH * KVLEN * KVW * 2);
constexpr size_t WS_OF = al256(WS_VBS + (size_t)DBATCH * KVLEN * KVW * 2);
constexpr size_t WS_OB = al256(WS_OF + (size_t)M * W * 4);
constexpr size_t WS_YF = al256(WS_OB + (size_t)M * W * 4);
constexpr size_t WS_YB = al256(WS_YF + (size_t)M * W * 4);
constexpr size_t WS_OHG = al256(WS_YB + (size_t)M * W * 4);
constexpr size_t WS_OAT = al256(WS_OHG + (size_t)M * W * 2);
constexpr size_t WS_OS5 = al256(WS_OAT + (size_t)M * W * 2);
constexpr size_t WS_YS = al256(WS_OS5 + (size_t)M * W * 2);
constexpr size_t WS_MG = al256(WS_YS + (size_t)M * W * 2);
static_assert(WS_OAT - WS_OHG == (size_t)M * W * 2 && WS_OS5 - WS_OAT == (size_t)M * W * 2, "branch operands must be equally spaced");
constexpr size_t WS_END = al256(WS_MG + (size_t)M * D * 2);

constexpr size_t O_Y = 0;
constexpr size_t O_CK = (size_t)M * D;
constexpr size_t O_CV = O_CK + (size_t)BATCH * DEPTH * SEQ * KVW;
constexpr size_t O_SH = O_CV + (size_t)BATCH * DEPTH * SEQ * KVW;
constexpr size_t O_SR = O_SH + (size_t)BATCH * DEPTH * 2 * HGH * 128 * 128;
constexpr size_t O_SI = O_SR + (size_t)BATCH * DEPTH * 2 * S5G * S5P;
constexpr size_t O_END = O_SI + (size_t)BATCH * DEPTH * 2 * S5G * S5P;

enum { I_XP = 0, I_XS, I_CK, I_CV, I_SH, I_SR, I_SI, I_C, I_CCTX, I_NORMW, I_WMOD, I_BMOD, I_WIN, I_LBL, I_ONORM, I_QNORM, I_KNORM,
       I_ARE, I_AIM, I_LDT, I_BRE, I_BIM, I_CRE, I_CIM, I_S5D, I_WGLU, I_WBRHG, I_WBRAT, I_WBRS5, I_WOUT, I_FNORM, N_IN };

struct Params { const float* in[N_IN]; float* out; unsigned char* ws; int ph_lo, ph_hi; };

constexpr int NTHREADS = 512, NWAVES = 8;
constexpr int STAGE_BYTES = 131072, MISC_OFF = STAGE_BYTES, LDS_BYTES = 147456;

#ifdef HOST_SIM
#define LAS
static inline void sim_glds16(const void* g, void* l) { memcpy((char*)l + sim::cur->lane * 16, g, 16); }
#define GLDS16(g, l) sim_glds16((const void*)(g), (void*)(l))
#define WAIT_V(n) ((void)0)
#define WAIT_L(n) ((void)0)
#define SBAR sim::block_sync()
#define SCHED ((void)0)
#define SETPRIO(x) ((void)0)
#define CFENCE ((void)0)
#define LAUNDER(x) ((void)0)
#define MFMA16(a, b, c) sim::mfma16<1>(&(a), &(b), c)
static inline float readlane_f(float v, int l) { return sim::shfl<float>(v, l); }
#else
#define LAS __attribute__((address_space(3)))
#define GLDS16(g, l) __builtin_amdgcn_global_load_lds((const unsigned*)(g), (LAS unsigned*)(l), 16, 0, 0)
#define WAIT_V(n) asm volatile("s_waitcnt vmcnt(" #n ")" ::: "memory")
#define WAIT_L(n) asm volatile("s_waitcnt lgkmcnt(" #n ")" ::: "memory")
#define SBAR __builtin_amdgcn_s_barrier()
#define SCHED __builtin_amdgcn_sched_barrier(0)
#define SETPRIO(x) __builtin_amdgcn_s_setprio(x)
#define CFENCE asm volatile("" ::: "memory")
#define LAUNDER(x) asm volatile("" : "+v"(x))
#define MFMA16(a, b, c) __builtin_amdgcn_mfma_f32_16x16x32_f16(a, b, c, 0, 0, 0)
__device__ __forceinline__ float readlane_f(float v, int l) { return __builtin_bit_cast(float, __builtin_amdgcn_readlane(__builtin_bit_cast(int, v), l)); }
#endif

__device__ __forceinline__ float sigm(float x) { return 1.0f / (1.0f + __expf(-x)); }
__device__ __forceinline__ float siluf(float x) { return x * sigm(x); }
__device__ __forceinline__ float geluf(float x) { const float u = 0.7978845608028654f * (x + 0.044715f * x * x * x); return 0.5f * x * (1.0f + tanhf(u)); }
__device__ __forceinline__ float wave_sum(float v) { v += __shfl_xor(v, 32); v += __shfl_xor(v, 16); v += __shfl_xor(v, 8); v += __shfl_xor(v, 4); v += __shfl_xor(v, 2); v += __shfl_xor(v, 1); return v; }

#ifndef HOST_SIM
#define XB_TMO      128
#define XB_XCNT(j)  (256  + 64 * (j))
#define XB_XSUB(j)  (1280 + 64 * (j))
#define XB_XGEN(j)  (2304 + 64 * (j))
#define XB_TOP      3328
#define XB_TOPGEN   3392
#define XCD_BAR_WORDS 3456
#define XB_SPIN_CAP (1u << 24)
__device__ __forceinline__ unsigned xb_ld(unsigned* p)              { return __hip_atomic_load(p, __ATOMIC_RELAXED, __HIP_MEMORY_SCOPE_AGENT); }
__device__ __forceinline__ unsigned xb_add(unsigned* p, unsigned v) { return __hip_atomic_fetch_add(p, v, __ATOMIC_RELAXED, __HIP_MEMORY_SCOPE_AGENT); }
__device__ __forceinline__ unsigned xb_xcc_id() { return (unsigned)__builtin_amdgcn_s_getreg((3 << 11) | 20) & 0xFu; }
#define XB_SPIN(cond, bar) do { unsigned _sp = 0; while (cond) { __builtin_amdgcn_s_sleep(1); \
    if ((++_sp & 255u) == 0u) { if (xb_ld(&(bar)[XB_TMO])) break; if (_sp > XB_SPIN_CAP) { atomicAdd(&(bar)[XB_TMO], 1u); break; } } } } while (0)
struct XcdBarrier { unsigned* bar; unsigned x; volatile LAS unsigned* st; };
__device__ __forceinline__ XcdBarrier xcd_barrier_post(unsigned* bar, volatile LAS unsigned* st) {
    XcdBarrier b; b.bar = bar; b.x = xb_xcc_id(); b.st = st;
    if (threadIdx.x == 0) (void)xb_add(&bar[XB_XCNT(b.x)], 1u);
    return b;
}
__device__ __forceinline__ void xcd_barrier_complete(unsigned* bar, unsigned x, unsigned& nloc, unsigned& nx) {
    const unsigned G = gridDim.x * gridDim.y * gridDim.z;
    unsigned sum, cnt, mine, sp = 0u;
    for (;;) {
        sum = 0u; cnt = 0u; mine = 0u;
#pragma unroll
        for (unsigned j = 0; j < 16; ++j) { const unsigned c = xb_ld(&bar[XB_XCNT(j)]); sum += c; cnt += (c > 0u) ? 1u : 0u; mine = (j == x) ? c : mine; }
        if (sum == G) break;
        __builtin_amdgcn_s_sleep(1);
        if ((++sp & 255u) == 0u) { if (xb_ld(&bar[XB_TMO])) break; if (sp > XB_SPIN_CAP) { atomicAdd(&bar[XB_TMO], 1u); break; } }
    }
    nloc = mine > 0u ? mine : 1u; nx = cnt > 0u ? cnt : 1u;
}
__device__ __forceinline__ void xcd_barrier(const XcdBarrier& b) {
    asm volatile("s_waitcnt vmcnt(0)" ::: "memory");
    __syncthreads();
    if (threadIdx.x == 0) {
        unsigned* bar = b.bar;
        __builtin_amdgcn_s_waitcnt(0);
        unsigned nloc = b.st[0], nx = b.st[1];
        if (nloc == 0u) { xcd_barrier_complete(bar, b.x, nloc, nx); b.st[0] = nloc; b.st[1] = nx; }
        const unsigned old = xb_add(&bar[XB_XSUB(b.x)], 1u);
        const unsigned gen = old / nloc;
        if (old + 1u == (gen + 1u) * nloc) {
            __builtin_amdgcn_fence(__ATOMIC_RELEASE, "agent");
            asm volatile("s_waitcnt vmcnt(0)" ::: "memory");
            const unsigned og = xb_add(&bar[XB_TOP], 1u);
            const unsigned tg = og / nx;
            if (og + 1u == (tg + 1u) * nx) xb_add(&bar[XB_TOPGEN], 1u);
            else XB_SPIN(xb_ld(&bar[XB_TOPGEN]) == tg, bar);
            __builtin_amdgcn_fence(__ATOMIC_ACQUIRE, "agent");
            xb_add(&bar[XB_XGEN(b.x)], 1u);
            asm volatile("s_waitcnt vmcnt(0)" ::: "memory");
        } else {
            XB_SPIN(xb_ld(&bar[XB_XGEN(b.x)]) == gen, bar);
            __builtin_amdgcn_fence(__ATOMIC_ACQUIRE, "agent");
            asm volatile("s_waitcnt vmcnt(0)" ::: "memory");
        }
    }
    __syncthreads();
}
#else
#define XCD_BAR_WORDS 3456
struct XcdBarrier { int dummy; };
static inline void xcd_barrier(const XcdBarrier&) { sim::grid_sync(); }
#endif

namespace pg8 {
constexpr int BM = 256, BK = 64, HALF = 128, HTB = HALF * BK * 2, NXCD = 8, WGM = 8;
__host__ __device__ __forceinline__ int lds_byte(int r, int c) { const int st = (r >> 4) * 2 + (c >> 5), rr = r & 15, cc = c & 31, ob = rr * 64 + cc * 2; return st * 1024 + (ob ^ (((ob >> 9) & 1) << 5)); }
__host__ __device__ __forceinline__ void stage_rc(int b, int& R, int& C) { const int st = b / 1024, sb = b % 1024, swz = sb ^ (((sb >> 9) & 1) << 5); R = (st >> 1) * 16 + swz / 64; C = (st & 1) * 32 + (swz % 64) / 2; }
__host__ __device__ __forceinline__ int perm32(int rho) { const int n = rho >> 4, i = rho & 15; return 8 * (i >> 2) + 4 * n + (i & 3); }
struct Unit { int pm, pn, sel; };
struct Gemm { const h16* A; const h16* Bt; size_t sa, sb; int M, N, K;
    __device__ __forceinline__ const char* a(int s) const { return (const char*)(A + (size_t)s * sa); }
    __device__ __forceinline__ const char* b(int s) const { return (const char*)(Bt + (size_t)s * sb); } };
struct StaticOrder {
    int nM, nN, nwg, G, c;
    __host__ __device__ void init(int M_, int N_, int G_, int c_) { nM = M_ / BM; nN = N_ / BM; nwg = nM * nN; G = G_; c = c_; }
    __host__ __device__ bool next(int i, Unit& u) const {
        const long L = (long)i * G + c; if (L >= nwg) return false;
        int wgid = (int)L; { const int q = nwg / NXCD, r = nwg % NXCD, xcd = wgid % NXCD, off = wgid / NXCD; wgid = (xcd < r ? xcd * (q + 1) : r * (q + 1) + (xcd - r) * q) + off; }
        const int nig = WGM * nN, gid = wgid / nig, fm = gid * WGM, gsz = (nM - fm) < WGM ? (nM - fm) : WGM;
        u.pm = fm + ((wgid % nig) % gsz); u.pn = (wgid % nig) / gsz; u.sel = 0; return true;
    }
};
template <int NSEL> struct MultiOrder {
    StaticOrder S;
    __host__ __device__ void init(int M_, int N_, int G_, int c_) { S.init(M_, N_, G_, c_); }
    __host__ __device__ bool next(int i, Unit& u) const { const bool ok = S.next(i / NSEL, u); u.sel = i % NSEL; return ok; }
};

template <class Epi, class Sched>
__device__ __forceinline__ void gemm_phase(LAS unsigned char* lds, const Gemm g, const Sched& S, const Epi& E) {
    int tid = threadIdx.x; LAUNDER(tid);
    const int wid = __builtin_amdgcn_readfirstlane(tid >> 6), lane = tid & 63, wr = wid >> 2, wc = wid & 3, fr = lane & 15, fq = lane >> 4;
    const int K = g.K, nt = K / BK;
    unsigned voffA[2], voffB[2];
#pragma unroll
    for (int i = 0; i < 2; ++i) { int R, C; stage_rc(tid * 16 + i * 8192, R, C); const int Rb = Epi::PERM ? ((R & ~31) + perm32(R & 31)) : R;
        voffA[i] = (unsigned)(R * K + C) * 2u; voffB[i] = (unsigned)(Rb * K + C) * 2u; }
    const size_t kstep = (size_t)(BK * 2);
    const size_t hstep = (size_t)HALF * K * 2;
    const size_t tstep = 2 * hstep;
    const unsigned ldsw = (unsigned)wid * 1024u;
    const int aoff = lds_byte(wr * 64 + fr, fq * 8), boff = lds_byte(wc * 32 + fr, fq * 8);
#define PG8_SA(b, h) (((b) * 2 + (h)) * HTB)
#define PG8_SB(b, h) ((4 + (b) * 2 + (h)) * HTB)
#define PG8_STAGE(bufoff, gbase, voff) do { _Pragma("unroll") for (int _i = 0; _i < 2; ++_i) \
        GLDS16((const char*)(gbase) + (voff)[_i], lds + (bufoff) + ldsw + _i * 8192); } while (0)
#define PG8_LDA(dst, b, h) do { _Pragma("unroll") for (int m = 0; m < 4; ++m) _Pragma("unroll") for (int k = 0; k < 2; ++k) dst[m][k] = *(const LAS h16x8*)(lds + PG8_SA(b, h) + aoff + m * 2048 + k * 1024); } while (0)
#define PG8_LDB(dst, b, h) do { _Pragma("unroll") for (int n = 0; n < 2; ++n) _Pragma("unroll") for (int k = 0; k < 2; ++k) dst[n][k] = *(const LAS h16x8*)(lds + PG8_SB(b, h) + boff + n * 2048 + k * 1024); } while (0)
#define PG8_MMA(ai, bj, At, Bt) do { SETPRIO(1); _Pragma("unroll") for (int m = 0; m < 4; ++m) _Pragma("unroll") for (int n = 0; n < 2; ++n) _Pragma("unroll") for (int k = 0; k < 2; ++k) \
        acc[ai][bj][m][n] = MFMA16(Bt[n][k], At[m][k], acc[ai][bj][m][n]); SETPRIO(0); } while (0)
    Unit cur, nxt; int ui = 0;
    if (!S.next(0, cur)) return;
    f32x4 acc[2][2][4][2];
#if defined(HOST_SIM) && defined(SIM_FAST_GEMM)
    for (;; ++ui) {
        if (!S.next(ui, cur)) break;
        const h16* Ap = (const h16*)g.a(cur.sel); const h16* Bp = (const h16*)g.b(cur.sel);
        for (int ai = 0; ai < 2; ++ai) for (int bj = 0; bj < 2; ++bj) for (int m = 0; m < 4; ++m) for (int n = 0; n < 2; ++n) for (int j = 0; j < 4; ++j) {
            const int row = cur.pm * 256 + ai * 128 + wr * 64 + m * 16 + fr;
            const int col = cur.pn * 256 + bj * 128 + wc * 32 + (Epi::PERM ? 8 * fq + 4 * n + j : 16 * n + 4 * fq + j);
            float sacc = 0.f; for (int k = 0; k < K; ++k) sacc += (float)Ap[(size_t)row * K + k] * (float)Bp[(size_t)col * K + k];
            acc[ai][bj][m][n][j] = sacc; }
        E(acc, cur, wr, wc, fr, fq);
    }
    (void)nxt; (void)voffA; (void)voffB; (void)aoff; (void)boff; (void)ldsw; (void)kstep; (void)tstep; (void)nt;
    return;
#endif
#pragma unroll
    for (int a = 0; a < 2; ++a)
#pragma unroll
        for (int b = 0; b < 2; ++b)
#pragma unroll
            for (int m = 0; m < 4; ++m)
#pragma unroll
                for (int n = 0; n < 2; ++n) acc[a][b][m][n] = (f32x4){0.f, 0.f, 0.f, 0.f};
    h16x8 At[4][2], B0[2][2], B1[2][2];
    const char* cA = g.a(cur.sel) + (size_t)cur.pm * tstep; const char* cB = g.b(cur.sel) + (size_t)cur.pn * tstep;
    PG8_STAGE(PG8_SB(0, 0), cB, voffB); PG8_STAGE(PG8_SA(0, 0), cA, voffA); PG8_STAGE(PG8_SB(0, 1), cB + hstep, voffB); PG8_STAGE(PG8_SA(0, 1), cA + hstep, voffA);
    if (wr == 1) SBAR;
    WAIT_V(4); SBAR;
    PG8_STAGE(PG8_SB(1, 0), cB + kstep, voffB); PG8_STAGE(PG8_SA(1, 0), cA + kstep, voffA); PG8_STAGE(PG8_SB(1, 1), cB + hstep + kstep, voffB);
    WAIT_V(6); SBAR;
    for (;;) {
        const bool has_next = S.next(ui + 1, nxt);
        const char* nA = has_next ? g.a(nxt.sel) + (size_t)nxt.pm * tstep : cA; const char* nB = has_next ? g.b(nxt.sel) + (size_t)nxt.pn * tstep : cB;
        for (int t = 0; t < nt; t += 2) {
            const bool last = (t == nt - 2);
            const char* a1 = cA + (size_t)(t + 1) * kstep;
            const char* a2 = last ? nA : cA + (size_t)(t + 2) * kstep; const char* b2 = last ? nB : cB + (size_t)(t + 2) * kstep;
            const char* a3 = a2 + kstep; const char* b3 = b2 + kstep;
            PG8_LDB(B0, 0, 0); SCHED; PG8_LDA(At, 0, 0); PG8_STAGE(PG8_SA(1, 1), a1 + hstep, voffA);
            WAIT_L(8); SBAR; WAIT_L(0); PG8_MMA(0, 0, At, B0); SBAR; SCHED;
            PG8_LDB(B1, 0, 1); PG8_STAGE(PG8_SB(0, 0), b2, voffB);
            SBAR; WAIT_L(0); PG8_MMA(0, 1, At, B1); SBAR;
            PG8_LDA(At, 0, 1); PG8_STAGE(PG8_SA(0, 0), a2, voffA);
            SBAR; WAIT_L(0); PG8_MMA(1, 0, At, B0); SBAR; SCHED;
            PG8_STAGE(PG8_SB(0, 1), b2 + hstep, voffB);
            WAIT_V(6); SBAR; PG8_MMA(1, 1, At, B1); SBAR;
            PG8_LDB(B0, 1, 0); SCHED; PG8_LDA(At, 1, 0); PG8_STAGE(PG8_SA(0, 1), a2 + hstep, voffA);
            WAIT_L(8); SBAR; WAIT_L(0); PG8_MMA(0, 0, At, B0); SBAR; SCHED;
            PG8_LDB(B1, 1, 1); PG8_STAGE(PG8_SB(1, 0), b3, voffB);
            SBAR; WAIT_L(0); PG8_MMA(0, 1, At, B1); SBAR;
            PG8_LDA(At, 1, 1); PG8_STAGE(PG8_SA(1, 0), a3, voffA);
            SBAR; WAIT_L(0); PG8_MMA(1, 0, At, B0); SBAR; SCHED;
            PG8_STAGE(PG8_SB(1, 1), b3 + hstep, voffB);
            WAIT_V(6); SBAR; PG8_MMA(1, 1, At, B1); SBAR;
        }
        E(acc, cur, wr, wc, fr, fq);
        if (!has_next) break;
#pragma unroll
        for (int a = 0; a < 2; ++a)
#pragma unroll
            for (int b = 0; b < 2; ++b)
#pragma unroll
                for (int m = 0; m < 4; ++m)
#pragma unroll
                    for (int n = 0; n < 2; ++n) acc[a][b][m][n] = (f32x4){0.f, 0.f, 0.f, 0.f};
        cur = nxt; cA = nA; cB = nB; ++ui;
    }
    WAIT_V(0);
    if (wr == 0) SBAR;
    SBAR;
#undef PG8_SA
#undef PG8_SB
#undef PG8_STAGE
#undef PG8_LDA
#undef PG8_LDB
#undef PG8_MMA
}
}

__device__ __forceinline__ int mod_row(int row) { return row < MP ? 0 : 1 + (row - MP) / DSEQ; }

struct EpiIn {
    static constexpr bool PERM = true;
    h16* Z; float* LOGF; const float* LB;
    __device__ __forceinline__ void operator()(const f32x4 (&acc)[2][2][4][2], const pg8::Unit& u, int wr, int wc, int fr, int fq) const {
        const int colt = u.pn * 256;
        int kind;
        if (colt < 2 * W) kind = 0; else if (colt < 4 * W) kind = 1; else if (colt < 5 * W) kind = 2; else if (colt < C_AG) kind = 0; else if (colt < C_SU) kind = 2;
        else if (colt < C_SG) kind = 0; else if (colt < C_MG) kind = 2; else kind = 3;
        const int row0 = u.pm * 256 + wr * 64 + fr;
        if (kind == 1) {
            const int dir = colt >= 3 * W ? 1 : 0;
#pragma unroll
            for (int bj = 0; bj < 2; ++bj) {
                const int c0 = colt + bj * 128 + wc * 32 + 8 * fq;
                const float* lbp = LB + (size_t)dir * DEPTH * W + (c0 - (2 + dir) * W);
                const f32x4 l0 = *(const f32x4*)lbp, l1 = *(const f32x4*)(lbp + 4);
#pragma unroll
                for (int ai = 0; ai < 2; ++ai)
#pragma unroll
                    for (int m = 0; m < 4; ++m) {
                        const int row = row0 + ai * 128 + m * 16;
                        f32x4 o0, o1;
#pragma unroll
                        for (int j = 0; j < 4; ++j) { o0[j] = logf(l0[j] + (1.0f - l0[j]) * sigm(acc[ai][bj][m][0][j])); o1[j] = logf(l1[j] + (1.0f - l1[j]) * sigm(acc[ai][bj][m][1][j])); }
                        float* dst = LOGF + (size_t)row * (2 * W) + (c0 - 2 * W);
                        *(f32x4*)dst = o0; *(f32x4*)(dst + 4) = o1;
                    }
            }
            return;
        }
#pragma unroll
        for (int ai = 0; ai < 2; ++ai)
#pragma unroll
            for (int m = 0; m < 4; ++m) {
                const int row = row0 + ai * 128 + m * 16;
#pragma unroll
                for (int bj = 0; bj < 2; ++bj) {
                    const int c0 = colt + bj * 128 + wc * 32 + 8 * fq;
                    h16x8 o;
#pragma unroll
                    for (int j = 0; j < 4; ++j) {
                        float a = acc[ai][bj][m][0][j], b = acc[ai][bj][m][1][j];
                        if (kind == 2) { a = siluf(a); b = siluf(b); } else if (kind == 3) { a = sigm(a); b = sigm(b); }
                        o[j] = (h16)a; o[4 + j] = (h16)b;
                    }
                    *(h16x8*)(Z + (size_t)row * INC + c0) = o;
                }
            }
    }
};
struct EpiGlu {
    static constexpr bool PERM = true;
    const h16* YS; const h16* Z; h16* OS5;
    __device__ __forceinline__ void operator()(const f32x4 (&acc)[2][2][4][2], const pg8::Unit& u, int wr, int wc, int fr, int fq) const {
        const int colt = u.pn * 256, row0 = u.pm * 256 + wr * 64 + fr;
#pragma unroll
        for (int ai = 0; ai < 2; ++ai)
#pragma unroll
            for (int m = 0; m < 4; ++m) {
                const int row = row0 + ai * 128 + m * 16;
#pragma unroll
                for (int bj = 0; bj < 2; ++bj) {
                    const int c0 = colt + bj * 128 + wc * 32 + 8 * fq;
                    const h16x8 ys = *(const h16x8*)(YS + (size_t)row * W + c0), sg = *(const h16x8*)(Z + (size_t)row * INC + C_SG + c0);
                    h16x8 o;
#pragma unroll
                    for (int j = 0; j < 4; ++j) { o[j] = (h16)((float)ys[j] * sigm(acc[ai][bj][m][0][j]) * (float)sg[j]); o[4 + j] = (h16)((float)ys[4 + j] * sigm(acc[ai][bj][m][1][j]) * (float)sg[4 + j]); }
                    *(h16x8*)(OS5 + (size_t)row * W + c0) = o;
                }
                CFENCE;
            }
    }
};
struct EpiBr {
    static constexpr bool PERM = true;
    const h16* Z; h16* MG;
    __device__ __forceinline__ void operator()(const f32x4 (&acc)[2][2][4][2], const pg8::Unit& u, int wr, int wc, int fr, int fq) const {
        const int colt = u.pn * 256, row0 = u.pm * 256 + wr * 64 + fr, b = u.sel;
#pragma unroll
        for (int ai = 0; ai < 2; ++ai)
#pragma unroll
            for (int m = 0; m < 4; ++m) {
                const int row = row0 + ai * 128 + m * 16;
#pragma unroll
                for (int bj = 0; bj < 2; ++bj) {
                    const int c0 = colt + bj * 128 + wc * 32 + 8 * fq;
                    const h16x8 gt = *(const h16x8*)(Z + (size_t)row * INC + C_MG + (size_t)b * D + c0);
                    h16x8 pv = gt; if (b > 0) pv = *(const h16x8*)(MG + (size_t)row * D + c0);
                    h16x8 o;
#pragma unroll
                    for (int j = 0; j < 4; ++j) {
                        float a = (float)gt[j] * acc[ai][bj][m][0][j], c = (float)gt[4 + j] * acc[ai][bj][m][1][j];
                        if (b > 0) { a += (float)pv[j]; c += (float)pv[4 + j]; }
                        o[j] = (h16)a; o[4 + j] = (h16)c;
                    }
                    *(h16x8*)(MG + (size_t)row * D + c0) = o;
                }
                CFENCE;
            }
    }
};
struct EpiOut {
    static constexpr bool PERM = false;
    const float* XP; const float* XS; float* X; const float* MOD;
    __device__ __forceinline__ void operator()(const f32x4 (&acc)[2][2][4][2], const pg8::Unit& u, int wr, int wc, int fr, int fq) const {
        const int colt = u.pn * 256, row0 = u.pm * 256 + wr * 64 + fr;
#pragma unroll
        for (int ai = 0; ai < 2; ++ai)
#pragma unroll
            for (int m = 0; m < 4; ++m) {
                const int row = row0 + ai * 128 + m * 16;
                const float* xin = row < MP ? XP + (size_t)row * D : XS + (size_t)(row - MP) * D;
                const float* gate = MOD + (size_t)mod_row(row) * 3 * D + 2 * D;
#pragma unroll
                for (int bj = 0; bj < 2; ++bj)
#pragma unroll
                    for (int n = 0; n < 2; ++n) {
                        const int c0 = colt + bj * 128 + wc * 32 + 16 * n + 4 * fq;
                        const f32x4 xi = *(const f32x4*)(xin + c0), gv = *(const f32x4*)(gate + c0);
                        *(f32x4*)(X + (size_t)row * D + c0) = xi + gv * acc[ai][bj][m][n];
                    }
                CFENCE;
            }
    }
};

__device__ __forceinline__ void transpose_cvt(LAS float* tile, const float* src, h16* dst, int K, int N, int bid, int G) {
    const int nkt = K / 64, nnt = N / 64, tid = threadIdx.x;
    for (int t = bid; t < nkt * nnt; t += G) {
        const int kt = t / nnt, ntile = t % nnt;
#pragma unroll
        for (int i = 0; i < 8; ++i) { const int idx = tid + i * 512, k = idx >> 6, n = idx & 63; tile[k * 65 + n] = src[(size_t)(kt * 64 + k) * N + ntile * 64 + n]; }
        __syncthreads();
#pragma unroll
        for (int i = 0; i < 8; ++i) { const int idx = tid + i * 512, n = idx >> 6, k = idx & 63; dst[(size_t)(ntile * 64 + n) * K + kt * 64 + k] = (h16)tile[k * 65 + n]; }
        __syncthreads();
    }
}
__device__ __forceinline__ void phase_prologue(const Params& p, LAS unsigned char* lds) {
    const int tid = threadIdx.x, bid = blockIdx.x, G = gridDim.x;
    unsigned char* ws = p.ws;
    {
        const int nitems = DEPTH * (3 * D / 128);
        if (bid < nitems) {
            LAS float* sc = (LAS float*)lds;
            LAS float* red = sc + NMODR * D;
            for (int i = tid; i < NMODR * D; i += NTHREADS) { const int r = i / D, k = i % D; const float c = r == 0 ? p.in[I_CCTX][k] : p.in[I_C][(size_t)(r - 1) * D + k]; sc[i] = siluf(c); }
            __syncthreads();
            for (int it = bid; it < nitems; it += G) {
                const int l = it / (3 * D / 128), j = (it % (3 * D / 128)) * 128 + (tid & 127), kg = tid >> 7;
                float a[NMODR];
#pragma unroll
                for (int r = 0; r < NMODR; ++r) a[r] = 0.f;
                const float* wp = p.in[I_WMOD] + (size_t)l * D * 3 * D + j;
                for (int k = kg * (D / 4); k < (kg + 1) * (D / 4); ++k) { const float w = wp[(size_t)k * 3 * D];
#pragma unroll
                    for (int r = 0; r < NMODR; ++r) a[r] += sc[r * D + k] * w; }
#pragma unroll
                for (int r = 0; r < NMODR; ++r) red[(kg * NMODR + r) * 128 + (tid & 127)] = a[r];
                __syncthreads();
                for (int i = tid; i < NMODR * 128; i += NTHREADS) { const int r = i / 128, jj = i % 128; const int jcol = (it % (3 * D / 128)) * 128 + jj;
                    const float s = red[(0 * NMODR + r) * 128 + jj] + red[(1 * NMODR + r) * 128 + jj] + red[(2 * NMODR + r) * 128 + jj] + red[(3 * NMODR + r) * 128 + jj];
                    ((float*)(ws + WS_MOD))[((size_t)l * NMODR + r) * 3 * D + jcol] = s + p.in[I_BMOD][(size_t)l * 3 * D + jcol]; }
                __syncthreads();
            }
        }
        __syncthreads();
    }
    for (int i = bid * NTHREADS + tid; i < 2 * W; i += G * NTHREADS) {
        const int dir = i / W, w = i % W; const float* lg = p.in[I_LBL] + (size_t)dir * DEPTH * W + w;
        float mx = -1e30f; for (int l = 0; l < DEPTH; ++l) mx = fmaxf(mx, lg[(size_t)l * W]);
        float den = 0.f; for (int l = 0; l < DEPTH; ++l) den += __expf(lg[(size_t)l * W] - mx);
        float cs = 0.f, first = 0.f;
        for (int l = 0; l < DEPTH; ++l) { cs += __expf(lg[(size_t)l * W] - mx) / den; if (l == 0) first = cs; ((float*)(ws + WS_LB))[((size_t)dir * DEPTH + l) * W + w] = cs - first; }
    }
    for (int i = bid * NTHREADS + tid; i < DEPTH * 2 * S5G * S5P; i += G * NTHREADS) {
        const int gidx = i / S5P;
        const float are = p.in[I_ARE][i], aim = p.in[I_AIM][i], dt = __expf(p.in[I_LDT][gidx]);
        const float mag = expf(are * dt), abr = mag * cosf(aim * dt), abi = mag * sinf(aim * dt);
        const float den = are * are + aim * aim, nre = abr - 1.0f;
        const float cre = (nre * are + abi * aim) / den, cim = (abi * are - nre * aim) / den;
        ((f32x2*)(ws + WS_ABAR))[i] = (f32x2){abr, abi};
        float* bb = (float*)(ws + WS_BBAR) + (size_t)i * 32;
        for (int c = 0; c < 16; ++c) { const float br = p.in[I_BRE][(size_t)i * 16 + c], bi = p.in[I_BIM][(size_t)i * 16 + c]; bb[c] = cre * br - cim * bi; bb[16 + c] = cre * bi + cim * br; }
    }
    LAS float* tile = (LAS float*)lds;
    for (int l = 0; l < DEPTH; ++l) {
        transpose_cvt(tile, p.in[I_WIN] + (size_t)l * D * INC, (h16*)(ws + WS_WIN) + (size_t)l * INC * D, D, INC, bid, G);
        transpose_cvt(tile, p.in[I_WGLU] + (size_t)l * W * W, (h16*)(ws + WS_WGLU) + (size_t)l * W * W, W, W, bid, G);
        transpose_cvt(tile, p.in[I_WBRHG] + (size_t)l * W * D, (h16*)(ws + WS_WBR) + (size_t)(l * 3 + 0) * D * W, W, D, bid, G);
        transpose_cvt(tile, p.in[I_WBRAT] + (size_t)l * W * D, (h16*)(ws + WS_WBR) + (size_t)(l * 3 + 1) * D * W, W, D, bid, G);
        transpose_cvt(tile, p.in[I_WBRS5] + (size_t)l * W * D, (h16*)(ws + WS_WBR) + (size_t)(l * 3 + 2) * D * W, W, D, bid, G);
        transpose_cvt(tile, p.in[I_WOUT] + (size_t)l * D * D, (h16*)(ws + WS_WOUT) + (size_t)l * D * D, D, D, bid, G);
    }
}

__device__ __forceinline__ void phase_norm(const Params& p, int l) {
    int tid_ = threadIdx.x; LAUNDER(tid_);
    const int lane = tid_ & 63, gw = blockIdx.x * NWAVES + (tid_ >> 6), nw = gridDim.x * NWAVES;
    const float* nwt = p.in[I_NORMW] + (size_t)l * D;
    const float* MOD = (const float*)(p.ws + WS_MOD) + (size_t)l * NMODR * 3 * D;
    h16* H = (h16*)(p.ws + WS_H);
    for (int row = gw; row < M; row += nw) {
        const float* x = l == 0 ? (row < MP ? p.in[I_XP] + (size_t)row * D : p.in[I_XS] + (size_t)(row - MP) * D) : (const float*)(p.ws + WS_X) + (size_t)row * D;
        f32x4 v[D / 256]; float ss = 0.f;
#pragma unroll
        for (int i = 0; i < D / 256; ++i) { v[i] = *(const f32x4*)(x + i * 256 + lane * 4); ss += v[i][0] * v[i][0] + v[i][1] * v[i][1] + v[i][2] * v[i][2] + v[i][3] * v[i][3]; }
        ss = wave_sum(ss);
        const float rstd = rsqrtf(ss / (float)D + EPS);
        const float* md = MOD + (size_t)mod_row(row) * 3 * D;
#pragma unroll
        for (int i = 0; i < D / 256; ++i) { const int c = i * 256 + lane * 4; const f32x4 wv = *(const f32x4*)(nwt + c), sh = *(const f32x4*)(md + c), scl = *(const f32x4*)(md + D + c);
            h16x4 o;
#pragma unroll
            for (int j = 0; j < 4; ++j) o[j] = (h16)(v[i][j] * rstd * wv[j] * (1.0f + scl[j]) + sh[j]);
            *(h16x4*)(H + (size_t)row * D + c) = o; }
    }
}
__device__ __forceinline__ void phase_final(const Params& p) {
    int tid_ = threadIdx.x; LAUNDER(tid_);
    const int lane = tid_ & 63, gw = blockIdx.x * NWAVES + (tid_ >> 6), nw = gridDim.x * NWAVES;
    const float* fw = p.in[I_FNORM];
    for (int row = gw; row < M; row += nw) {
        const float* x = (const float*)(p.ws + WS_X) + (size_t)row * D;
        f32x4 v[D / 256]; float ss = 0.f;
#pragma unroll
        for (int i = 0; i < D / 256; ++i) { v[i] = *(const f32x4*)(x + i * 256 + lane * 4); ss += v[i][0] * v[i][0] + v[i][1] * v[i][1] + v[i][2] * v[i][2] + v[i][3] * v[i][3]; }
        ss = wave_sum(ss);
        const float rstd = rsqrtf(ss / (float)D + EPS);
#pragma unroll
        for (int i = 0; i < D / 256; ++i) { const int c = i * 256 + lane * 4; const f32x4 wv = *(const f32x4*)(fw + c);
            *(f32x4*)(p.out + O_Y + (size_t)row * D + c) = v[i] * rstd * wv; }
    }
}

__device__ __forceinline__ void c_attn_prep(const Params& p, int l, int item, int lane) {
    constexpr int NS = AQH + 2 * AKVH;
    const int row = item / NS, slot = item % NS;
    const h16* Z = (const h16*)(p.ws + WS_Z) + (size_t)row * INC;
    const bool smp = row >= MP;
    const int b = smp ? (row - MP) / DSEQ : row / SEQ, t = smp ? (row - MP) % DSEQ : row % SEQ;
    if (slot < AQH + AKVH) {
        const bool isq = slot < AQH; const int hh = isq ? slot : slot - AQH;
        const h16* src = Z + (isq ? C_AQ : C_AK) + hh * 128;
        const float* wn = p.in[isq ? I_QNORM : I_KNORM] + (size_t)l * 128;
        float x0 = (float)src[lane], x1 = (float)src[lane + 64];
        const float ss = wave_sum(x0 * x0 + x1 * x1);
        const float rstd = rsqrtf(ss * (1.0f / 128.0f) + EPS);
        x0 = x0 * rstd * wn[lane]; x1 = x1 * rstd * wn[lane + 64];
        if (!isq && !smp) { float* ck = p.out + O_CK + (((size_t)b * DEPTH + l) * SEQ + t) * KVW + hh * 128; ck[lane] = x0; ck[lane + 64] = x1; }
        if (smp) {
            const int j = lane & 31; const float inv = exp2f(-(float)j * (13.287712379549449f / 32.0f));
            const float a0 = (float)(t / 64) * inv, a1 = (float)(t % 64) * inv;
            const float c0 = cosf(a0), s0 = sinf(a0), c1 = cosf(a1), s1 = sinf(a1);
            const float p0 = __shfl_xor(x0, 32), p1 = __shfl_xor(x1, 32);
            x0 = lane < 32 ? x0 * c0 - p0 * s0 : x0 * c0 + p0 * s0;
            x1 = lane < 32 ? x1 * c1 - p1 * s1 : x1 * c1 + p1 * s1;
        }
        if (isq) { h16* dst = (h16*)(p.ws + WS_AQ2) + (size_t)row * W + hh * 128; const float sc = 0.08838834764831845f; dst[lane] = (h16)(x0 * sc); dst[lane + 64] = (h16)(x1 * sc); }
        else { h16* dst = smp ? (h16*)(p.ws + WS_KBS) + ((size_t)b * KVLEN + PAST + t) * KVW + hh * 128 : (h16*)(p.ws + WS_KBC) + ((size_t)b * SEQ + t) * KVW + hh * 128; dst[lane] = (h16)x0; dst[lane + 64] = (h16)x1; }
    } else {
        const int hh = slot - AQH - AKVH; const h16* src = Z + C_AV + hh * 128;
        const h16 v0 = src[lane], v1 = src[lane + 64];
        if (!smp) { float* cv = p.out + O_CV + (((size_t)b * DEPTH + l) * SEQ + t) * KVW + hh * 128; cv[lane] = (float)v0; cv[lane + 64] = (float)v1; }
        h16* dst = smp ? (h16*)(p.ws + WS_VBS) + ((size_t)b * KVLEN + PAST + t) * KVW + hh * 128 : (h16*)(p.ws + WS_VBC) + ((size_t)b * SEQ + t) * KVW + hh * 128; dst[lane] = v0; dst[lane + 64] = v1;
    }
}
__device__ __forceinline__ void c_cache_copy(const Params& p, int l, int item, int lane) {
    const int b = item / PAST, pos = item % PAST;
    const float* ck = p.in[I_CK] + (((size_t)b * DEPTH + l) * PAST + pos) * KVW; const float* cv = p.in[I_CV] + (((size_t)b * DEPTH + l) * PAST + pos) * KVW;
    h16* kd = (h16*)(p.ws + WS_KBS) + ((size_t)b * KVLEN + pos) * KVW; h16* vd = (h16*)(p.ws + WS_VBS) + ((size_t)b * KVLEN + pos) * KVW;
    for (int i = lane; i < KVW; i += 64) { kd[i] = (h16)ck[i]; vd[i] = (h16)cv[i]; }
}
__device__ __forceinline__ void c_hgrn(const Params& p, int l, int item, int lane) {
    const int vh = item & 1, dir = (item >> 1) & 1, h = (item >> 2) % HGH, sq = (item >> 2) / HGH;
    const bool smp = sq < DBATCH; const int b = smp ? sq : sq - DBATCH;
    const int T = smp ? DSEQ : SEQ, row0 = smp ? MP + b * DSEQ : b * SEQ;
    const h16* Z = (const h16*)(p.ws + WS_Z); const float* LOGF = (const float*)(p.ws + WS_LOGF);
    float* O = (float*)(p.ws + (dir ? WS_OB : WS_OF));
    const int vcol = vh * 64 + lane;
    float S[128];
    if (smp) { const float* s0 = p.in[I_SH] + ((((size_t)b * DEPTH + l) * 2 + dir) * HGH + h) * 128 * 128 + vcol;
#pragma unroll
        for (int d = 0; d < 128; ++d) S[d] = s0[(size_t)d * 128]; }
    else {
#pragma unroll
        for (int d = 0; d < 128; ++d) S[d] = 0.f; }
    for (int tt = 0; tt < T; ++tt) {
        const int row = row0 + (dir ? T - 1 - tt : tt);
        const float* lf = LOGF + (size_t)row * 2 * W + dir * W + h * 128;
        const h16* zr = Z + (size_t)row * INC;
        const float f0 = __expf(lf[lane]), f1 = __expf(lf[lane + 64]);
        const float k0 = 1.0f - f0, k1 = 1.0f - f1;
        const float q0 = (float)zr[C_HQ + h * 128 + lane], q1 = (float)zr[C_HQ + h * 128 + lane + 64];
        const float v = (float)zr[C_HI + h * 128 + vcol];
        float o = 0.f;
#pragma unroll
        for (int d = 0; d < 64; ++d) { const float fd = readlane_f(f0, d), kd = readlane_f(k0, d), qd = readlane_f(q0, d); S[d] = fd * S[d] + kd * v; o += qd * S[d]; }
#pragma unroll
        for (int d = 0; d < 64; ++d) { const float fd = readlane_f(f1, d), kd = readlane_f(k1, d), qd = readlane_f(q1, d); S[64 + d] = fd * S[64 + d] + kd * v; o += qd * S[64 + d]; }
        O[(size_t)row * W + h * 128 + vcol] = o;
    }
    if (!smp) { float* so = p.out + O_SH + ((((size_t)b * DEPTH + l) * 2 + dir) * HGH + h) * 128 * 128 + vcol;
#pragma unroll
        for (int d = 0; d < 128; ++d) so[(size_t)d * 128] = S[d]; }
}
__device__ __forceinline__ void c_s5(const Params& p, int l, int item, int lane) {
    const int dir = item & 1, g = (item >> 1) % S5G, sq = (item >> 1) / S5G;
    const bool smp = sq < DBATCH; const int b = smp ? sq : sq - DBATCH;
    const int T = smp ? DSEQ : SEQ, row0 = smp ? MP + b * DSEQ : b * SEQ;
    const h16* Z = (const h16*)(p.ws + WS_Z);
    float* Y = (float*)(p.ws + (dir ? WS_YB : WS_YF));
    const size_t pi = (((size_t)l * 2 + dir) * S5G + g) * S5P + lane;
    const f32x2 ab = ((const f32x2*)(p.ws + WS_ABAR))[pi];
    float bre[16], bim[16], cre[16], cim[16];
    { const float* bb = (const float*)(p.ws + WS_BBAR) + pi * 32;
#pragma unroll
      for (int c = 0; c < 16; ++c) { bre[c] = bb[c]; bim[c] = bb[16 + c]; cre[c] = p.in[I_CRE][(((size_t)l * S5G + g) * 16 + c) * S5P + lane]; cim[c] = p.in[I_CIM][(((size_t)l * S5G + g) * 16 + c) * S5P + lane]; } }
    float sr = 0.f, si = 0.f;
    if (smp) { const size_t si0 = (((size_t)b * DEPTH + l) * 2 + dir) * S5G * S5P + (size_t)g * S5P + lane; sr = p.in[I_SR][si0]; si = p.in[I_SI][si0]; }
    const int b3 = (lane >> 3) & 1, b2 = (lane >> 2) & 1, b1 = (lane >> 1) & 1, b0 = lane & 1;
    for (int tt = 0; tt < T; ++tt) {
        const int row = row0 + (dir ? T - 1 - tt : tt);
        const float uv = (float)Z[(size_t)row * INC + C_SU + g * 16 + (lane & 15)];
        float bur = 0.f, bui = 0.f;
#pragma unroll
        for (int c = 0; c < 16; ++c) { const float uc = readlane_f(uv, c); bur += bre[c] * uc; bui += bim[c] * uc; }
        const float nr = ab[0] * sr - ab[1] * si + bur, ni = ab[0] * si + ab[1] * sr + bui;
        sr = nr; si = ni;
        float w8[8], w4[4], w2[2], w1;
#pragma unroll
        for (int j = 0; j < 8; ++j) { const float lo = cre[j] * sr - cim[j] * si, hi = cre[j + 8] * sr - cim[j + 8] * si; const float send = b3 ? lo : hi, keep = b3 ? hi : lo; w8[j] = keep + __shfl_xor(send, 8); }
#pragma unroll
        for (int j = 0; j < 4; ++j) { const float send = b2 ? w8[j] : w8[j + 4], keep = b2 ? w8[j + 4] : w8[j]; w4[j] = keep + __shfl_xor(send, 4); }
#pragma unroll
        for (int j = 0; j < 2; ++j) { const float send = b1 ? w4[j] : w4[j + 2], keep = b1 ? w4[j + 2] : w4[j]; w2[j] = keep + __shfl_xor(send, 2); }
        { const float send = b0 ? w2[0] : w2[1], keep = b0 ? w2[1] : w2[0]; w1 = keep + __shfl_xor(send, 1); }
        w1 += __shfl_xor(w1, 16); w1 += __shfl_xor(w1, 32);
        if (lane < 16) Y[(size_t)row * W + g * 16 + lane] = w1;
    }
    if (!smp) { const size_t so = (((size_t)b * DEPTH + l) * 2 + dir) * S5G * S5P + (size_t)g * S5P + lane; p.out[O_SR + so] = sr; p.out[O_SI + so] = si; }
}
__device__ __forceinline__ void phase_scans(const Params& p, int l) {
    int tid_ = threadIdx.x; LAUNDER(tid_);
    const int lane = tid_ & 63, gw = blockIdx.x * NWAVES + (tid_ >> 6), nw = gridDim.x * NWAVES;
    constexpr int N_HS = DBATCH * HGH * 4, N_S5S = DBATCH * S5G * 2, N_HC = BATCH * HGH * 4, N_S5C = BATCH * S5G * 2, N_CC = DBATCH * PAST, N_PREP = M * (AQH + 2 * AKVH);
    constexpr int E1 = N_HS, E2 = E1 + N_S5S, E3 = E2 + N_HC, E4 = E3 + N_S5C, E5 = E4 + N_CC, E6 = E5 + N_PREP;
    for (int it = gw; it < E6; it += nw) {
        if (it < E1) c_hgrn(p, l, it, lane);
        else if (it < E2) c_s5(p, l, it - E1, lane);
        else if (it < E3) c_hgrn(p, l, N_HS + (it - E2), lane);
        else if (it < E4) c_s5(p, l, N_S5S + (it - E3), lane);
        else if (it < E5) c_cache_copy(p, l, it - E4, lane);
        else c_attn_prep(p, l, it - E5, lane);
    }
}

__device__ __forceinline__ void d_attn(const Params& p, int item, int lane) {
    constexpr int IT_C = BATCH * AQH * (SEQ / 4);
    const bool smp = item >= IT_C; const int it = smp ? item - IT_C : item;
    const int T = smp ? DSEQ : SEQ, NK = smp ? KVLEN : SEQ;
    const int qg = it % (T / 4), qh = (it / (T / 4)) % AQH, b = it / ((T / 4) * AQH);
    const int kh = qh / 4, sub = lane >> 4, j = lane & 15;
    const int t = qg * 4 + sub, row = (smp ? MP + b * DSEQ : b * SEQ) + t;
    const h16x8 qv = *(const h16x8*)((const h16*)(p.ws + WS_AQ2) + (size_t)row * W + qh * 128 + j * 8);
    float q[8], o[8];
#pragma unroll
    for (int i = 0; i < 8; ++i) { q[i] = (float)qv[i]; o[i] = 0.f; }
    const h16* KB = smp ? (const h16*)(p.ws + WS_KBS) + (size_t)b * KVLEN * KVW : (const h16*)(p.ws + WS_KBC) + (size_t)b * SEQ * KVW;
    const h16* VB = smp ? (const h16*)(p.ws + WS_VBS) + (size_t)b * KVLEN * KVW : (const h16*)(p.ws + WS_VBC) + (size_t)b * SEQ * KVW;
    float mx = -1e30f, den = 0.f;
    for (int s = 0; s < NK; ++s) {
        const h16x8 kv = *(const h16x8*)(KB + (size_t)s * KVW + kh * 128 + j * 8);
        float d = 0.f;
#pragma unroll
        for (int i = 0; i < 8; ++i) d += q[i] * (float)kv[i];
        d += __shfl_xor(d, 1); d += __shfl_xor(d, 2); d += __shfl_xor(d, 4); d += __shfl_xor(d, 8);
        const float mn = fmaxf(mx, d), corr = __expf(mx - mn), pe = __expf(d - mn);
        den = den * corr + pe; mx = mn;
        const h16x8 vv = *(const h16x8*)(VB + (size_t)s * KVW + kh * 128 + j * 8);
#pragma unroll
        for (int i = 0; i < 8; ++i) o[i] = o[i] * corr + pe * (float)vv[i];
    }
    const float inv = 1.0f / den;
    const h16x8 ag = *(const h16x8*)((const h16*)(p.ws + WS_Z) + (size_t)row * INC + C_AG + qh * 128 + j * 8);
    h16x8 ov;
#pragma unroll
    for (int i = 0; i < 8; ++i) ov[i] = (h16)(o[i] * inv * (float)ag[i]);
    *(h16x8*)((h16*)(p.ws + WS_OAT) + (size_t)row * W + qh * 128 + j * 8) = ov;
}
__device__ __forceinline__ void d_hgpost(const Params& p, int l, int item, int lane) {
    const int row = item / HGH, h = item % HGH;
    const size_t o0 = (size_t)row * W + h * 128;
    const float* OF = (const float*)(p.ws + WS_OF); const float* OB = (const float*)(p.ws + WS_OB);
    const float a0 = OF[o0 + lane] + OB[o0 + lane], a1 = OF[o0 + lane + 64] + OB[o0 + lane + 64];
    const float ss = wave_sum(a0 * a0 + a1 * a1);
    const float rstd = rsqrtf(ss * (1.0f / 128.0f) + EPS);
    const float* wn = p.in[I_ONORM] + (size_t)l * 128;
    const h16* gz = (const h16*)(p.ws + WS_Z) + (size_t)row * INC + C_HGG + h * 128;
    h16* dst = (h16*)(p.ws + WS_OHG) + o0;
    dst[lane] = (h16)(a0 * rstd * wn[lane] * (float)gz[lane]); dst[lane + 64] = (h16)(a1 * rstd * wn[lane + 64] * (float)gz[lane + 64]);
}
__device__ __forceinline__ void phase_attn(const Params& p, int l) {
    int tid_ = threadIdx.x; LAUNDER(tid_);
    const int lane = tid_ & 63, gw = blockIdx.x * NWAVES + (tid_ >> 6), nw = gridDim.x * NWAVES;
    constexpr int N_AS = DBATCH * AQH * (DSEQ / 4), N_AC = BATCH * AQH * (SEQ / 4), N_HP = M * HGH;
    for (int it = gw; it < N_AS + N_AC + N_HP; it += nw) {
        if (it < N_AS) d_attn(p, N_AC + it, lane);
        else if (it < N_AS + N_AC) d_attn(p, it - N_AS, lane);
        else d_hgpost(p, l, it - N_AS - N_AC, lane);
    }
    const float* YF = (const float*)(p.ws + WS_YF); const float* YB = (const float*)(p.ws + WS_YB); const h16* Z = (const h16*)(p.ws + WS_Z);
    const float* dd = p.in[I_S5D] + (size_t)l * W; h16* YS = (h16*)(p.ws + WS_YS);
    for (size_t i = ((size_t)blockIdx.x * NTHREADS + threadIdx.x) * 4; i < (size_t)M * W; i += (size_t)gridDim.x * NTHREADS * 4) {
        const size_t row = i / W; const int c = (int)(i % W);
        const f32x4 a = *(const f32x4*)(YF + i), b = *(const f32x4*)(YB + i), dv = *(const f32x4*)(dd + c);
        const h16x4 u = *(const h16x4*)(Z + row * INC + C_SU + c);
        h16x4 o;
#pragma unroll
        for (int j = 0; j < 4; ++j) o[j] = (h16)geluf(a[j] + b[j] + dv[j] * (float)u[j]);
        *(h16x4*)(YS + i) = o;
    }
}

constexpr int NPL = 7, PH_FINAL = 1 + DEPTH * NPL, N_PHASES = PH_FINAL + 1;

__global__ void __launch_bounds__(NTHREADS, 2) fwd_kernel(Params p) {
#ifdef HOST_SIM
    unsigned char* lds = sim::cur->blk->lds;
#else
    extern __shared__ __attribute__((aligned(16))) unsigned char lds_raw[];
    LAS unsigned char* lds = (LAS unsigned char*)lds_raw;
#endif
    const int lo = p.ph_lo, hi = p.ph_hi;
#ifndef HOST_SIM
    if (threadIdx.x < 4) ((LAS unsigned*)(lds + MISC_OFF))[threadIdx.x] = 0u;
    __syncthreads();
    XcdBarrier bar; bar.bar = (unsigned*)(p.ws + WS_BAR); bar.x = 0; bar.st = nullptr;
    if (hi - lo > 1) bar = xcd_barrier_post((unsigned*)(p.ws + WS_BAR), (volatile LAS unsigned*)(lds + MISC_OFF));
#else
    XcdBarrier bar{0};
#endif
#define IN(k) (lo <= (k) && (k) < hi)
#define SEAM(k) do { if (IN(k) && IN((k) + 1)) xcd_barrier(bar); } while (0)
    unsigned char* ws = p.ws;
    const int G = gridDim.x, bid = blockIdx.x;
    if (IN(0)) { phase_prologue(p, lds); } SEAM(0);
    for (int l = 0; l < DEPTH; ++l) {
        const int pb = 1 + l * NPL;
        if (IN(pb + 0)) { phase_norm(p, l); } SEAM(pb + 0);
        if (IN(pb + 1)) {
            pg8::Gemm g{(const h16*)(ws + WS_H), (const h16*)(ws + WS_WIN) + (size_t)l * INC * D, 0, 0, M, INC, D};
            pg8::StaticOrder S; S.init(M, INC, G, bid);
            EpiIn E{(h16*)(ws + WS_Z), (float*)(ws + WS_LOGF), (const float*)(ws + WS_LB) + (size_t)l * W};
            pg8::gemm_phase<EpiIn, pg8::StaticOrder>(lds, g, S, E);
        } SEAM(pb + 1);
        if (IN(pb + 2)) { phase_scans(p, l); } SEAM(pb + 2);
        if (IN(pb + 3)) { phase_attn(p, l); } SEAM(pb + 3);
        if (IN(pb + 4)) {
            pg8::Gemm g{(const h16*)(ws + WS_YS), (const h16*)(ws + WS_WGLU) + (size_t)l * W * W, 0, 0, M, W, W};
            pg8::StaticOrder S; S.init(M, W, G, bid);
            EpiGlu E{(const h16*)(ws + WS_YS), (const h16*)(ws + WS_Z), (h16*)(ws + WS_OS5)};
            pg8::gemm_phase<EpiGlu, pg8::StaticOrder>(lds, g, S, E);
        } SEAM(pb + 4);
        if (IN(pb + 5)) {
            const h16* wbr = (const h16*)(ws + WS_WBR) + (size_t)l * 3 * D * W;
            pg8::Gemm g{(const h16*)(ws + WS_OHG), wbr, (size_t)M * W, (size_t)D * W, M, D, W};
            pg8::MultiOrder<3> S; S.init(M, D, G, bid);
            EpiBr E{(const h16*)(ws + WS_Z), (h16*)(ws + WS_MG)};
            pg8::gemm_phase<EpiBr, pg8::MultiOrder<3>>(lds, g, S, E);
        } SEAM(pb + 5);
        if (IN(pb + 6)) {
            pg8::Gemm g{(const h16*)(ws + WS_MG), (const h16*)(ws + WS_WOUT) + (size_t)l * D * D, 0, 0, M, D, D};
            pg8::StaticOrder S; S.init(M, D, G, bid);
            const float* X = (const float*)(ws + WS_X);
            EpiOut E{l == 0 ? p.in[I_XP] : X, l == 0 ? p.in[I_XS] : X + (size_t)MP * D, (float*)(ws + WS_X), (const float*)(ws + WS_MOD) + (size_t)l * NMODR * 3 * D};
            pg8::gemm_phase<EpiOut, pg8::StaticOrder>(lds, g, S, E);
        } SEAM(pb + 6);
    }
    if (IN(PH_FINAL)) { phase_final(p); }
#undef IN
#undef SEAM
}

#ifndef HOST_SIM
extern "C" void kernel_launch(void* const* d_in, const int* in_sizes, int n_in, void* d_out, int out_size, void* d_ws, size_t ws_size, hipStream_t stream) {
    static int grid = 0;
    if (grid == 0) {
        if (n_in != N_IN || (size_t)out_size != O_END || ws_size < WS_END) { grid = -1; return; }
        int dev = 0, cus = 0;
        if (hipGetDevice(&dev) != hipSuccess || hipDeviceGetAttribute(&cus, hipDeviceAttributeMultiprocessorCount, dev) != hipSuccess) { grid = -1; return; }
        if (hipFuncSetAttribute((const void*)fwd_kernel, hipFuncAttributeMaxDynamicSharedMemorySize, LDS_BYTES) != hipSuccess) { grid = -1; return; }
        int per_cu = 0; (void)hipOccupancyMaxActiveBlocksPerMultiprocessor(&per_cu, (const void*)fwd_kernel, NTHREADS, LDS_BYTES); (void)hipGetLastError();
        grid = cus;
    }
    if (grid < 0) return;
    (void)hipMemsetAsync((char*)d_ws + WS_BAR, 0, 16384, stream);
    Params p{};
    for (int i = 0; i < N_IN; ++i) p.in[i] = (const float*)d_in[i];
    p.out = (float*)d_out; p.ws = (unsigned char*)d_ws;
#if N_LAUNCH_MODE == 1
    p.ph_lo = 0; p.ph_hi = N_PHASES;
    hipLaunchKernelGGL(fwd_kernel, dim3(grid), dim3(NTHREADS), LDS_BYTES, stream, p);
#else
    for (int k = 0; k < N_PHASES; ++k) { p.ph_lo = k; p.ph_hi = k + 1; hipLaunchKernelGGL(fwd_kernel, dim3(grid), dim3(NTHREADS), LDS_BYTES, stream, p); }
#endif
}
#endif
```

```cpp
#ifndef HOST_SIM
#include <hip/hip_runtime.h>
#endif

#ifndef CFG_D
#define CFG_D 2048
#define CFG_BATCH 32
#define CFG_SEQ 256
#define CFG_DEPTH 4
#define CFG_DBATCH 8
#define CFG_DSEQ 1024
#define CFG_PAST 256
#endif
#ifndef N_LAUNCH_MODE
#define N_LAUNCH_MODE 1
#endif

constexpr int D = CFG_D, BATCH = CFG_BATCH, SEQ = CFG_SEQ, DEPTH = CFG_DEPTH, DBATCH = CFG_DBATCH, DSEQ = CFG_DSEQ, PAST = CFG_PAST;
constexpr int W = D / 2;
constexpr int HGH = W / 128;
constexpr int AQH = W / 128, AKVH = AQH / 4, KVW = AKVH * 128;
constexpr int S5G = W / 16, S5P = 64;
constexpr int C_HQ = 0, C_HI = W, C_FF = 2 * W, C_FB = 3 * W, C_HGG = 4 * W, C_AQ = 5 * W, C_AK = 6 * W, C_AV = 6 * W + KVW, C_AG = 6 * W + 2 * KVW,
              C_SU = 7 * W + 2 * KVW, C_SG = 8 * W + 2 * KVW, C_MG = 9 * W + 2 * KVW, INC = C_MG + 3 * D;
constexpr int MP = BATCH * SEQ, MS = DBATCH * DSEQ, M = MP + MS;
constexpr int KVLEN = PAST + DSEQ;
constexpr int NMODR = 1 + DBATCH;
constexpr float EPS = 1e-6f;
static_assert(INC % 256 == 0 && MP % 256 == 0 && MS % 256 == 0 && W % 256 == 0, "tile shapes");

typedef _Float16 h16;
typedef h16 h16x8 __attribute__((ext_vector_type(8)));
typedef h16 h16x4 __attribute__((ext_vector_type(4)));
typedef h16 h16x2 __attribute__((ext_vector_type(2)));
typedef float f32x4 __attribute__((ext_vector_type(4)));
typedef float f32x2 __attribute__((ext_vector_type(2)));

constexpr size_t al256(size_t x) { return (x + 255) & ~(size_t)255; }
constexpr size_t WS_BAR = 0;
constexpr size_t WS_MOD = 16384;
constexpr size_t WS_LB = al256(WS_MOD + (size_t)DEPTH * NMODR * 3 * D * 4);
constexpr size_t WS_ABAR = al256(WS_LB + (size_t)2 * DEPTH * W * 4);
constexpr size_t WS_BBAR = al256(WS_ABAR + (size_t)DEPTH * 2 * S5G * S5P * 8);
constexpr size_t WS_WIN = al256(WS_BBAR + (size_t)DEPTH * 2 * S5G * S5P * 32 * 4);
constexpr size_t WS_WGLU = al256(WS_WIN + (size_t)DEPTH * INC * D * 2);
constexpr size_t WS_WBR = al256(WS_WGLU + (size_t)DEPTH * W * W * 2);
constexpr size_t WS_WOUT = al256(WS_WBR + (size_t)DEPTH * 3 * D * W * 2);
constexpr size_t WS_X = al256(WS_WOUT + (size_t)DEPTH * D * D * 2);
constexpr size_t WS_H = al256(WS_X + (size_t)M * D * 4);
constexpr size_t WS_Z = al256(WS_H + (size_t)M * D * 2);
constexpr size_t WS_LOGF = al256(WS_Z + (size_t)M * INC * 2);
constexpr size_t WS_AQ2 = al256(WS_LOGF + (size_t)M * 2 * W * 4);
constexpr size_t WS_KBC = al256(WS_AQ2 + (size_t)M * W * 2);
constexpr size_t WS_VBC = al256(WS_KBC + (size_t)MP * KVW * 2);
constexpr size_t WS_KBS = al256(WS_VBC + (size_t)MP * KVW * 2);
constexpr size_t WS_VBS = al256(WS_KBS + (size_t)DBATCH * KVLEN * KVW * 2);
constexpr size_t WS_OF = al256(WS_VBS + (size_t)DBATCH * KVLEN * KVW * 2);
constexpr size_t WS_OB = al256(WS_OF + (size_t)M * W * 4);
constexpr size_t WS_YF = al256(WS_OB + (size_t)M * W * 4);
constexpr size_t WS_YB = al256(WS_YF + (size_t)M * W * 4);
constexpr size_t WS_OHG = al256(WS_YB + (size_t)M * W * 4);
constexpr size_t WS_OAT = al256(WS_OHG + (size_t)M * W * 2);
constexpr size_t WS_OS5 = al256(WS_OAT + (size_t)M * W * 2);
constexpr size_t WS_YS = al256(WS_OS5 + (size_t)M * W * 2);
constexpr size_t WS_MG = al256(WS_YS + (size_t)M * W * 2);
static_assert(WS_OAT - WS_OHG == (size_t)M * W * 2 && WS_OS5 - WS_OAT == (size_t)M * W * 2, "branch operands must be equally spaced");
constexpr size_t WS_END = al256(WS_MG + (size_t)M * D * 2);

constexpr size_t O_Y = 0;
constexpr size_t O_CK = (size_t)M * D;
constexpr size_t O_CV = O_CK + (size_t)BATCH * DEPTH * SEQ * KVW;
constexpr size_t O_SH = O_CV + (size_t)BATCH * DEPTH * SEQ * KVW;
constexpr size_t O_SR = O_SH + (size_t)BATCH * DEPTH * 2 * HGH * 128 * 128;
constexpr size_t O_SI = O_SR + (size_t)BATCH * DEPTH * 2 * S5G * S5P;
constexpr size_t O_END = O_SI + (size_t)BATCH * DEPTH * 2 * S5G * S5P;

enum { I_XP = 0, I_XS, I_CK, I_CV, I_SH, I_SR, I_SI, I_C, I_CCTX, I_NORMW, I_WMOD, I_BMOD, I_WIN, I_LBL, I_ONORM, I_QNORM, I_KNORM,
       I_ARE, I_AIM, I_LDT, I_BRE, I_BIM, I_CRE, I_CIM, I_S5D, I_WGLU, I_WBRHG, I_WBRAT, I_WBRS5, I_WOUT, I_FNORM, N_IN };

struct Params { const float* in[N_IN]; float* out; unsigned char* ws; int ph_lo, ph_hi; };

constexpr int NTHREADS = 512, NWAVES = 8;
constexpr int STAGE_BYTES = 131072, MISC_OFF = STAGE_BYTES, LDS_BYTES = 147456;

#ifdef HOST_SIM
#define LAS
static inline void sim_glds16(const void* g, void* l) { memcpy((char*)l + sim::cur->lane * 16, g, 16); }
#define GLDS16(g, l) sim_glds16((const void*)(g), (void*)(l))
#define WAIT_V(n) ((void)0)
#define WAIT_L(n) ((void)0)
#define SBAR sim::block_sync()
#define SCHED ((void)0)
#define SETPRIO(x) ((void)0)
#define CFENCE ((void)0)
#define LAUNDER(x) ((void)0)
#define MFMA16(a, b, c) sim::mfma16<1>(&(a), &(b), c)
#define MFMA16K16(a, b, c) sim::mfma16k16_f16(&(a), &(b), c)
static inline float readlane_f(float v, int l) { return sim::shfl<float>(v, l); }
#else
#define LAS __attribute__((address_space(3)))
#define GLDS16(g, l) __builtin_amdgcn_global_load_lds((const unsigned*)(g), (LAS unsigned*)(l), 16, 0, 0)
#define WAIT_V(n) asm volatile("s_waitcnt vmcnt(" #n ")" ::: "memory")
#define WAIT_L(n) asm volatile("s_waitcnt lgkmcnt(" #n ")" ::: "memory")
#define SBAR __builtin_amdgcn_s_barrier()
#define SCHED __builtin_amdgcn_sched_barrier(0)
#define SETPRIO(x) __builtin_amdgcn_s_setprio(x)
#define CFENCE asm volatile("" ::: "memory")
#define LAUNDER(x) asm volatile("" : "+v"(x))
#define MFMA16(a, b, c) __builtin_amdgcn_mfma_f32_16x16x32_f16(a, b, c, 0, 0, 0)
#define MFMA16K16(a, b, c) __builtin_amdgcn_mfma_f32_16x16x16f16(a, b, c, 0, 0, 0)
__device__ __forceinline__ float readlane_f(float v, int l) { return __builtin_bit_cast(float, __builtin_amdgcn_readlane(__builtin_bit_cast(int, v), l)); }
#endif

#ifdef HOST_SIM
#define MFMA32(a, b, c) sim::mfma32<1>(&(a), &(b), c)
#define WAVE_LDS_SYNC() sim::wave_sync()
#define EXP2F(x) exp2f(x)
#define RCPF(x) (1.0f / (x))
static inline void permlane32_swap_u(unsigned a, unsigned b, unsigned& ra, unsigned& rb) { sim_permlane32_swap(a, b, ra, rb); }
#else
#define MFMA32(a, b, c) __builtin_amdgcn_mfma_f32_32x32x16_f16(a, b, c, 0, 0, 0)
#define WAVE_LDS_SYNC() asm volatile("s_waitcnt lgkmcnt(0)" ::: "memory")
#define EXP2F(x) __builtin_amdgcn_exp2f(x)
#define RCPF(x) __builtin_amdgcn_rcpf(x)
__device__ __forceinline__ void permlane32_swap_u(unsigned a, unsigned b, unsigned& ra, unsigned& rb) { auto r = __builtin_amdgcn_permlane32_swap(a, b, false, false); ra = r[0]; rb = r[1]; }
#endif
__device__ __forceinline__ float sigm(float x) { return 1.0f / (1.0f + __expf(-x)); }
__device__ __forceinline__ float siluf(float x) { return x * sigm(x); }
__device__ __forceinline__ float geluf(float x) { const float u = 0.7978845608028654f * (x + 0.044715f * x * x * x); return 0.5f * x * (1.0f + tanhf(u)); }
__device__ __forceinline__ float wave_sum(float v) { v += __shfl_xor(v, 32); v += __shfl_xor(v, 16); v += __shfl_xor(v, 8); v += __shfl_xor(v, 4); v += __shfl_xor(v, 2); v += __shfl_xor(v, 1); return v; }

#ifndef HOST_SIM
#define XB_TMO      128
#define XB_XCNT(j)  (256  + 64 * (j))
#define XB_XSUB(j)  (1280 + 64 * (j))
#define XB_XGEN(j)  (2304 + 64 * (j))
#define XB_TOP      3328
#define XB_TOPGEN   3392
#define XCD_BAR_WORDS 3456
#define XB_SPIN_CAP (1u << 24)
__device__ __forceinline__ unsigned xb_ld(unsigned* p)              { return __hip_atomic_load(p, __ATOMIC_RELAXED, __HIP_MEMORY_SCOPE_AGENT); }
__device__ __forceinline__ unsigned xb_add(unsigned* p, unsigned v) { return __hip_atomic_fetch_add(p, v, __ATOMIC_RELAXED, __HIP_MEMORY_SCOPE_AGENT); }
__device__ __forceinline__ unsigned xb_xcc_id() { return (unsigned)__builtin_amdgcn_s_getreg((3 << 11) | 20) & 0xFu; }
#define XB_SPIN(cond, bar) do { unsigned _sp = 0; while (cond) { __builtin_amdgcn_s_sleep(1); \
    if ((++_sp & 255u) == 0u) { if (xb_ld(&(bar)[XB_TMO])) break; if (_sp > XB_SPIN_CAP) { atomicAdd(&(bar)[XB_TMO], 1u); break; } } } } while (0)
struct XcdBarrier { unsigned* bar; unsigned x; volatile LAS unsigned* st; };
__device__ __forceinline__ XcdBarrier xcd_barrier_post(unsigned* bar, volatile LAS unsigned* st) {
    XcdBarrier b; b.bar = bar; b.x = xb_xcc_id(); b.st = st;
    if (threadIdx.x == 0) (void)xb_add(&bar[XB_XCNT(b.x)], 1u);
    return b;
}
__device__ __forceinline__ void xcd_barrier_complete(unsigned* bar, unsigned x, unsigned& nloc, unsigned& nx) {
    const unsigned G = gridDim.x * gridDim.y * gridDim.z;
    unsigned sum, cnt, mine, sp = 0u;
    for (;;) {
        sum = 0u; cnt = 0u; mine = 0u;
#pragma unroll
        for (unsigned j = 0; j < 16; ++j) { const unsigned c = xb_ld(&bar[XB_XCNT(j)]); sum += c; cnt += (c > 0u) ? 1u : 0u; mine = (j == x) ? c : mine; }
        if (sum == G) break;
        __builtin_amdgcn_s_sleep(1);
        if ((++sp & 255u) == 0u) { if (xb_ld(&bar[XB_TMO])) break; if (sp > XB_SPIN_CAP) { atomicAdd(&bar[XB_TMO], 1u); break; } }
    }
    nloc = mine > 0u ? mine : 1u; nx = cnt > 0u ? cnt : 1u;
}
__device__ __forceinline__ void xcd_barrier(const XcdBarrier& b) {
    asm volatile("s_waitcnt vmcnt(0)" ::: "memory");
    __syncthreads();
    if (threadIdx.x == 0) {
        unsigned* bar = b.bar;
        __builtin_amdgcn_s_waitcnt(0);
        unsigned nloc = b.st[0], nx = b.st[1];
        if (nloc == 0u) { xcd_barrier_complete(bar, b.x, nloc, nx); b.st[0] = nloc; b.st[1] = nx; }
        const unsigned old = xb_add(&bar[XB_XSUB(b.x)], 1u);
        const unsigned gen = old / nloc;
        if (old + 1u == (gen + 1u) * nloc) {
            __builtin_amdgcn_fence(__ATOMIC_RELEASE, "agent");
            asm volatile("s_waitcnt vmcnt(0)" ::: "memory");
            const unsigned og = xb_add(&bar[XB_TOP], 1u);
            const unsigned tg = og / nx;
            if (og + 1u == (tg + 1u) * nx) xb_add(&bar[XB_TOPGEN], 1u);
            else XB_SPIN(xb_ld(&bar[XB_TOPGEN]) == tg, bar);
            __builtin_amdgcn_fence(__ATOMIC_ACQUIRE, "agent");
            xb_add(&bar[XB_XGEN(b.x)], 1u);
            asm volatile("s_waitcnt vmcnt(0)" ::: "memory");
        } else {
            XB_SPIN(xb_ld(&bar[XB_XGEN(b.x)]) == gen, bar);
            __builtin_amdgcn_fence(__ATOMIC_ACQUIRE, "agent");
            asm volatile("s_waitcnt vmcnt(0)" ::: "memory");
        }
    }
    __syncthreads();
}
#else
#define XCD_BAR_WORDS 3456
struct XcdBarrier { int dummy; };
static inline void xcd_barrier(const XcdBarrier&) { sim::grid_sync(); }
#endif

namespace pg8 {
constexpr int BM = 256, BK = 64, HALF = 128, HTB = HALF * BK * 2, NXCD = 8, WGM = 8;
__host__ __device__ __forceinline__ int lds_byte(int r, int c) { const int st = (r >> 4) * 2 + (c >> 5), rr = r & 15, cc = c & 31, ob = rr * 64 + cc * 2; return st * 1024 + (ob ^ (((ob >> 9) & 1) << 5)); }
__host__ __device__ __forceinline__ void stage_rc(int b, int& R, int& C) { const int st = b / 1024, sb = b % 1024, swz = sb ^ (((sb >> 9) & 1) << 5); R = (st >> 1) * 16 + swz / 64; C = (st & 1) * 32 + (swz % 64) / 2; }
__host__ __device__ __forceinline__ int perm32(int rho) { const int n = rho >> 4, i = rho & 15; return 8 * (i >> 2) + 4 * n + (i & 3); }
struct Unit { int pm, pn, sel; };
struct Gemm { const h16* A; const h16* Bt; size_t sa, sb; int M, N, K;
    __device__ __forceinline__ const char* a(int s) const { return (const char*)(A + (size_t)s * sa); }
    __device__ __forceinline__ const char* b(int s) const { return (const char*)(Bt + (size_t)s * sb); } };
struct StaticOrder {
    int nM, nN, nwg, G, c;
    __host__ __device__ void init(int M_, int N_, int G_, int c_) { nM = M_ / BM; nN = N_ / BM; nwg = nM * nN; G = G_; c = c_; }
    __host__ __device__ bool next(int i, Unit& u) const {
        const long L = (long)i * G + c; if (L >= nwg) return false;
        int wgid = (int)L; { const int q = nwg / NXCD, r = nwg % NXCD, xcd = wgid % NXCD, off = wgid / NXCD; wgid = (xcd < r ? xcd * (q + 1) : r * (q + 1) + (xcd - r) * q) + off; }
        const int nig = WGM * nN, gid = wgid / nig, fm = gid * WGM, gsz = (nM - fm) < WGM ? (nM - fm) : WGM;
        u.pm = fm + ((wgid % nig) % gsz); u.pn = (wgid % nig) / gsz; u.sel = 0; return true;
    }
};
template <int NSEL> struct MultiOrder {
    StaticOrder S;
    __host__ __device__ void init(int M_, int N_, int G_, int c_) { S.init(M_, N_, G_, c_); }
    __host__ __device__ bool next(int i, Unit& u) const { const bool ok = S.next(i / NSEL, u); u.sel = i % NSEL; return ok; }
};

template <class Epi, class Sched>
__device__ __forceinline__ void gemm_phase(LAS unsigned char* lds, const Gemm g, const Sched& S, const Epi& E) {
    int tid = threadIdx.x; LAUNDER(tid);
    const int wid = __builtin_amdgcn_readfirstlane(tid >> 6), lane = tid & 63, wr = wid >> 2, wc = wid & 3, fr = lane & 15, fq = lane >> 4;
    const int K = g.K, nt = K / BK;
    unsigned voffA[2], voffB[2];
#pragma unroll
    for (int i = 0; i < 2; ++i) { int R, C; stage_rc(tid * 16 + i * 8192, R, C); const int Rb = Epi::PERM ? ((R & ~31) + perm32(R & 31)) : R;
        voffA[i] = (unsigned)(R * K + C) * 2u; voffB[i] = (unsigned)(Rb * K + C) * 2u; }
    const size_t kstep = (size_t)(BK * 2);
    const size_t hstep = (size_t)HALF * K * 2;
    const size_t tstep = 2 * hstep;
    const unsigned ldsw = (unsigned)wid * 1024u;
    const int aoff = lds_byte(wr * 64 + fr, fq * 8), boff = lds_byte(wc * 32 + fr, fq * 8);
#define PG8_SA(b, h) (((b) * 2 + (h)) * HTB)
#define PG8_SB(b, h) ((4 + (b) * 2 + (h)) * HTB)
#define PG8_STAGE(bufoff, gbase, voff) do { _Pragma("unroll") for (int _i = 0; _i < 2; ++_i) \
        GLDS16((const char*)(gbase) + (voff)[_i], lds + (bufoff) + ldsw + _i * 8192); } while (0)
#define PG8_LDA(dst, b, h) do { _Pragma("unroll") for (int m = 0; m < 4; ++m) _Pragma("unroll") for (int k = 0; k < 2; ++k) dst[m][k] = *(const LAS h16x8*)(lds + PG8_SA(b, h) + aoff + m * 2048 + k * 1024); } while (0)
#define PG8_LDB(dst, b, h) do { _Pragma("unroll") for (int n = 0; n < 2; ++n) _Pragma("unroll") for (int k = 0; k < 2; ++k) dst[n][k] = *(const LAS h16x8*)(lds + PG8_SB(b, h) + boff + n * 2048 + k * 1024); } while (0)
#define PG8_MMA(ai, bj, At, Bt) do { SETPRIO(1); _Pragma("unroll") for (int m = 0; m < 4; ++m) _Pragma("unroll") for (int n = 0; n < 2; ++n) _Pragma("unroll") for (int k = 0; k < 2; ++k) \
        acc[ai][bj][m][n] = MFMA16(Bt[n][k], At[m][k], acc[ai][bj][m][n]); SETPRIO(0); } while (0)
    Unit cur, nxt; int ui = 0;
    if (!S.next(0, cur)) return;
    f32x4 acc[2][2][4][2];
#if defined(HOST_SIM) && defined(SIM_FAST_GEMM)
    for (;; ++ui) {
        if (!S.next(ui, cur)) break;
        const h16* Ap = (const h16*)g.a(cur.sel); const h16* Bp = (const h16*)g.b(cur.sel);
        for (int ai = 0; ai < 2; ++ai) for (int bj = 0; bj < 2; ++bj) for (int m = 0; m < 4; ++m) for (int n = 0; n < 2; ++n) for (int j = 0; j < 4; ++j) {
            const int row = cur.pm * 256 + ai * 128 + wr * 64 + m * 16 + fr;
            const int col = cur.pn * 256 + bj * 128 + wc * 32 + (Epi::PERM ? 8 * fq + 4 * n + j : 16 * n + 4 * fq + j);
            float sacc = 0.f; for (int k = 0; k < K; ++k) sacc += (float)Ap[(size_t)row * K + k] * (float)Bp[(size_t)col * K + k];
            acc[ai][bj][m][n][j] = sacc; }
        E(acc, cur, wr, wc, fr, fq);
    }
    (void)nxt; (void)voffA; (void)voffB; (void)aoff; (void)boff; (void)ldsw; (void)kstep; (void)tstep; (void)nt;
    return;
#endif
#pragma unroll
    for (int a = 0; a < 2; ++a)
#pragma unroll
        for (int b = 0; b < 2; ++b)
#pragma unroll
            for (int m = 0; m < 4; ++m)
#pragma unroll
                for (int n = 0; n < 2; ++n) acc[a][b][m][n] = (f32x4){0.f, 0.f, 0.f, 0.f};
    h16x8 At[4][2], B0[2][2], B1[2][2];
    const char* cA = g.a(cur.sel) + (size_t)cur.pm * tstep; const char* cB = g.b(cur.sel) + (size_t)cur.pn * tstep;
    PG8_STAGE(PG8_SB(0, 0), cB, voffB); PG8_STAGE(PG8_SA(0, 0), cA, voffA); PG8_STAGE(PG8_SB(0, 1), cB + hstep, voffB); PG8_STAGE(PG8_SA(0, 1), cA + hstep, voffA);
    if (wr == 1) SBAR;
    WAIT_V(4); SBAR;
    PG8_STAGE(PG8_SB(1, 0), cB + kstep, voffB); PG8_STAGE(PG8_SA(1, 0), cA + kstep, voffA); PG8_STAGE(PG8_SB(1, 1), cB + hstep + kstep, voffB);
    WAIT_V(6); SBAR;
    for (;;) {
        const bool has_next = S.next(ui + 1, nxt);
        const char* nA = has_next ? g.a(nxt.sel) + (size_t)nxt.pm * tstep : cA; const char* nB = has_next ? g.b(nxt.sel) + (size_t)nxt.pn * tstep : cB;
        for (int t = 0; t < nt; t += 2) {
            const bool last = (t == nt - 2);
            const char* a1 = cA + (size_t)(t + 1) * kstep;
            const char* a2 = last ? nA : cA + (size_t)(t + 2) * kstep; const char* b2 = last ? nB : cB + (size_t)(t + 2) * kstep;
            const char* a3 = a2 + kstep; const char* b3 = b2 + kstep;
            PG8_LDB(B0, 0, 0); SCHED; PG8_LDA(At, 0, 0); PG8_STAGE(PG8_SA(1, 1), a1 + hstep, voffA);
            WAIT_L(8); SBAR; WAIT_L(0); PG8_MMA(0, 0, At, B0); SBAR; SCHED;
            PG8_LDB(B1, 0, 1); PG8_STAGE(PG8_SB(0, 0), b2, voffB);
            SBAR; WAIT_L(0); PG8_MMA(0, 1, At, B1); SBAR;
            PG8_LDA(At, 0, 1); PG8_STAGE(PG8_SA(0, 0), a2, voffA);
            SBAR; WAIT_L(0); PG8_MMA(1, 0, At, B0); SBAR; SCHED;
            PG8_STAGE(PG8_SB(0, 1), b2 + hstep, voffB);
            WAIT_V(6); SBAR; PG8_MMA(1, 1, At, B1); SBAR;
            PG8_LDB(B0, 1, 0); SCHED; PG8_LDA(At, 1, 0); PG8_STAGE(PG8_SA(0, 1), a2 + hstep, voffA);
            WAIT_L(8); SBAR; WAIT_L(0); PG8_MMA(0, 0, At, B0); SBAR; SCHED;
            PG8_LDB(B1, 1, 1); PG8_STAGE(PG8_SB(1, 0), b3, voffB);
            SBAR; WAIT_L(0); PG8_MMA(0, 1, At, B1); SBAR;
            PG8_LDA(At, 1, 1); PG8_STAGE(PG8_SA(1, 0), a3, voffA);
            SBAR; WAIT_L(0); PG8_MMA(1, 0, At, B0); SBAR; SCHED;
            PG8_STAGE(PG8_SB(1, 1), b3 + hstep, voffB);
            WAIT_V(6); SBAR; PG8_MMA(1, 1, At, B1); SBAR;
        }
        E(acc, cur, wr, wc, fr, fq);
        if (!has_next) break;
#pragma unroll
        for (int a = 0; a < 2; ++a)
#pragma unroll
            for (int b = 0; b < 2; ++b)
#pragma unroll
                for (int m = 0; m < 4; ++m)
#pragma unroll
                    for (int n = 0; n < 2; ++n) acc[a][b][m][n] = (f32x4){0.f, 0.f, 0.f, 0.f};
        cur = nxt; cA = nA; cB = nB; ++ui;
    }
    WAIT_V(0);
    if (wr == 0) SBAR;
    SBAR;
#undef PG8_SA
#undef PG8_SB
#undef PG8_STAGE
#undef PG8_LDA
#undef PG8_LDB
#undef PG8_MMA
}
}

__device__ __forceinline__ int mod_row(int row) { return row < MP ? 0 : 1 + (row - MP) / DSEQ; }

struct EpiIn {
    static constexpr bool PERM = true;
    h16* Z; float* LOGF; const float* LB;
    __device__ __forceinline__ void operator()(const f32x4 (&acc)[2][2][4][2], const pg8::Unit& u, int wr, int wc, int fr, int fq) const {
        const int colt = u.pn * 256;
        int kind;
        if (colt < 2 * W) kind = 0; else if (colt < 4 * W) kind = 1; else if (colt < 5 * W) kind = 2; else if (colt < C_AG) kind = 0; else if (colt < C_SU) kind = 2;
        else if (colt < C_SG) kind = 0; else if (colt < C_MG) kind = 2; else kind = 3;
        const int row0 = u.pm * 256 + wr * 64 + fr;
        if (kind == 1) {
            const int dir = colt >= 3 * W ? 1 : 0;
#pragma unroll
            for (int bj = 0; bj < 2; ++bj) {
                const int c0 = colt + bj * 128 + wc * 32 + 8 * fq;
                const float* lbp = LB + (size_t)dir * DEPTH * W + (c0 - (2 + dir) * W);
                const f32x4 l0 = *(const f32x4*)lbp, l1 = *(const f32x4*)(lbp + 4);
#pragma unroll
                for (int ai = 0; ai < 2; ++ai)
#pragma unroll
                    for (int m = 0; m < 4; ++m) {
                        const int row = row0 + ai * 128 + m * 16;
                        f32x4 o0, o1;
#pragma unroll
                        for (int j = 0; j < 4; ++j) { o0[j] = logf(l0[j] + (1.0f - l0[j]) * sigm(acc[ai][bj][m][0][j])); o1[j] = logf(l1[j] + (1.0f - l1[j]) * sigm(acc[ai][bj][m][1][j])); }
                        float* dst = LOGF + (size_t)row * (2 * W) + (c0 - 2 * W);
                        *(f32x4*)dst = o0; *(f32x4*)(dst + 4) = o1;
                    }
            }
            return;
        }
#pragma unroll
        for (int ai = 0; ai < 2; ++ai)
#pragma unroll
            for (int m = 0; m < 4; ++m) {
                const int row = row0 + ai * 128 + m * 16;
#pragma unroll
                for (int bj = 0; bj < 2; ++bj) {
                    const int c0 = colt + bj * 128 + wc * 32 + 8 * fq;
                    h16x8 o;
#pragma unroll
                    for (int j = 0; j < 4; ++j) {
                        float a = acc[ai][bj][m][0][j], b = acc[ai][bj][m][1][j];
                        if (kind == 2) { a = siluf(a); b = siluf(b); } else if (kind == 3) { a = sigm(a); b = sigm(b); }
                        o[j] = (h16)a; o[4 + j] = (h16)b;
                    }
                    *(h16x8*)(Z + (size_t)row * INC + c0) = o;
                }
            }
    }
};
struct EpiGlu {
    static constexpr bool PERM = true;
    const h16* YS; const h16* Z; h16* OS5;
    __device__ __forceinline__ void operator()(const f32x4 (&acc)[2][2][4][2], const pg8::Unit& u, int wr, int wc, int fr, int fq) const {
        const int colt = u.pn * 256, row0 = u.pm * 256 + wr * 64 + fr;
#pragma unroll
        for (int ai = 0; ai < 2; ++ai)
#pragma unroll
            for (int m = 0; m < 4; ++m) {
                const int row = row0 + ai * 128 + m * 16;
#pragma unroll
                for (int bj = 0; bj < 2; ++bj) {
                    const int c0 = colt + bj * 128 + wc * 32 + 8 * fq;
                    const h16x8 ys = *(const h16x8*)(YS + (size_t)row * W + c0), sg = *(const h16x8*)(Z + (size_t)row * INC + C_SG + c0);
                    h16x8 o;
#pragma unroll
                    for (int j = 0; j < 4; ++j) { o[j] = (h16)((float)ys[j] * sigm(acc[ai][bj][m][0][j]) * (float)sg[j]); o[4 + j] = (h16)((float)ys[4 + j] * sigm(acc[ai][bj][m][1][j]) * (float)sg[4 + j]); }
                    *(h16x8*)(OS5 + (size_t)row * W + c0) = o;
                }
                CFENCE;
            }
    }
};
struct EpiBr {
    static constexpr bool PERM = true;
    const h16* Z; h16* MG;
    __device__ __forceinline__ void operator()(const f32x4 (&acc)[2][2][4][2], const pg8::Unit& u, int wr, int wc, int fr, int fq) const {
        const int colt = u.pn * 256, row0 = u.pm * 256 + wr * 64 + fr, b = u.sel;
#pragma unroll
        for (int ai = 0; ai < 2; ++ai)
#pragma unroll
            for (int m = 0; m < 4; ++m) {
                const int row = row0 + ai * 128 + m * 16;
#pragma unroll
                for (int bj = 0; bj < 2; ++bj) {
                    const int c0 = colt + bj * 128 + wc * 32 + 8 * fq;
                    const h16x8 gt = *(const h16x8*)(Z + (size_t)row * INC + C_MG + (size_t)b * D + c0);
                    h16x8 pv = gt; if (b > 0) pv = *(const h16x8*)(MG + (size_t)row * D + c0);
                    h16x8 o;
#pragma unroll
                    for (int j = 0; j < 4; ++j) {
                        float a = (float)gt[j] * acc[ai][bj][m][0][j], c = (float)gt[4 + j] * acc[ai][bj][m][1][j];
                        if (b > 0) { a += (float)pv[j]; c += (float)pv[4 + j]; }
                        o[j] = (h16)a; o[4 + j] = (h16)c;
                    }
                    *(h16x8*)(MG + (size_t)row * D + c0) = o;
                }
                CFENCE;
            }
    }
};
struct EpiOut {
    static constexpr bool PERM = false;
    const float* XP; const float* XS; float* X; const float* MOD;
    __device__ __forceinline__ void operator()(const f32x4 (&acc)[2][2][4][2], const pg8::Unit& u, int wr, int wc, int fr, int fq) const {
        const int colt = u.pn * 256, row0 = u.pm * 256 + wr * 64 + fr;
#pragma unroll
        for (int ai = 0; ai < 2; ++ai)
#pragma unroll
            for (int m = 0; m < 4; ++m) {
                const int row = row0 + ai * 128 + m * 16;
                const float* xin = row < MP ? XP + (size_t)row * D : XS + (size_t)(row - MP) * D;
                const float* gate = MOD + (size_t)mod_row(row) * 3 * D + 2 * D;
#pragma unroll
                for (int bj = 0; bj < 2; ++bj)
#pragma unroll
                    for (int n = 0; n < 2; ++n) {
                        const int c0 = colt + bj * 128 + wc * 32 + 16 * n + 4 * fq;
                        const f32x4 xi = *(const f32x4*)(xin + c0), gv = *(const f32x4*)(gate + c0);
                        *(f32x4*)(X + (size_t)row * D + c0) = xi + gv * acc[ai][bj][m][n];
                    }
                CFENCE;
            }
    }
};

__device__ __forceinline__ void transpose_cvt(LAS float* tile, const float* src, h16* dst, int K, int N, int bid, int G) {
    const int nkt = K / 64, nnt = N / 64, tid = threadIdx.x;
    for (int t = bid; t < nkt * nnt; t += G) {
        const int kt = t / nnt, ntile = t % nnt;
#pragma unroll
        for (int i = 0; i < 8; ++i) { const int idx = tid + i * 512, k = idx >> 6, n = idx & 63; tile[k * 65 + n] = src[(size_t)(kt * 64 + k) * N + ntile * 64 + n]; }
        __syncthreads();
#pragma unroll
        for (int i = 0; i < 8; ++i) { const int idx = tid + i * 512, n = idx >> 6, k = idx & 63; dst[(size_t)(ntile * 64 + n) * K + kt * 64 + k] = (h16)tile[k * 65 + n]; }
        __syncthreads();
    }
}
__device__ __forceinline__ void phase_prologue(const Params& p, LAS unsigned char* lds) {
    const int tid = threadIdx.x, bid = blockIdx.x, G = gridDim.x;
    unsigned char* ws = p.ws;
    {
        const int nitems = DEPTH * (3 * D / 128);
        if (bid < nitems) {
            LAS float* sc = (LAS float*)lds;
            LAS float* red = sc + NMODR * D;
            for (int i = tid; i < NMODR * D; i += NTHREADS) { const int r = i / D, k = i % D; const float c = r == 0 ? p.in[I_CCTX][k] : p.in[I_C][(size_t)(r - 1) * D + k]; sc[i] = siluf(c); }
            __syncthreads();
            for (int it = bid; it < nitems; it += G) {
                const int l = it / (3 * D / 128), j = (it % (3 * D / 128)) * 128 + (tid & 127), kg = tid >> 7;
                float a[NMODR];
#pragma unroll
                for (int r = 0; r < NMODR; ++r) a[r] = 0.f;
                const float* wp = p.in[I_WMOD] + (size_t)l * D * 3 * D + j;
                for (int k = kg * (D / 4); k < (kg + 1) * (D / 4); ++k) { const float w = wp[(size_t)k * 3 * D];
#pragma unroll
                    for (int r = 0; r < NMODR; ++r) a[r] += sc[r * D + k] * w; }
#pragma unroll
                for (int r = 0; r < NMODR; ++r) red[(kg * NMODR + r) * 128 + (tid & 127)] = a[r];
                __syncthreads();
                for (int i = tid; i < NMODR * 128; i += NTHREADS) { const int r = i / 128, jj = i % 128; const int jcol = (it % (3 * D / 128)) * 128 + jj;
                    const float s = red[(0 * NMODR + r) * 128 + jj] + red[(1 * NMODR + r) * 128 + jj] + red[(2 * NMODR + r) * 128 + jj] + red[(3 * NMODR + r) * 128 + jj];
                    ((float*)(ws + WS_MOD))[((size_t)l * NMODR + r) * 3 * D + jcol] = s + p.in[I_BMOD][(size_t)l * 3 * D + jcol]; }
                __syncthreads();
            }
        }
        __syncthreads();
    }
    for (int i = bid * NTHREADS + tid; i < 2 * W; i += G * NTHREADS) {
        const int dir = i / W, w = i % W; const float* lg = p.in[I_LBL] + (size_t)dir * DEPTH * W + w;
        float mx = -1e30f; for (int l = 0; l < DEPTH; ++l) mx = fmaxf(mx, lg[(size_t)l * W]);
        float den = 0.f; for (int l = 0; l < DEPTH; ++l) den += __expf(lg[(size_t)l * W] - mx);
        float cs = 0.f, first = 0.f;
        for (int l = 0; l < DEPTH; ++l) { cs += __expf(lg[(size_t)l * W] - mx) / den; if (l == 0) first = cs; ((float*)(ws + WS_LB))[((size_t)dir * DEPTH + l) * W + w] = cs - first; }
    }
    for (int i = bid * NTHREADS + tid; i < DEPTH * 2 * S5G * S5P; i += G * NTHREADS) {
        const int gidx = i / S5P;
        const float are = p.in[I_ARE][i], aim = p.in[I_AIM][i], dt = __expf(p.in[I_LDT][gidx]);
        const float mag = expf(are * dt), abr = mag * cosf(aim * dt), abi = mag * sinf(aim * dt);
        const float den = are * are + aim * aim, nre = abr - 1.0f;
        const float cre = (nre * are + abi * aim) / den, cim = (abi * are - nre * aim) / den;
        ((f32x2*)(ws + WS_ABAR))[i] = (f32x2){abr, abi};
        float* bb = (float*)(ws + WS_BBAR) + (size_t)i * 32;
        for (int c = 0; c < 16; ++c) { const float br = p.in[I_BRE][(size_t)i * 16 + c], bi = p.in[I_BIM][(size_t)i * 16 + c]; bb[c] = cre * br - cim * bi; bb[16 + c] = cre * bi + cim * br; }
    }
    LAS float* tile = (LAS float*)lds;
    for (int l = 0; l < DEPTH; ++l) {
        transpose_cvt(tile, p.in[I_WIN] + (size_t)l * D * INC, (h16*)(ws + WS_WIN) + (size_t)l * INC * D, D, INC, bid, G);
        transpose_cvt(tile, p.in[I_WGLU] + (size_t)l * W * W, (h16*)(ws + WS_WGLU) + (size_t)l * W * W, W, W, bid, G);
        transpose_cvt(tile, p.in[I_WBRHG] + (size_t)l * W * D, (h16*)(ws + WS_WBR) + (size_t)(l * 3 + 0) * D * W, W, D, bid, G);
        transpose_cvt(tile, p.in[I_WBRAT] + (size_t)l * W * D, (h16*)(ws + WS_WBR) + (size_t)(l * 3 + 1) * D * W, W, D, bid, G);
        transpose_cvt(tile, p.in[I_WBRS5] + (size_t)l * W * D, (h16*)(ws + WS_WBR) + (size_t)(l * 3 + 2) * D * W, W, D, bid, G);
        transpose_cvt(tile, p.in[I_WOUT] + (size_t)l * D * D, (h16*)(ws + WS_WOUT) + (size_t)l * D * D, D, D, bid, G);
    }
}

__device__ __forceinline__ void phase_norm(const Params& p, int l) {
    int tid_ = threadIdx.x; LAUNDER(tid_);
    const int lane = tid_ & 63, gw = blockIdx.x * NWAVES + (tid_ >> 6), nw = gridDim.x * NWAVES;
    const float* nwt = p.in[I_NORMW] + (size_t)l * D;
    const float* MOD = (const float*)(p.ws + WS_MOD) + (size_t)l * NMODR * 3 * D;
    h16* H = (h16*)(p.ws + WS_H);
    for (int row = gw; row < M; row += nw) {
        const float* x = l == 0 ? (row < MP ? p.in[I_XP] + (size_t)row * D : p.in[I_XS] + (size_t)(row - MP) * D) : (const float*)(p.ws + WS_X) + (size_t)row * D;
        f32x4 v[D / 256]; float ss = 0.f;
#pragma unroll
        for (int i = 0; i < D / 256; ++i) { v[i] = *(const f32x4*)(x + i * 256 + lane * 4); ss += v[i][0] * v[i][0] + v[i][1] * v[i][1] + v[i][2] * v[i][2] + v[i][3] * v[i][3]; }
        ss = wave_sum(ss);
        const float rstd = rsqrtf(ss / (float)D + EPS);
        const float* md = MOD + (size_t)mod_row(row) * 3 * D;
#pragma unroll
        for (int i = 0; i < D / 256; ++i) { const int c = i * 256 + lane * 4; const f32x4 wv = *(const f32x4*)(nwt + c), sh = *(const f32x4*)(md + c), scl = *(const f32x4*)(md + D + c);
            h16x4 o;
#pragma unroll
            for (int j = 0; j < 4; ++j) o[j] = (h16)(v[i][j] * rstd * wv[j] * (1.0f + scl[j]) + sh[j]);
            *(h16x4*)(H + (size_t)row * D + c) = o; }
    }
}
__device__ __forceinline__ void phase_final(const Params& p) {
    int tid_ = threadIdx.x; LAUNDER(tid_);
    const int lane = tid_ & 63, gw = blockIdx.x * NWAVES + (tid_ >> 6), nw = gridDim.x * NWAVES;
    const float* fw = p.in[I_FNORM];
    for (int row = gw; row < M; row += nw) {
        const float* x = (const float*)(p.ws + WS_X) + (size_t)row * D;
        f32x4 v[D / 256]; float ss = 0.f;
#pragma unroll
        for (int i = 0; i < D / 256; ++i) { v[i] = *(const f32x4*)(x + i * 256 + lane * 4); ss += v[i][0] * v[i][0] + v[i][1] * v[i][1] + v[i][2] * v[i][2] + v[i][3] * v[i][3]; }
        ss = wave_sum(ss);
        const float rstd = rsqrtf(ss / (float)D + EPS);
#pragma unroll
        for (int i = 0; i < D / 256; ++i) { const int c = i * 256 + lane * 4; const f32x4 wv = *(const f32x4*)(fw + c);
            *(f32x4*)(p.out + O_Y + (size_t)row * D + c) = v[i] * rstd * wv; }
    }
}

__device__ __forceinline__ void c_attn_prep(const Params& p, int l, int item, int lane) {
    constexpr int NS = AQH + 2 * AKVH;
    const int row = item / NS, slot = item % NS;
    const h16* Z = (const h16*)(p.ws + WS_Z) + (size_t)row * INC;
    const bool smp = row >= MP;
    const int b = smp ? (row - MP) / DSEQ : row / SEQ, t = smp ? (row - MP) % DSEQ : row % SEQ;
    if (slot < AQH + AKVH) {
        const bool isq = slot < AQH; const int hh = isq ? slot : slot - AQH;
        const h16* src = Z + (isq ? C_AQ : C_AK) + hh * 128;
        const float* wn = p.in[isq ? I_QNORM : I_KNORM] + (size_t)l * 128;
        float x0 = (float)src[lane], x1 = (float)src[lane + 64];
        const float ss = wave_sum(x0 * x0 + x1 * x1);
        const float rstd = rsqrtf(ss * (1.0f / 128.0f) + EPS);
        x0 = x0 * rstd * wn[lane]; x1 = x1 * rstd * wn[lane + 64];
        if (!isq && !smp) { float* ck = p.out + O_CK + (((size_t)b * DEPTH + l) * SEQ + t) * KVW + hh * 128; ck[lane] = x0; ck[lane + 64] = x1; }
        if (smp) {
            const int j = lane & 31; const float inv = exp2f(-(float)j * (13.287712379549449f / 32.0f));
            const float a0 = (float)(t / 64) * inv, a1 = (float)(t % 64) * inv;
            const float c0 = cosf(a0), s0 = sinf(a0), c1 = cosf(a1), s1 = sinf(a1);
            const float p0 = __shfl_xor(x0, 32), p1 = __shfl_xor(x1, 32);
            x0 = lane < 32 ? x0 * c0 - p0 * s0 : x0 * c0 + p0 * s0;
            x1 = lane < 32 ? x1 * c1 - p1 * s1 : x1 * c1 + p1 * s1;
        }
        if (isq) { h16* dst = (h16*)(p.ws + WS_AQ2) + (size_t)row * W + hh * 128; const float sc = 0.08838834764831845f; dst[lane] = (h16)(x0 * sc); dst[lane + 64] = (h16)(x1 * sc); }
        else { h16* dst = smp ? (h16*)(p.ws + WS_KBS) + ((size_t)b * KVLEN + PAST + t) * KVW + hh * 128 : (h16*)(p.ws + WS_KBC) + ((size_t)b * SEQ + t) * KVW + hh * 128; dst[lane] = (h16)x0; dst[lane + 64] = (h16)x1; }
    } else {
        const int hh = slot - AQH - AKVH; const h16* src = Z + C_AV + hh * 128;
        const h16 v0 = src[lane], v1 = src[lane + 64];
        if (!smp) { float* cv = p.out + O_CV + (((size_t)b * DEPTH + l) * SEQ + t) * KVW + hh * 128; cv[lane] = (float)v0; cv[lane + 64] = (float)v1; }
        if (smp) { h16* dst = (h16*)(p.ws + WS_VBS) + ((size_t)(b * AKVH + hh) * 128) * KVLEN + PAST + t; dst[(size_t)lane * KVLEN] = v0; dst[(size_t)(lane + 64) * KVLEN] = v1; }
        else { h16* dst = (h16*)(p.ws + WS_VBC) + ((size_t)(b * AKVH + hh) * 128) * SEQ + t; dst[(size_t)lane * SEQ] = v0; dst[(size_t)(lane + 64) * SEQ] = v1; }
    }
}
__device__ __forceinline__ void c_cache_copy(const Params& p, int l, int item, int lane) {
    const int b = item / PAST, pos = item % PAST;
    const float* ck = p.in[I_CK] + (((size_t)b * DEPTH + l) * PAST + pos) * KVW; const float* cv = p.in[I_CV] + (((size_t)b * DEPTH + l) * PAST + pos) * KVW;
    h16* kd = (h16*)(p.ws + WS_KBS) + ((size_t)b * KVLEN + pos) * KVW; h16* vd = (h16*)(p.ws + WS_VBS) + (size_t)b * KVW * KVLEN + pos;
    for (int i = lane; i < KVW; i += 64) { kd[i] = (h16)ck[i]; vd[(size_t)i * KVLEN] = (h16)cv[i]; }
}
constexpr int S5_STS = 136, S5_WAVE_LDS = 16 * S5_STS * 2;
struct cpx { float r, i; };
__device__ __forceinline__ cpx cmulf(cpx a, cpx b) { return cpx{a.r * b.r - a.i * b.i, a.r * b.i + a.i * b.r}; }
__device__ __forceinline__ cpx cfma(cpx a, cpx b, cpx c) { return cpx{a.r * b.r - a.i * b.i + c.r, a.r * b.i + a.i * b.r + c.i}; }
__device__ __forceinline__ cpx cshfl_up(cpx v, int d) { return cpx{__shfl_up(v.r, d), __shfl_up(v.i, d)}; }
__device__ __forceinline__ void c_s5(const Params& p, int l, int item, int lane, LAS unsigned char* ldsw) {
    const int dir = item & 1, g = (item >> 1) % S5G, sq = (item >> 1) / S5G;
    const bool smp = sq < DBATCH; const int b = smp ? sq : sq - DBATCH;
    const int T = smp ? DSEQ : SEQ, row0 = smp ? MP + b * DSEQ : b * SEQ;
    const h16* Z = (const h16*)(p.ws + WS_Z);
    float* Y = (float*)(p.ws + (dir ? WS_YB : WS_YF));
    LAS h16* ST = (LAS h16*)ldsw;
    const int lr = lane & 15, q = lane >> 4;
    const size_t pbase = (((size_t)l * 2 + dir) * S5G + g) * S5P;
    cpx a1[4], a4[4], a8[4], apq[4], sp[4];
    h16x4 bre[4], bim[4]; h16x8 cfr[4];
#pragma unroll
    for (int pt = 0; pt < 4; ++pt) {
        const size_t pi = pbase + lr + 16 * pt;
        const f32x2 ab = ((const f32x2*)(p.ws + WS_ABAR))[pi];
        a1[pt] = cpx{ab[0], ab[1]}; const cpx a2 = cmulf(a1[pt], a1[pt]); a4[pt] = cmulf(a2, a2); a8[pt] = cmulf(a4[pt], a4[pt]);
        const cpx a12 = cmulf(a8[pt], a4[pt]), a16 = cmulf(a8[pt], a8[pt]);
        apq[pt] = q == 0 ? a4[pt] : (q == 1 ? a8[pt] : (q == 2 ? a12 : a16));
        const float* bb = (const float*)(p.ws + WS_BBAR) + pi * 32;
        const f32x4 br4 = *(const f32x4*)(bb + 4 * q), bi4 = *(const f32x4*)(bb + 16 + 4 * q);
#pragma unroll
        for (int j = 0; j < 4; ++j) { bre[pt][j] = (h16)br4[j]; bim[pt][j] = (h16)bi4[j]; }
        sp[pt] = cpx{0.f, 0.f};
        if (smp) { const size_t si0 = (((size_t)b * DEPTH + l) * 2 + dir) * S5G * S5P + (size_t)g * S5P + lr + 16 * pt; sp[pt] = cpx{p.in[I_SR][si0], p.in[I_SI][si0]}; }
        CFENCE;
    }
#pragma unroll
    for (int ks = 0; ks < 4; ++ks)
#pragma unroll
        for (int j = 0; j < 8; ++j) { const int pp = 4 * ks + q + 16 * (j >> 1); const size_t ci = (((size_t)l * S5G + g) * 16 + lr) * S5P + pp;
            cfr[ks][j] = (j & 1) ? (h16)(-p.in[I_CIM][ci]) : (h16)p.in[I_CRE][ci]; if (j == 7) CFENCE; }
#pragma unroll 1
    for (int blk = 0; blk < T / 16; ++blk) {
        h16x4 ufr;
        { const int tt = blk * 16 + lr; const int row = row0 + (dir ? T - 1 - tt : tt); ufr = *(const h16x4*)(Z + (size_t)row * INC + C_SU + g * 16 + 4 * q); }
        h16x8 wr[4];
#pragma unroll
        for (int pt = 0; pt < 4; ++pt) {
            f32x4 zr4 = (f32x4){0.f, 0.f, 0.f, 0.f}, zi4 = (f32x4){0.f, 0.f, 0.f, 0.f};
            zr4 = MFMA16K16(ufr, bre[pt], zr4); zi4 = MFMA16K16(ufr, bim[pt], zi4);
            cpx z0 = cpx{zr4[0], zi4[0]};
            cpx z1 = cfma(a1[pt], z0, cpx{zr4[1], zi4[1]});
            cpx z2 = cfma(a1[pt], z1, cpx{zr4[2], zi4[2]});
            cpx z3 = cfma(a1[pt], z2, cpx{zr4[3], zi4[3]});
            cpx e = z3;
            { const cpx er = cshfl_up(e, 16); if (q >= 1) e = cfma(a4[pt], er, e); }
            { const cpx er = cshfl_up(e, 32); if (q >= 2) e = cfma(a8[pt], er, e); }
            const cpx E = cfma(apq[pt], sp[pt], e);
            const cpx Eup = cshfl_up(E, 16);
            cpx cq = q == 0 ? sp[pt] : Eup;
            cq = cmulf(a1[pt], cq); z0.r += cq.r; z0.i += cq.i;
            cq = cmulf(a1[pt], cq); z1.r += cq.r; z1.i += cq.i;
            cq = cmulf(a1[pt], cq); z2.r += cq.r; z2.i += cq.i;
            cq = cmulf(a1[pt], cq); z3.r += cq.r; z3.i += cq.i;
            sp[pt] = cpx{__shfl(E.r, lr + 48), __shfl(E.i, lr + 48)};
            wr[0][2 * pt] = (h16)z0.r; wr[0][2 * pt + 1] = (h16)z0.i; wr[1][2 * pt] = (h16)z1.r; wr[1][2 * pt + 1] = (h16)z1.i;
            wr[2][2 * pt] = (h16)z2.r; wr[2][2 * pt + 1] = (h16)z2.i; wr[3][2 * pt] = (h16)z3.r; wr[3][2 * pt + 1] = (h16)z3.i;
        }
#pragma unroll
        for (int i = 0; i < 4; ++i) *(LAS h16x8*)(ST + (4 * q + i) * S5_STS + 8 * lr) = wr[i];
        WAVE_LDS_SYNC();
        f32x4 acc = (f32x4){0.f, 0.f, 0.f, 0.f};
#pragma unroll
        for (int ks = 0; ks < 4; ++ks) { const h16x8 afr = *(const LAS h16x8*)(ST + lr * S5_STS + 32 * ks + 8 * q); acc = MFMA16(afr, cfr[ks], acc); }
#pragma unroll
        for (int i = 0; i < 4; ++i) { const int tt = blk * 16 + 4 * q + i; const int row = row0 + (dir ? T - 1 - tt : tt); Y[(size_t)row * W + g * 16 + lr] = acc[i]; }
        WAVE_LDS_SYNC();
    }
    if (!smp && q == 0) {
#pragma unroll
        for (int pt = 0; pt < 4; ++pt) { const size_t so = (((size_t)b * DEPTH + l) * 2 + dir) * S5G * S5P + (size_t)g * S5P + lr + 16 * pt; p.out[O_SR + so] = sp[pt].r; p.out[O_SI + so] = sp[pt].i; }
    }
}
typedef __bf16 bf16;
typedef bf16 bf16x8 __attribute__((ext_vector_type(8)));
typedef bf16 bf16x4 __attribute__((ext_vector_type(4)));
#ifdef HOST_SIM
#define MFMA16B(a, b, c) sim::mfma16<0>(&(a), &(b), c)
#else
#define MFMA16B(a, b, c) __builtin_amdgcn_mfma_f32_16x16x32_bf16(a, b, c, 0, 0, 0)
#endif
constexpr int HS_QK = 136, HS_T = 40;
constexpr int HG_QH = 0, HG_KH = HG_QH + 32 * HS_QK * 2, HG_KHT = HG_KH + 32 * HS_QK * 2, HG_VT = HG_KHT + 128 * HS_T * 2, HG_P = HG_VT + 2 * 128 * HS_T * 2,
              HG_SST = HG_P + 2 * 32 * HS_T * 2, HG_END = HG_SST + 128 * HS_QK * 2;
static_assert(HG_END <= STAGE_BYTES, "hgrn LDS");
__device__ __forceinline__ void hgrn_item(const Params& p, int l, int sq, int h, int dir, LAS unsigned char* lds) {
    int tid = threadIdx.x; LAUNDER(tid);
    const int w = tid >> 6, lane = tid & 63, lr = lane & 15, lq = lane >> 4;
    const bool smp = sq < DBATCH; const int b = smp ? sq : sq - DBATCH;
    const int T = smp ? DSEQ : SEQ, row0 = smp ? MP + b * DSEQ : b * SEQ, NC = T / 32;
    const h16* Z = (const h16*)(p.ws + WS_Z); const float* LOGF = (const float*)(p.ws + WS_LOGF);
    float* O = (float*)(p.ws + (dir ? WS_OB : WS_OF));
    LAS bf16* QH = (LAS bf16*)(lds + HG_QH); LAS bf16* KH = (LAS bf16*)(lds + HG_KH); LAS bf16* KHT = (LAS bf16*)(lds + HG_KHT);
    LAS bf16* VT = (LAS bf16*)(lds + HG_VT); LAS bf16* PP = (LAS bf16*)(lds + HG_P); LAS bf16* SST = (LAS bf16*)(lds + HG_SST);
    const int dcol = 16 * w + lr;
    f32x4 S[8];
    if (smp) { const float* s0 = p.in[I_SH] + ((((size_t)b * DEPTH + l) * 2 + dir) * HGH + h) * 128 * 128;
#pragma unroll
        for (int vt = 0; vt < 8; ++vt)
#pragma unroll
            for (int i = 0; i < 4; ++i) S[vt][i] = s0[(size_t)(16 * w + 4 * lq + i) * 128 + 16 * vt + lr]; }
    else {
#pragma unroll
        for (int vt = 0; vt < 8; ++vt) S[vt] = (f32x4){0.f, 0.f, 0.f, 0.f}; }
    float lf[8]; h16 qv[8], vv[8];
#define HG_LOAD(c) do { _Pragma("unroll") for (int i = 0; i < 8; ++i) { const int tt = (c) * 32 + 8 * lq + i; const int row = row0 + (dir ? T - 1 - tt : tt); \
        lf[i] = LOGF[(size_t)row * 2 * W + dir * W + h * 128 + dcol]; qv[i] = Z[(size_t)row * INC + C_HQ + h * 128 + dcol]; vv[i] = Z[(size_t)row * INC + C_HI + h * 128 + dcol]; } } while (0)
    HG_LOAD(0);
    for (int c = 0; c < NC; ++c) {
        const int buf = c & 1;
        float bc[8]; float run = 0.f;
#pragma unroll
        for (int i = 0; i < 8; ++i) { run += lf[i]; bc[i] = run; }
        const float t0 = __shfl(run, lr), t1 = __shfl(run, lr + 16), t2 = __shfl(run, lr + 32), t3 = __shfl(run, lr + 48);
        const float pre = (lq > 0 ? t0 : 0.f) + (lq > 1 ? t1 : 0.f) + (lq > 2 ? t2 : 0.f), bl = (t0 + t1) + (t2 + t3);
        bf16x8 kht, vtv;
#pragma unroll
        for (int i = 0; i < 8; ++i) { const float bi = pre + bc[i]; const float kk = (1.0f - __expf(lf[i])) * __expf(bl - bi), qq = (float)qv[i] * __expf(bi - bl);
            const int t = 8 * lq + i; QH[t * HS_QK + dcol] = (bf16)qq; KH[t * HS_QK + dcol] = (bf16)kk; kht[i] = (bf16)kk; vtv[i] = (bf16)(float)vv[i]; }
        *(LAS bf16x8*)(KHT + dcol * HS_T + 8 * lq) = kht;
        *(LAS bf16x8*)(VT + buf * 128 * HS_T + dcol * HS_T + 8 * lq) = vtv;
        const float ebl = __expf(bl);
#pragma unroll
        for (int i = 0; i < 4; ++i) { const float e = __shfl(ebl, 4 * lq + i);
#pragma unroll
            for (int vt = 0; vt < 8; ++vt) S[vt][i] *= e; }
#pragma unroll
        for (int vt = 0; vt < 8; ++vt) { bf16x4 sv; sv[0] = (bf16)S[vt][0]; sv[1] = (bf16)S[vt][1]; sv[2] = (bf16)S[vt][2]; sv[3] = (bf16)S[vt][3];
            *(LAS bf16x4*)(SST + (16 * vt + lr) * HS_QK + 16 * w + 4 * lq) = sv; }
        if (c + 1 < NC) HG_LOAD(c + 1);
        __syncthreads();
        f32x4 oi[2] = {(f32x4){0.f, 0.f, 0.f, 0.f}, (f32x4){0.f, 0.f, 0.f, 0.f}};
#pragma unroll
        for (int ks = 0; ks < 4; ++ks) { const bf16x8 bfr = *(const LAS bf16x8*)(SST + (16 * w + lr) * HS_QK + 32 * ks + 8 * lq);
#pragma unroll
            for (int ti = 0; ti < 2; ++ti) { const bf16x8 afr = *(const LAS bf16x8*)(QH + (16 * ti + lr) * HS_QK + 32 * ks + 8 * lq); oi[ti] = MFMA16B(afr, bfr, oi[ti]); } }
        if (w < 3) { const int ti = (w + 1) >> 1, si = w >> 1;
            f32x4 sc = (f32x4){0.f, 0.f, 0.f, 0.f};
#pragma unroll
            for (int ks = 0; ks < 4; ++ks) { const bf16x8 afr = *(const LAS bf16x8*)(QH + (16 * ti + lr) * HS_QK + 32 * ks + 8 * lq), bfr = *(const LAS bf16x8*)(KH + (16 * si + lr) * HS_QK + 32 * ks + 8 * lq);
                sc = MFMA16B(afr, bfr, sc); }
#pragma unroll
            for (int i = 0; i < 4; ++i) { const int t = 16 * ti + 4 * lq + i, s_ = 16 * si + lr; PP[buf * 32 * HS_T + t * HS_T + s_] = (bf16)(s_ <= t ? sc[i] : 0.f); }
        } else if (w == 3) {
#pragma unroll
            for (int i = 0; i < 4; ++i) PP[buf * 32 * HS_T + (4 * lq + i) * HS_T + 16 + lr] = (bf16)0.f;
        }
        { const bf16x8 afr = *(const LAS bf16x8*)(KHT + (16 * w + lr) * HS_T + 8 * lq);
#pragma unroll
          for (int vt = 0; vt < 8; ++vt) { const bf16x8 bfr = *(const LAS bf16x8*)(VT + buf * 128 * HS_T + (16 * vt + lr) * HS_T + 8 * lq); S[vt] = MFMA16B(afr, bfr, S[vt]); } }
        __syncthreads();
        { const bf16x8 bfr = *(const LAS bf16x8*)(VT + buf * 128 * HS_T + (16 * w + lr) * HS_T + 8 * lq);
#pragma unroll
          for (int ti = 0; ti < 2; ++ti) { const bf16x8 afr = *(const LAS bf16x8*)(PP + buf * 32 * HS_T + (16 * ti + lr) * HS_T + 8 * lq); oi[ti] = MFMA16B(afr, bfr, oi[ti]); } }
#pragma unroll
        for (int ti = 0; ti < 2; ++ti)
#pragma unroll
            for (int i = 0; i < 4; ++i) { const int tt = c * 32 + 16 * ti + 4 * lq + i; const int row = row0 + (dir ? T - 1 - tt : tt); O[(size_t)row * W + h * 128 + 16 * w + lr] = oi[ti][i]; }
    }
#undef HG_LOAD
    if (!smp) { float* so = p.out + O_SH + ((((size_t)b * DEPTH + l) * 2 + dir) * HGH + h) * 128 * 128;
#pragma unroll
        for (int vt = 0; vt < 8; ++vt)
#pragma unroll
            for (int i = 0; i < 4; ++i) so[(size_t)(16 * w + 4 * lq + i) * 128 + 16 * vt + lr] = S[vt][i]; }
    __syncthreads();
}
__device__ __forceinline__ void phase_scans(const Params& p, int l, LAS unsigned char* lds) {
    int tid_ = threadIdx.x; LAUNDER(tid_);
    const int lane = tid_ & 63, gw = blockIdx.x * NWAVES + (tid_ >> 6), nw = gridDim.x * NWAVES;
    {
        constexpr int NL = DBATCH * HGH * 2, NS = BATCH * HGH * 2;
        const int G = gridDim.x, bid = blockIdx.x;
        for (int it = bid; it < NL; it += G) hgrn_item(p, l, it / (HGH * 2), (it >> 1) % HGH, it & 1, lds);
        if (NL < G) { if (bid >= NL) for (int it = bid - NL; it < NS; it += G - NL) hgrn_item(p, l, DBATCH + it / (HGH * 2), (it >> 1) % HGH, it & 1, lds); }
        else { for (int it = bid; it < NS; it += G) hgrn_item(p, l, DBATCH + it / (HGH * 2), (it >> 1) % HGH, it & 1, lds); }
    }
    constexpr int N_S5S = DBATCH * S5G * 2, N_S5C = BATCH * S5G * 2, N_CC = DBATCH * PAST, N_PREP = M * (AQH + 2 * AKVH);
    constexpr int E2 = N_S5S, E4 = E2 + N_S5C, E5 = E4 + N_CC, E6 = E5 + N_PREP;
    for (int it = gw; it < E6; it += nw) {
        if (it < E4) c_s5(p, l, it, lane, lds + (tid_ >> 6) * S5_WAVE_LDS);
        else if (it < E5) c_cache_copy(p, l, it - E4, lane);
        else c_attn_prep(p, l, it - E5, lane);
    }
}

typedef float f32x16 __attribute__((ext_vector_type(16)));
typedef unsigned u32x4 __attribute__((ext_vector_type(4)));
__device__ __forceinline__ int crow(int r, int hi) { return (r & 3) + 8 * (r >> 2) + 4 * hi; }
__device__ __forceinline__ unsigned cvtpk_h(float lo, float hi) { h16x2 v; v[0] = (h16)lo; v[1] = (h16)hi; return __builtin_bit_cast(unsigned, v); }
constexpr int AT_K = 0, AT_V = 32768, AT_WS = 65536;
__device__ __forceinline__ void attn_unit(const h16* Qb, const h16* Kb, const h16* VTb, int NK, const h16* Gb, h16* Ob, LAS unsigned char* lds) {
    int tid = threadIdx.x; LAUNDER(tid);
    const int wid = tid >> 6, lane = tid & 63, r32 = lane & 31, hi = lane >> 5;
    LAS float* wsf = (LAS float*)(lds + AT_WS) + wid * 64; LAS float* al_l = wsf; LAS float* li_l = wsf + 32;
    constexpr float C = 1.4426950408889634f;
    float m_reg = -1e30f, l_reg = 0.f;
    f32x16 o[4];
#pragma unroll
    for (int d = 0; d < 4; ++d)
#pragma unroll
        for (int r = 0; r < 16; ++r) o[d][r] = 0.f;
    h16x8 qr[8];
    { const h16* Qw = Qb + (size_t)(wid * 32 + r32) * W + hi * 8;
#pragma unroll
      for (int d0 = 0; d0 < 8; ++d0) qr[d0] = *(const h16x8*)(Qw + d0 * 16); }
    const int kr_ = tid >> 4, kc_ = tid & 15, vr_ = tid >> 3, vc_ = tid & 7;
    const int kst0 = kr_ * 256 + ((kc_ * 16) ^ ((kr_ & 15) << 4)), kst1 = (kr_ + 32) * 256 + ((kc_ * 16) ^ (((kr_ + 32) & 15) << 4));
    const int vst0 = vr_ * 128 + ((vc_ * 16) ^ (((vr_ >> 1) & 7) << 4)), vst1 = (vr_ + 64) * 128 + ((vc_ * 16) ^ ((((vr_ + 64) >> 1) & 7) << 4));
    const h16* kg0 = Kb + (size_t)kr_ * KVW + kc_ * 8; const h16* kg1 = Kb + (size_t)(kr_ + 32) * KVW + kc_ * 8;
    const h16* vg0 = VTb + (size_t)vr_ * NK + vc_ * 8; const h16* vg1 = VTb + (size_t)(vr_ + 64) * NK + vc_ * 8;
    const int NT = NK / 64;
    h16x8 ka = *(const h16x8*)kg0, kb = *(const h16x8*)kg1, va = *(const h16x8*)vg0, vb = *(const h16x8*)vg1;
    *(LAS h16x8*)(lds + AT_K + kst0) = ka; *(LAS h16x8*)(lds + AT_K + kst1) = kb; *(LAS h16x8*)(lds + AT_V + vst0) = va; *(LAS h16x8*)(lds + AT_V + vst1) = vb;
    __syncthreads();
    for (int j = 0; j < NT; ++j) {
        const int buf = j & 1;
        if (j + 1 < NT) { ka = *(const h16x8*)(kg0 + (size_t)(j + 1) * 64 * KVW); kb = *(const h16x8*)(kg1 + (size_t)(j + 1) * 64 * KVW); va = *(const h16x8*)(vg0 + (j + 1) * 64); vb = *(const h16x8*)(vg1 + (j + 1) * 64); }
        const LAS unsigned char* Kl = lds + AT_K + buf * 16384; const LAS unsigned char* Vl = lds + AT_V + buf * 16384;
        f32x16 p0, p1;
#pragma unroll
        for (int r = 0; r < 16; ++r) { p0[r] = 0.f; p1[r] = 0.f; }
#pragma unroll
        for (int d0 = 0; d0 < 8; ++d0) { const int cb = (d0 * 16 + hi * 8) * 2;
            const h16x8 b0 = *(const LAS h16x8*)(Kl + r32 * 256 + (cb ^ ((r32 & 15) << 4)));
            const h16x8 b1 = *(const LAS h16x8*)(Kl + (32 + r32) * 256 + (cb ^ ((r32 & 15) << 4)));
            p0 = MFMA32(b0, qr[d0], p0); p1 = MFMA32(b1, qr[d0], p1); }
        float pmax = p0[0];
#pragma unroll
        for (int r = 1; r < 16; ++r) pmax = fmaxf(pmax, p0[r]);
#pragma unroll
        for (int r = 0; r < 16; ++r) pmax = fmaxf(pmax, p1[r]);
        { unsigned ra, rb; permlane32_swap_u(__builtin_bit_cast(unsigned, pmax), __builtin_bit_cast(unsigned, pmax), ra, rb); pmax = fmaxf(__builtin_bit_cast(float, ra), __builtin_bit_cast(float, rb)); }
        const float mn = fmaxf(m_reg, pmax), alpha = EXP2F((m_reg - mn) * C), mnC = -mn * C; m_reg = mn;
        float ps = 0.f;
#pragma unroll
        for (int r = 0; r < 16; ++r) { p0[r] = EXP2F(fmaf(p0[r], C, mnC)); p1[r] = EXP2F(fmaf(p1[r], C, mnC)); ps += p0[r] + p1[r]; }
        { unsigned ra, rb; permlane32_swap_u(__builtin_bit_cast(unsigned, ps), __builtin_bit_cast(unsigned, ps), ra, rb); ps = __builtin_bit_cast(float, ra) + __builtin_bit_cast(float, rb); }
        l_reg = l_reg * alpha + ps;
        if (hi == 0) al_l[r32] = alpha;
        WAVE_LDS_SYNC();
#pragma unroll
        for (int r = 0; r < 16; ++r) { const float a = al_l[crow(r, hi)];
#pragma unroll
            for (int d = 0; d < 4; ++d) o[d][r] *= a; }
        WAVE_LDS_SYNC();
        h16x8 pa[4];
#define PK4(P, BASE, OUT) do { const unsigned a0 = cvtpk_h(P[BASE + 0], P[BASE + 1]), a1 = cvtpk_h(P[BASE + 2], P[BASE + 3]), b0_ = cvtpk_h(P[BASE + 4], P[BASE + 5]), b1_ = cvtpk_h(P[BASE + 6], P[BASE + 7]); \
        unsigned r00, r01, r10, r11; permlane32_swap_u(a0, b0_, r00, r01); permlane32_swap_u(a1, b1_, r10, r11); u32x4 w_ = {r00, r10, r01, r11}; OUT = __builtin_bit_cast(h16x8, w_); } while (0)
        PK4(p0, 0, pa[0]); PK4(p0, 8, pa[1]); PK4(p1, 0, pa[2]); PK4(p1, 8, pa[3]);
#undef PK4
#pragma unroll
        for (int d0 = 0; d0 < 4; ++d0) { const int vrow = d0 * 32 + r32;
#pragma unroll
            for (int ks = 0; ks < 4; ++ks) { const int cb = (ks * 16 + hi * 8) * 2;
                const h16x8 vf = *(const LAS h16x8*)(Vl + vrow * 128 + (cb ^ (((vrow >> 1) & 7) << 4)));
                o[d0] = MFMA32(pa[ks], vf, o[d0]); } }
        if (j + 1 < NT) { const int nb = (buf ^ 1) * 16384;
            *(LAS h16x8*)(lds + AT_K + nb + kst0) = ka; *(LAS h16x8*)(lds + AT_K + nb + kst1) = kb; *(LAS h16x8*)(lds + AT_V + nb + vst0) = va; *(LAS h16x8*)(lds + AT_V + nb + vst1) = vb; }
        __syncthreads();
    }
    if (hi == 0) li_l[r32] = l_reg;
    WAVE_LDS_SYNC();
#pragma unroll
    for (int r = 0; r < 16; ++r) { const int orow = wid * 32 + crow(r, hi); const float rl = RCPF(li_l[crow(r, hi)]);
#pragma unroll
        for (int d0 = 0; d0 < 4; ++d0) { const int c = d0 * 32 + r32; Ob[(size_t)orow * W + c] = (h16)(o[d0][r] * rl * (float)Gb[(size_t)orow * INC + c]); } }
    WAVE_LDS_SYNC();
}
__device__ __forceinline__ void d_hgpost(const Params& p, int l, int item, int lane) {
    const int row = item / HGH, h = item % HGH;
    const size_t o0 = (size_t)row * W + h * 128;
    const float* OF = (const float*)(p.ws + WS_OF); const float* OB = (const float*)(p.ws + WS_OB);
    const float a0 = OF[o0 + lane] + OB[o0 + lane], a1 = OF[o0 + lane + 64] + OB[o0 + lane + 64];
    const float ss = wave_sum(a0 * a0 + a1 * a1);
    const float rstd = rsqrtf(ss * (1.0f / 128.0f) + EPS);
    const float* wn = p.in[I_ONORM] + (size_t)l * 128;
    const h16* gz = (const h16*)(p.ws + WS_Z) + (size_t)row * INC + C_HGG + h * 128;
    h16* dst = (h16*)(p.ws + WS_OHG) + o0;
    dst[lane] = (h16)(a0 * rstd * wn[lane] * (float)gz[lane]); dst[lane + 64] = (h16)(a1 * rstd * wn[lane + 64] * (float)gz[lane + 64]);
}
__device__ __forceinline__ void phase_attn(const Params& p, int l, LAS unsigned char* lds) {
    int tid_ = threadIdx.x; LAUNDER(tid_);
    const int lane = tid_ & 63, gw = blockIdx.x * NWAVES + (tid_ >> 6), nw = gridDim.x * NWAVES;
    constexpr int NU_S = DBATCH * AQH * (DSEQ / 256), NU_C = BATCH * AQH * (SEQ / 256);
    for (int u = blockIdx.x; u < NU_S + NU_C; u += gridDim.x) {
        const bool smp = u < NU_S; const int uu = smp ? u : u - NU_S;
        const int T = smp ? DSEQ : SEQ, NK = smp ? KVLEN : SEQ;
        const int qb = uu % (T / 256), qh = (uu / (T / 256)) % AQH, b = uu / ((T / 256) * AQH), kh = qh / 4;
        const int row0 = (smp ? MP + b * DSEQ : b * SEQ) + qb * 256;
        const h16* Kb = (smp ? (const h16*)(p.ws + WS_KBS) : (const h16*)(p.ws + WS_KBC)) + (size_t)b * NK * KVW + kh * 128;
        const h16* VTb = (smp ? (const h16*)(p.ws + WS_VBS) : (const h16*)(p.ws + WS_VBC)) + (size_t)(b * AKVH + kh) * 128 * NK;
        attn_unit((const h16*)(p.ws + WS_AQ2) + (size_t)row0 * W + qh * 128, Kb, VTb, NK, (const h16*)(p.ws + WS_Z) + (size_t)row0 * INC + C_AG + qh * 128,
                  (h16*)(p.ws + WS_OAT) + (size_t)row0 * W + qh * 128, lds);
    }
    constexpr int N_HP = M * HGH;
    for (int it = gw; it < N_HP; it += nw) d_hgpost(p, l, it, lane);
    const float* YF = (const float*)(p.ws + WS_YF); const float* YB = (const float*)(p.ws + WS_YB); const h16* Z = (const h16*)(p.ws + WS_Z);
    const float* dd = p.in[I_S5D] + (size_t)l * W; h16* YS = (h16*)(p.ws + WS_YS);
    for (size_t i = ((size_t)blockIdx.x * NTHREADS + tid_) * 4; i < (size_t)M * W; i += (size_t)gridDim.x * NTHREADS * 4) {
        const size_t row = i / W; const int c = (int)(i % W);
        const f32x4 a = *(const f32x4*)(YF + i), b = *(const f32x4*)(YB + i), dv = *(const f32x4*)(dd + c);
        const h16x4 u = *(const h16x4*)(Z + row * INC + C_SU + c);
        h16x4 o;
#pragma unroll
        for (int j = 0; j < 4; ++j) o[j] = (h16)geluf(a[j] + b[j] + dv[j] * (float)u[j]);
        *(h16x4*)(YS + i) = o;
    }
}

constexpr int NPL = 7, PH_FINAL = 1 + DEPTH * NPL, N_PHASES = PH_FINAL + 1;

__global__ void __launch_bounds__(NTHREADS, 2) fwd_kernel(Params p) {
#ifdef HOST_SIM
    unsigned char* lds = sim::cur->blk->lds;
#else
    extern __shared__ __attribute__((aligned(16))) unsigned char lds_raw[];
    LAS unsigned char* lds = (LAS unsigned char*)lds_raw;
#endif
    const int lo = p.ph_lo, hi = p.ph_hi;
#ifndef HOST_SIM
    if (threadIdx.x < 4) ((LAS unsigned*)(lds + MISC_OFF))[threadIdx.x] = 0u;
    __syncthreads();
    XcdBarrier bar; bar.bar = (unsigned*)(p.ws + WS_BAR); bar.x = 0; bar.st = nullptr;
    if (hi - lo > 1) bar = xcd_barrier_post((unsigned*)(p.ws + WS_BAR), (volatile LAS unsigned*)(lds + MISC_OFF));
#else
    XcdBarrier bar{0};
#endif
#define IN(k) (lo <= (k) && (k) < hi)
#define SEAM(k) do { if (IN(k) && IN((k) + 1)) xcd_barrier(bar); } while (0)
    unsigned char* ws = p.ws;
    const int G = gridDim.x, bid = blockIdx.x;
    if (IN(0)) { phase_prologue(p, lds); } SEAM(0);
    for (int l = 0; l < DEPTH; ++l) {
        const int pb = 1 + l * NPL;
        if (IN(pb + 0)) { phase_norm(p, l); } SEAM(pb + 0);
        if (IN(pb + 1)) {
            pg8::Gemm g{(const h16*)(ws + WS_H), (const h16*)(ws + WS_WIN) + (size_t)l * INC * D, 0, 0, M, INC, D};
            pg8::StaticOrder S; S.init(M, INC, G, bid);
            EpiIn E{(h16*)(ws + WS_Z), (float*)(ws + WS_LOGF), (const float*)(ws + WS_LB) + (size_t)l * W};
            pg8::gemm_phase<EpiIn, pg8::StaticOrder>(lds, g, S, E);
        } SEAM(pb + 1);
        if (IN(pb + 2)) { phase_scans(p, l, lds); } SEAM(pb + 2);
        if (IN(pb + 3)) { phase_attn(p, l, lds); } SEAM(pb + 3);
        if (IN(pb + 4)) {
            pg8::Gemm g{(const h16*)(ws + WS_YS), (const h16*)(ws + WS_WGLU) + (size_t)l * W * W, 0, 0, M, W, W};
            pg8::StaticOrder S; S.init(M, W, G, bid);
            EpiGlu E{(const h16*)(ws + WS_YS), (const h16*)(ws + WS_Z), (h16*)(ws + WS_OS5)};
            pg8::gemm_phase<EpiGlu, pg8::StaticOrder>(lds, g, S, E);
        } SEAM(pb + 4);
        if (IN(pb + 5)) {
            const h16* wbr = (const h16*)(ws + WS_WBR) + (size_t)l * 3 * D * W;
            pg8::Gemm g{(const h16*)(ws + WS_OHG), wbr, (size_t)M * W, (size_t)D * W, M, D, W};
            pg8::MultiOrder<3> S; S.init(M, D, G, bid);
            EpiBr E{(const h16*)(ws + WS_Z), (h16*)(ws + WS_MG)};
            pg8::gemm_phase<EpiBr, pg8::MultiOrder<3>>(lds, g, S, E);
        } SEAM(pb + 5);
        if (IN(pb + 6)) {
            pg8::Gemm g{(const h16*)(ws + WS_MG), (const h16*)(ws + WS_WOUT) + (size_t)l * D * D, 0, 0, M, D, D};
            pg8::StaticOrder S; S.init(M, D, G, bid);
            const float* X = (const float*)(ws + WS_X);
            EpiOut E{l == 0 ? p.in[I_XP] : X, l == 0 ? p.in[I_XS] : X + (size_t)MP * D, (float*)(ws + WS_X), (const float*)(ws + WS_MOD) + (size_t)l * NMODR * 3 * D};
            pg8::gemm_phase<EpiOut, pg8::StaticOrder>(lds, g, S, E);
        } SEAM(pb + 6);
    }
    if (IN(PH_FINAL)) { phase_final(p); }
#undef IN
#undef SEAM
}

#ifndef HOST_SIM
extern "C" void kernel_launch(void* const* d_in, const int* in_sizes, int n_in, void* d_out, int out_size, void* d_ws, size_t ws_size, hipStream_t stream) {
    static int grid = 0;
    if (grid == 0) {
        if (n_in != N_IN || (size_t)out_size != O_END || ws_size < WS_END) { grid = -1; return; }
        int dev = 0, cus = 0;
        if (hipGetDevice(&dev) != hipSuccess || hipDeviceGetAttribute(&cus, hipDeviceAttributeMultiprocessorCount, dev) != hipSuccess) { grid = -1; return; }
        if (hipFuncSetAttribute((const void*)fwd_kernel, hipFuncAttributeMaxDynamicSharedMemorySize, LDS_BYTES) != hipSuccess) { grid = -1; return; }
        int per_cu = 0; (void)hipOccupancyMaxActiveBlocksPerMultiprocessor(&per_cu, (const void*)fwd_kernel, NTHREADS, LDS_BYTES); (void)hipGetLastError();
        grid = cus;
    }
    if (grid < 0) return;
    (void)hipMemsetAsync((char*)d_ws + WS_BAR, 0, 16384, stream);
    Params p{};
    for (int i = 0; i < N_IN; ++i) p.in[i] = (const float*)d_in[i];
    p.out = (float*)d_out; p.ws = (unsigned char*)d_ws;
#if N_LAUNCH_MODE == 1
    p.ph_lo = 0; p.ph_hi = N_PHASES;
    hipLaunchKernelGGL(fwd_kernel, dim3(grid), dim3(NTHREADS), LDS_BYTES, stream, p);
#else
    for (int k = 0; k < N_PHASES; ++k) { p.ph_lo = k; p.ph_hi = k + 1; hipLaunchKernelGGL(fwd_kernel, dim3(grid), dim3(NTHREADS), LDS_BYTES, stream, p); }
#endif
}
#endif
```

```cpp
#ifndef HOST_SIM
#include <hip/hip_runtime.h>
#endif

#ifndef CFG_D
#define CFG_D 2048
#define CFG_BATCH 32
#define CFG_SEQ 256
#define CFG_DEPTH 4
#define CFG_DBATCH 8
#define CFG_DSEQ 1024
#define CFG_PAST 256
#endif
#ifndef PROBE_REP
#define PROBE_REP -1
#endif
#ifndef PROBE_SPIN
#define PROBE_SPIN 0
#endif
#ifndef N_LAUNCH_MODE
#define N_LAUNCH_MODE 1
#endif

constexpr int D = CFG_D, BATCH = CFG_BATCH, SEQ = CFG_SEQ, DEPTH = CFG_DEPTH, DBATCH = CFG_DBATCH, DSEQ = CFG_DSEQ, PAST = CFG_PAST;
constexpr int W = D / 2;
constexpr int HGH = W / 128;
constexpr int AQH = W / 128, AKVH = AQH / 4, KVW = AKVH * 128;
constexpr int S5G = W / 16, S5P = 64;
constexpr int C_HQ = 0, C_HI = W, C_FF = 2 * W, C_FB = 3 * W, C_HGG = 4 * W, C_AQ = 5 * W, C_AK = 6 * W, C_AV = 6 * W + KVW, C_AG = 6 * W + 2 * KVW,
              C_SU = 7 * W + 2 * KVW, C_SG = 8 * W + 2 * KVW, C_MG = 9 * W + 2 * KVW, INC = C_MG + 3 * D;
constexpr int MP = BATCH * SEQ, MS = DBATCH * DSEQ, M = MP + MS;
constexpr int KVLEN = PAST + DSEQ;
constexpr int NMODR = 1 + DBATCH;
constexpr float EPS = 1e-6f;
static_assert(INC % 256 == 0 && MP % 256 == 0 && MS % 256 == 0 && W % 256 == 0, "tile shapes");

typedef _Float16 h16;
typedef h16 h16x8 __attribute__((ext_vector_type(8)));
typedef h16 h16x4 __attribute__((ext_vector_type(4)));
typedef h16 h16x2 __attribute__((ext_vector_type(2)));
typedef float f32x4 __attribute__((ext_vector_type(4)));
typedef float f32x2 __attribute__((ext_vector_type(2)));

constexpr size_t al256(size_t x) { return (x + 255) & ~(size_t)255; }
constexpr size_t WS_BAR = 0;
constexpr size_t WS_MOD = 16384;
constexpr size_t WS_LB = al256(WS_MOD + (size_t)DEPTH * NMODR * 3 * D * 4);
constexpr size_t WS_ABAR = al256(WS_LB + (size_t)2 * DEPTH * W * 4);
constexpr size_t WS_BBAR = al256(WS_ABAR + (size_t)DEPTH * 2 * S5G * S5P * 8);
constexpr size_t WS_ROPE = al256(WS_BBAR + (size_t)DEPTH * 2 * S5G * S5P * 32 * 4);
constexpr size_t WS_WIN = al256(WS_ROPE + (size_t)(DSEQ / 64 + 64) * 32 * 8);
constexpr size_t WS_WGLU = al256(WS_WIN + (size_t)DEPTH * INC * D * 2);
constexpr size_t WS_WBR = al256(WS_WGLU + (size_t)DEPTH * W * W * 2);
constexpr size_t WS_WOUT = al256(WS_WBR + (size_t)DEPTH * 3 * D * W * 2);
constexpr size_t WS_X = al256(WS_WOUT + (size_t)DEPTH * D * D * 2);
constexpr size_t WS_H = al256(WS_X + (size_t)M * D * 4);
constexpr size_t WS_Z = al256(WS_H + (size_t)M * D * 2);
constexpr size_t WS_LOGF = al256(WS_Z + (size_t)M * INC * 2);
constexpr size_t WS_AQ2 = al256(WS_LOGF + (size_t)M * 2 * W * 4);
constexpr size_t WS_KBC = al256(WS_AQ2 + (size_t)M * W * 2);
constexpr size_t WS_VBC = al256(WS_KBC + (size_t)MP * KVW * 2);
constexpr size_t WS_KBS = al256(WS_VBC + (size_t)MP * KVW * 2);
constexpr size_t WS_VBS = al256(WS_KBS + (size_t)DBATCH * KVLEN * KVW * 2);
constexpr size_t WS_OF = al256(WS_VBS + (size_t)DBATCH * KVLEN * KVW * 2);
constexpr size_t WS_OB = al256(WS_OF + (size_t)M * W * 4);
constexpr size_t WS_YF = al256(WS_OB + (size_t)M * W * 4);
constexpr size_t WS_YB = al256(WS_YF + (size_t)M * W * 4);
constexpr size_t WS_OHG = al256(WS_YB + (size_t)M * W * 4);
constexpr size_t WS_OAT = al256(WS_OHG + (size_t)M * W * 2);
constexpr size_t WS_OS5 = al256(WS_OAT + (size_t)M * W * 2);
constexpr size_t WS_YS = al256(WS_OS5 + (size_t)M * W * 2);
constexpr size_t WS_MG = al256(WS_YS + (size_t)M * W * 2);
static_assert(WS_OAT - WS_OHG == (size_t)M * W * 2 && WS_OS5 - WS_OAT == (size_t)M * W * 2, "branch operands must be equally spaced");
constexpr size_t WS_END = al256(WS_MG + (size_t)M * D * 2);

constexpr size_t O_Y = 0;
constexpr size_t O_CK = (size_t)M * D;
constexpr size_t O_CV = O_CK + (size_t)BATCH * DEPTH * SEQ * KVW;
constexpr size_t O_SH = O_CV + (size_t)BATCH * DEPTH * SEQ * KVW;
constexpr size_t O_SR = O_SH + (size_t)BATCH * DEPTH * 2 * HGH * 128 * 128;
constexpr size_t O_SI = O_SR + (size_t)BATCH * DEPTH * 2 * S5G * S5P;
constexpr size_t O_END = O_SI + (size_t)BATCH * DEPTH * 2 * S5G * S5P;

enum { I_XP = 0, I_XS, I_CK, I_CV, I_SH, I_SR, I_SI, I_C, I_CCTX, I_NORMW, I_WMOD, I_BMOD, I_WIN, I_LBL, I_ONORM, I_QNORM, I_KNORM,
       I_ARE, I_AIM, I_LDT, I_BRE, I_BIM, I_CRE, I_CIM, I_S5D, I_WGLU, I_WBRHG, I_WBRAT, I_WBRS5, I_WOUT, I_FNORM, N_IN };

struct Params { const float* in[N_IN]; float* out; unsigned char* ws; int ph_lo, ph_hi; };

constexpr int NTHREADS = 512, NWAVES = 8;
constexpr int STAGE_BYTES = 131072, MISC_OFF = STAGE_BYTES, LDS_BYTES = 147456;

#ifdef HOST_SIM
#define LAS
static inline void sim_glds16(const void* g, void* l) { memcpy((char*)l + sim::cur->lane * 16, g, 16); }
#define GLDS16(g, l) sim_glds16((const void*)(g), (void*)(l))
#define WAIT_V(n) ((void)0)
#define WAIT_L(n) ((void)0)
#define SBAR sim::block_sync()
#define SCHED ((void)0)
#define SETPRIO(x) ((void)0)
#define CFENCE ((void)0)
#define LAUNDER(x) ((void)0)
#define MFMA16(a, b, c) sim::mfma16<1>(&(a), &(b), c)
#define MFMA16K16(a, b, c) sim::mfma16k16_f16(&(a), &(b), c)
static inline float readlane_f(float v, int l) { return sim::shfl<float>(v, l); }
#else
#define LAS __attribute__((address_space(3)))
#define GLDS16(g, l) __builtin_amdgcn_global_load_lds((const unsigned*)(g), (LAS unsigned*)(l), 16, 0, 0)
#define WAIT_V(n) asm volatile("s_waitcnt vmcnt(" #n ")" ::: "memory")
#define WAIT_L(n) asm volatile("s_waitcnt lgkmcnt(" #n ")" ::: "memory")
#define SBAR __builtin_amdgcn_s_barrier()
#define SCHED __builtin_amdgcn_sched_barrier(0)
#define SETPRIO(x) __builtin_amdgcn_s_setprio(x)
#define CFENCE asm volatile("" ::: "memory")
#define LAUNDER(x) asm volatile("" : "+v"(x))
#define MFMA16(a, b, c) __builtin_amdgcn_mfma_f32_16x16x32_f16(a, b, c, 0, 0, 0)
#define MFMA16K16(a, b, c) __builtin_amdgcn_mfma_f32_16x16x16f16(a, b, c, 0, 0, 0)
__device__ __forceinline__ float readlane_f(float v, int l) { return __builtin_bit_cast(float, __builtin_amdgcn_readlane(__builtin_bit_cast(int, v), l)); }
#endif

#ifdef HOST_SIM
#define MFMA32(a, b, c) sim::mfma32<1>(&(a), &(b), c)
#define WAVE_LDS_SYNC() sim::wave_sync()
#define EXP2F(x) exp2f(x)
#define RCPF(x) (1.0f / (x))
static inline void permlane32_swap_u(unsigned a, unsigned b, unsigned& ra, unsigned& rb) { sim_permlane32_swap(a, b, ra, rb); }
#else
#define MFMA32(a, b, c) __builtin_amdgcn_mfma_f32_32x32x16_f16(a, b, c, 0, 0, 0)
#define WAVE_LDS_SYNC() asm volatile("s_waitcnt lgkmcnt(0)" ::: "memory")
#define EXP2F(x) __builtin_amdgcn_exp2f(x)
#define RCPF(x) __builtin_amdgcn_rcpf(x)
__device__ __forceinline__ void permlane32_swap_u(unsigned a, unsigned b, unsigned& ra, unsigned& rb) { auto r = __builtin_amdgcn_permlane32_swap(a, b, false, false); ra = r[0]; rb = r[1]; }
#endif
#if !defined(HOST_SIM) && PROBE_SPIN
#define PSPIN_T0(id) unsigned long long _pt0 = 0; if (PROBE_SPIN == (id) && blockIdx.x == 0 && threadIdx.x == 0) _pt0 = __builtin_amdgcn_s_memrealtime();
#define PSPIN_T1(id, wsp) if (PROBE_SPIN == (id) && blockIdx.x == 0 && threadIdx.x == 0) { const unsigned long long _d = __builtin_amdgcn_s_memrealtime() - _pt0; atomicAdd((unsigned*)(wsp) + 64, (unsigned)_d); }
#else
#define PSPIN_T0(id)
#define PSPIN_T1(id, wsp)
#endif
__device__ __forceinline__ float sigm(float x) { return 1.0f / (1.0f + __expf(-x)); }
__device__ __forceinline__ float siluf(float x) { return x * sigm(x); }
__device__ __forceinline__ float geluf(float x) { const float u = 0.7978845608028654f * (x + 0.044715f * x * x * x); return 0.5f * x * (1.0f + tanhf(u)); }
__device__ __forceinline__ float wave_sum(float v) { v += __shfl_xor(v, 32); v += __shfl_xor(v, 16); v += __shfl_xor(v, 8); v += __shfl_xor(v, 4); v += __shfl_xor(v, 2); v += __shfl_xor(v, 1); return v; }

#ifndef HOST_SIM
#define XB_TMO      128
#define XB_XCNT(j)  (256  + 64 * (j))
#define XB_XSUB(j)  (1280 + 64 * (j))
#define XB_XGEN(j)  (2304 + 64 * (j))
#define XB_TOP      3328
#define XB_TOPGEN   3392
#define XCD_BAR_WORDS 3456
#define XB_SPIN_CAP (1u << 24)
__device__ __forceinline__ unsigned xb_ld(unsigned* p)              { return __hip_atomic_load(p, __ATOMIC_RELAXED, __HIP_MEMORY_SCOPE_AGENT); }
__device__ __forceinline__ unsigned xb_add(unsigned* p, unsigned v) { return __hip_atomic_fetch_add(p, v, __ATOMIC_RELAXED, __HIP_MEMORY_SCOPE_AGENT); }
__device__ __forceinline__ unsigned xb_xcc_id() { return (unsigned)__builtin_amdgcn_s_getreg((3 << 11) | 20) & 0xFu; }
#define XB_SPIN(cond, bar) do { unsigned _sp = 0; while (cond) { __builtin_amdgcn_s_sleep(1); \
    if ((++_sp & 255u) == 0u) { if (xb_ld(&(bar)[XB_TMO])) break; if (_sp > XB_SPIN_CAP) { atomicAdd(&(bar)[XB_TMO], 1u); break; } } } } while (0)
struct XcdBarrier { unsigned* bar; unsigned x; volatile LAS unsigned* st; };
__device__ __forceinline__ XcdBarrier xcd_barrier_post(unsigned* bar, volatile LAS unsigned* st) {
    XcdBarrier b; b.bar = bar; b.x = xb_xcc_id(); b.st = st;
    if (threadIdx.x == 0) (void)xb_add(&bar[XB_XCNT(b.x)], 1u);
    return b;
}
__device__ __forceinline__ void xcd_barrier_complete(unsigned* bar, unsigned x, unsigned& nloc, unsigned& nx) {
    const unsigned G = gridDim.x * gridDim.y * gridDim.z;
    unsigned sum, cnt, mine, sp = 0u;
    for (;;) {
        sum = 0u; cnt = 0u; mine = 0u;
#pragma unroll
        for (unsigned j = 0; j < 16; ++j) { const unsigned c = xb_ld(&bar[XB_XCNT(j)]); sum += c; cnt += (c > 0u) ? 1u : 0u; mine = (j == x) ? c : mine; }
        if (sum == G) break;
        __builtin_amdgcn_s_sleep(1);
        if ((++sp & 255u) == 0u) { if (xb_ld(&bar[XB_TMO])) break; if (sp > XB_SPIN_CAP) { atomicAdd(&bar[XB_TMO], 1u); break; } }
    }
    nloc = mine > 0u ? mine : 1u; nx = cnt > 0u ? cnt : 1u;
}
__device__ __forceinline__ void xcd_barrier(const XcdBarrier& b) {
    asm volatile("s_waitcnt vmcnt(0)" ::: "memory");
    __syncthreads();
    if (threadIdx.x == 0) {
        unsigned* bar = b.bar;
        __builtin_amdgcn_s_waitcnt(0);
        unsigned nloc = b.st[0], nx = b.st[1];
        if (nloc == 0u) { xcd_barrier_complete(bar, b.x, nloc, nx); b.st[0] = nloc; b.st[1] = nx; }
        const unsigned old = xb_add(&bar[XB_XSUB(b.x)], 1u);
        const unsigned gen = old / nloc;
        if (old + 1u == (gen + 1u) * nloc) {
            __builtin_amdgcn_fence(__ATOMIC_RELEASE, "agent");
            asm volatile("s_waitcnt vmcnt(0)" ::: "memory");
            const unsigned og = xb_add(&bar[XB_TOP], 1u);
            const unsigned tg = og / nx;
            if (og + 1u == (tg + 1u) * nx) xb_add(&bar[XB_TOPGEN], 1u);
            else XB_SPIN(xb_ld(&bar[XB_TOPGEN]) == tg, bar);
            __builtin_amdgcn_fence(__ATOMIC_ACQUIRE, "agent");
            xb_add(&bar[XB_XGEN(b.x)], 1u);
            asm volatile("s_waitcnt vmcnt(0)" ::: "memory");
        } else {
            XB_SPIN(xb_ld(&bar[XB_XGEN(b.x)]) == gen, bar);
            __builtin_amdgcn_fence(__ATOMIC_ACQUIRE, "agent");
            asm volatile("s_waitcnt vmcnt(0)" ::: "memory");
        }
    }
    __syncthreads();
}
#else
#define XCD_BAR_WORDS 3456
struct XcdBarrier { int dummy; };
static inline void xcd_barrier(const XcdBarrier&) { sim::grid_sync(); }
#endif

namespace pg8 {
constexpr int BM = 256, BK = 64, HALF = 128, HTB = HALF * BK * 2, NXCD = 8, WGM = 8;
__host__ __device__ __forceinline__ int lds_byte(int r, int c) { const int st = (r >> 4) * 2 + (c >> 5), rr = r & 15, cc = c & 31, ob = rr * 64 + cc * 2; return st * 1024 + (ob ^ (((ob >> 9) & 1) << 5)); }
__host__ __device__ __forceinline__ void stage_rc(int b, int& R, int& C) { const int st = b / 1024, sb = b % 1024, swz = sb ^ (((sb >> 9) & 1) << 5); R = (st >> 1) * 16 + swz / 64; C = (st & 1) * 32 + (swz % 64) / 2; }
__host__ __device__ __forceinline__ int perm32(int rho) { const int n = rho >> 4, i = rho & 15; return 8 * (i >> 2) + 4 * n + (i & 3); }
struct Unit { int pm, pn, sel; };
struct Gemm { const h16* A; const h16* Bt; size_t sa, sb; int M, N, K;
    __device__ __forceinline__ const char* a(int s) const { return (const char*)(A + (size_t)s * sa); }
    __device__ __forceinline__ const char* b(int s) const { return (const char*)(Bt + (size_t)s * sb); } };
struct StaticOrder {
    int nM, nN, nwg, G, c;
    __host__ __device__ void init(int M_, int N_, int G_, int c_) { nM = M_ / BM; nN = N_ / BM; nwg = nM * nN; G = G_; c = c_; }
    __host__ __device__ bool next(int i, Unit& u) const {
        const long L = (long)i * G + c; if (L >= nwg) return false;
        int wgid = (int)L; { const int q = nwg / NXCD, r = nwg % NXCD, xcd = wgid % NXCD, off = wgid / NXCD; wgid = (xcd < r ? xcd * (q + 1) : r * (q + 1) + (xcd - r) * q) + off; }
        const int nig = WGM * nN, gid = wgid / nig, fm = gid * WGM, gsz = (nM - fm) < WGM ? (nM - fm) : WGM;
        u.pm = fm + ((wgid % nig) % gsz); u.pn = (wgid % nig) / gsz; u.sel = 0; return true;
    }
};
template <int NSEL> struct MultiOrder {
    StaticOrder S;
    __host__ __device__ void init(int M_, int N_, int G_, int c_) { S.init(M_, N_, G_, c_); }
    __host__ __device__ bool next(int i, Unit& u) const { const bool ok = S.next(i / NSEL, u); u.sel = i % NSEL; return ok; }
};

template <class Epi, class Sched>
__device__ __forceinline__ void gemm_phase(LAS unsigned char* lds, const Gemm g, const Sched& S, const Epi& E) {
    int tid = threadIdx.x; LAUNDER(tid);
    const int wid = __builtin_amdgcn_readfirstlane(tid >> 6), lane = tid & 63, wr = wid >> 2, wc = wid & 3, fr = lane & 15, fq = lane >> 4;
    const int K = g.K, nt = K / BK;
    unsigned voffA[2], voffB[2];
#pragma unroll
    for (int i = 0; i < 2; ++i) { int R, C; stage_rc(tid * 16 + i * 8192, R, C); const int Rb = Epi::PERM ? ((R & ~31) + perm32(R & 31)) : R;
        voffA[i] = (unsigned)(R * K + C) * 2u; voffB[i] = (unsigned)(Rb * K + C) * 2u; }
    const size_t kstep = (size_t)(BK * 2);
    const size_t hstep = (size_t)HALF * K * 2;
    const size_t tstep = 2 * hstep;
    const unsigned ldsw = (unsigned)wid * 1024u;
    const int aoff = lds_byte(wr * 64 + fr, fq * 8), boff = lds_byte(wc * 32 + fr, fq * 8);
#define PG8_SA(b, h) (((b) * 2 + (h)) * HTB)
#define PG8_SB(b, h) ((4 + (b) * 2 + (h)) * HTB)
#define PG8_STAGE(bufoff, gbase, voff) do { _Pragma("unroll") for (int _i = 0; _i < 2; ++_i) \
        GLDS16((const char*)(gbase) + (voff)[_i], lds + (bufoff) + ldsw + _i * 8192); } while (0)
#define PG8_LDA(dst, b, h) do { _Pragma("unroll") for (int m = 0; m < 4; ++m) _Pragma("unroll") for (int k = 0; k < 2; ++k) dst[m][k] = *(const LAS h16x8*)(lds + PG8_SA(b, h) + aoff + m * 2048 + k * 1024); } while (0)
#define PG8_LDB(dst, b, h) do { _Pragma("unroll") for (int n = 0; n < 2; ++n) _Pragma("unroll") for (int k = 0; k < 2; ++k) dst[n][k] = *(const LAS h16x8*)(lds + PG8_SB(b, h) + boff + n * 2048 + k * 1024); } while (0)
#define PG8_MMA(ai, bj, At, Bt) do { SETPRIO(1); _Pragma("unroll") for (int m = 0; m < 4; ++m) _Pragma("unroll") for (int n = 0; n < 2; ++n) _Pragma("unroll") for (int k = 0; k < 2; ++k) \
        acc[ai][bj][m][n] = MFMA16(Bt[n][k], At[m][k], acc[ai][bj][m][n]); SETPRIO(0); } while (0)
    Unit cur, nxt; int ui = 0;
    if (!S.next(0, cur)) return;
    f32x4 acc[2][2][4][2];
#if defined(HOST_SIM) && defined(SIM_FAST_GEMM)
    for (;; ++ui) {
        if (!S.next(ui, cur)) break;
        const h16* Ap = (const h16*)g.a(cur.sel); const h16* Bp = (const h16*)g.b(cur.sel);
        for (int ai = 0; ai < 2; ++ai) for (int bj = 0; bj < 2; ++bj) for (int m = 0; m < 4; ++m) for (int n = 0; n < 2; ++n) for (int j = 0; j < 4; ++j) {
            const int row = cur.pm * 256 + ai * 128 + wr * 64 + m * 16 + fr;
            const int col = cur.pn * 256 + bj * 128 + wc * 32 + (Epi::PERM ? 8 * fq + 4 * n + j : 16 * n + 4 * fq + j);
            float sacc = 0.f; for (int k = 0; k < K; ++k) sacc += (float)Ap[(size_t)row * K + k] * (float)Bp[(size_t)col * K + k];
            acc[ai][bj][m][n][j] = sacc; }
        E(acc, cur, wr, wc, fr, fq);
    }
    (void)nxt; (void)voffA; (void)voffB; (void)aoff; (void)boff; (void)ldsw; (void)kstep; (void)tstep; (void)nt;
    return;
#endif
#pragma unroll
    for (int a = 0; a < 2; ++a)
#pragma unroll
        for (int b = 0; b < 2; ++b)
#pragma unroll
            for (int m = 0; m < 4; ++m)
#pragma unroll
                for (int n = 0; n < 2; ++n) acc[a][b][m][n] = (f32x4){0.f, 0.f, 0.f, 0.f};
    h16x8 At[4][2], B0[2][2], B1[2][2];
    const char* cA = g.a(cur.sel) + (size_t)cur.pm * tstep; const char* cB = g.b(cur.sel) + (size_t)cur.pn * tstep;
    PG8_STAGE(PG8_SB(0, 0), cB, voffB); PG8_STAGE(PG8_SA(0, 0), cA, voffA); PG8_STAGE(PG8_SB(0, 1), cB + hstep, voffB); PG8_STAGE(PG8_SA(0, 1), cA + hstep, voffA);
    if (wr == 1) SBAR;
    WAIT_V(4); SBAR;
    PG8_STAGE(PG8_SB(1, 0), cB + kstep, voffB); PG8_STAGE(PG8_SA(1, 0), cA + kstep, voffA); PG8_STAGE(PG8_SB(1, 1), cB + hstep + kstep, voffB);
    WAIT_V(6); SBAR;
    for (;;) {
        const bool has_next = S.next(ui + 1, nxt);
        const char* nA = has_next ? g.a(nxt.sel) + (size_t)nxt.pm * tstep : cA; const char* nB = has_next ? g.b(nxt.sel) + (size_t)nxt.pn * tstep : cB;
        for (int t = 0; t < nt; t += 2) {
            const bool last = (t == nt - 2);
            const char* a1 = cA + (size_t)(t + 1) * kstep;
            const char* a2 = last ? nA : cA + (size_t)(t + 2) * kstep; const char* b2 = last ? nB : cB + (size_t)(t + 2) * kstep;
            const char* a3 = a2 + kstep; const char* b3 = b2 + kstep;
            PG8_LDB(B0, 0, 0); SCHED; PG8_LDA(At, 0, 0); PG8_STAGE(PG8_SA(1, 1), a1 + hstep, voffA);
            WAIT_L(8); SBAR; WAIT_L(0); PG8_MMA(0, 0, At, B0); SBAR; SCHED;
            PG8_LDB(B1, 0, 1); PG8_STAGE(PG8_SB(0, 0), b2, voffB);
            SBAR; WAIT_L(0); PG8_MMA(0, 1, At, B1); SBAR;
            PG8_LDA(At, 0, 1); PG8_STAGE(PG8_SA(0, 0), a2, voffA);
            SBAR; WAIT_L(0); PG8_MMA(1, 0, At, B0); SBAR; SCHED;
            PG8_STAGE(PG8_SB(0, 1), b2 + hstep, voffB);
            WAIT_V(6); SBAR; PG8_MMA(1, 1, At, B1); SBAR;
            PG8_LDB(B0, 1, 0); SCHED; PG8_LDA(At, 1, 0); PG8_STAGE(PG8_SA(0, 1), a2 + hstep, voffA);
            WAIT_L(8); SBAR; WAIT_L(0); PG8_MMA(0, 0, At, B0); SBAR; SCHED;
            PG8_LDB(B1, 1, 1); PG8_STAGE(PG8_SB(1, 0), b3, voffB);
            SBAR; WAIT_L(0); PG8_MMA(0, 1, At, B1); SBAR;
            PG8_LDA(At, 1, 1); PG8_STAGE(PG8_SA(1, 0), a3, voffA);
            SBAR; WAIT_L(0); PG8_MMA(1, 0, At, B0); SBAR; SCHED;
            PG8_STAGE(PG8_SB(1, 1), b3 + hstep, voffB);
            WAIT_V(6); SBAR; PG8_MMA(1, 1, At, B1); SBAR;
        }
        E(acc, cur, wr, wc, fr, fq);
        if (!has_next) break;
#pragma unroll
        for (int a = 0; a < 2; ++a)
#pragma unroll
            for (int b = 0; b < 2; ++b)
#pragma unroll
                for (int m = 0; m < 4; ++m)
#pragma unroll
                    for (int n = 0; n < 2; ++n) acc[a][b][m][n] = (f32x4){0.f, 0.f, 0.f, 0.f};
        cur = nxt; cA = nA; cB = nB; ++ui;
    }
    WAIT_V(0);
    if (wr == 0) SBAR;
    SBAR;
#undef PG8_SA
#undef PG8_SB
#undef PG8_STAGE
#undef PG8_LDA
#undef PG8_LDB
#undef PG8_MMA
}
}

__device__ __forceinline__ int mod_row(int row) { return row < MP ? 0 : 1 + (row - MP) / DSEQ; }

struct EpiIn {
    static constexpr bool PERM = true;
    h16* Z; float* LOGF; const float* LB;
    __device__ __forceinline__ void operator()(const f32x4 (&acc)[2][2][4][2], const pg8::Unit& u, int wr, int wc, int fr, int fq) const {
        const int colt = u.pn * 256;
        int kind;
        if (colt < 2 * W) kind = 0; else if (colt < 4 * W) kind = 1; else if (colt < 5 * W) kind = 2; else if (colt < C_AG) kind = 0; else if (colt < C_SU) kind = 2;
        else if (colt < C_SG) kind = 0; else if (colt < C_MG) kind = 2; else kind = 3;
        const int row0 = u.pm * 256 + wr * 64 + fr;
        if (kind == 1) {
            const int dir = colt >= 3 * W ? 1 : 0;
#pragma unroll
            for (int bj = 0; bj < 2; ++bj) {
                const int c0 = colt + bj * 128 + wc * 32 + 8 * fq;
                const float* lbp = LB + (size_t)dir * DEPTH * W + (c0 - (2 + dir) * W);
                const f32x4 l0 = *(const f32x4*)lbp, l1 = *(const f32x4*)(lbp + 4);
#pragma unroll
                for (int ai = 0; ai < 2; ++ai)
#pragma unroll
                    for (int m = 0; m < 4; ++m) {
                        const int row = row0 + ai * 128 + m * 16;
                        f32x4 o0, o1;
#pragma unroll
                        for (int j = 0; j < 4; ++j) { o0[j] = logf(l0[j] + (1.0f - l0[j]) * sigm(acc[ai][bj][m][0][j])); o1[j] = logf(l1[j] + (1.0f - l1[j]) * sigm(acc[ai][bj][m][1][j])); }
                        float* dst = LOGF + (size_t)row * (2 * W) + (c0 - 2 * W);
                        *(f32x4*)dst = o0; *(f32x4*)(dst + 4) = o1;
                    }
            }
            return;
        }
#pragma unroll
        for (int ai = 0; ai < 2; ++ai)
#pragma unroll
            for (int m = 0; m < 4; ++m) {
                const int row = row0 + ai * 128 + m * 16;
#pragma unroll
                for (int bj = 0; bj < 2; ++bj) {
                    const int c0 = colt + bj * 128 + wc * 32 + 8 * fq;
                    h16x8 o;
#pragma unroll
                    for (int j = 0; j < 4; ++j) {
                        float a = acc[ai][bj][m][0][j], b = acc[ai][bj][m][1][j];
                        if (kind == 2) { a = siluf(a); b = siluf(b); } else if (kind == 3) { a = sigm(a); b = sigm(b); }
                        o[j] = (h16)a; o[4 + j] = (h16)b;
                    }
                    *(h16x8*)(Z + (size_t)row * INC + c0) = o;
                }
            }
    }
};
struct EpiGlu {
    static constexpr bool PERM = true;
    const h16* YS; const h16* Z; h16* OS5;
    __device__ __forceinline__ void operator()(const f32x4 (&acc)[2][2][4][2], const pg8::Unit& u, int wr, int wc, int fr, int fq) const {
        const int colt = u.pn * 256, row0 = u.pm * 256 + wr * 64 + fr;
#pragma unroll
        for (int ai = 0; ai < 2; ++ai) {
            h16x8 ys[4][2], sg[4][2];
#pragma unroll
            for (int m = 0; m < 4; ++m)
#pragma unroll
                for (int bj = 0; bj < 2; ++bj) { const int row = row0 + ai * 128 + m * 16, c0 = colt + bj * 128 + wc * 32 + 8 * fq;
                    ys[m][bj] = *(const h16x8*)(YS + (size_t)row * W + c0); sg[m][bj] = *(const h16x8*)(Z + (size_t)row * INC + C_SG + c0); }
#pragma unroll
            for (int m = 0; m < 4; ++m)
#pragma unroll
                for (int bj = 0; bj < 2; ++bj) { const int row = row0 + ai * 128 + m * 16, c0 = colt + bj * 128 + wc * 32 + 8 * fq;
                    h16x8 o;
#pragma unroll
                    for (int j = 0; j < 4; ++j) { o[j] = (h16)((float)ys[m][bj][j] * sigm(acc[ai][bj][m][0][j]) * (float)sg[m][bj][j]); o[4 + j] = (h16)((float)ys[m][bj][4 + j] * sigm(acc[ai][bj][m][1][j]) * (float)sg[m][bj][4 + j]); }
                    *(h16x8*)(OS5 + (size_t)row * W + c0) = o; }
            CFENCE;
        }
    }
};
struct EpiBr {
    static constexpr bool PERM = true;
    const h16* Z; h16* MG;
    __device__ __forceinline__ void operator()(const f32x4 (&acc)[2][2][4][2], const pg8::Unit& u, int wr, int wc, int fr, int fq) const {
        const int colt = u.pn * 256, row0 = u.pm * 256 + wr * 64 + fr, b = u.sel;
#pragma unroll
        for (int ai = 0; ai < 2; ++ai) {
            h16x8 gt[4][2], pv[4][2];
#pragma unroll
            for (int m = 0; m < 4; ++m)
#pragma unroll
                for (int bj = 0; bj < 2; ++bj) { const int row = row0 + ai * 128 + m * 16, c0 = colt + bj * 128 + wc * 32 + 8 * fq;
                    gt[m][bj] = *(const h16x8*)(Z + (size_t)row * INC + C_MG + (size_t)b * D + c0);
                    pv[m][bj] = gt[m][bj]; if (b > 0) pv[m][bj] = *(const h16x8*)(MG + (size_t)row * D + c0); }
#pragma unroll
            for (int m = 0; m < 4; ++m)
#pragma unroll
                for (int bj = 0; bj < 2; ++bj) { const int row = row0 + ai * 128 + m * 16, c0 = colt + bj * 128 + wc * 32 + 8 * fq;
                    h16x8 o;
#pragma unroll
                    for (int j = 0; j < 4; ++j) {
                        float a = (float)gt[m][bj][j] * acc[ai][bj][m][0][j], c = (float)gt[m][bj][4 + j] * acc[ai][bj][m][1][j];
                        if (b > 0) { a += (float)pv[m][bj][j]; c += (float)pv[m][bj][4 + j]; }
                        o[j] = (h16)a; o[4 + j] = (h16)c; }
                    *(h16x8*)(MG + (size_t)row * D + c0) = o; }
            CFENCE;
        }
    }
};
struct EpiOut {
    static constexpr bool PERM = false;
    const float* XP; const float* XS; float* X; const float* MOD;
    __device__ __forceinline__ void operator()(const f32x4 (&acc)[2][2][4][2], const pg8::Unit& u, int wr, int wc, int fr, int fq) const {
        const int colt = u.pn * 256, row0 = u.pm * 256 + wr * 64 + fr;
        const float* gate = MOD + (size_t)mod_row(u.pm * 256) * 3 * D + 2 * D;
        f32x4 gv[2][2];
#pragma unroll
        for (int bj = 0; bj < 2; ++bj)
#pragma unroll
            for (int n = 0; n < 2; ++n) gv[bj][n] = *(const f32x4*)(gate + colt + bj * 128 + wc * 32 + 16 * n + 4 * fq);
#pragma unroll
        for (int ai = 0; ai < 2; ++ai)
#pragma unroll
            for (int mp = 0; mp < 2; ++mp) {
                f32x4 xi[2][2][2];
#pragma unroll
                for (int mm = 0; mm < 2; ++mm) { const int row = row0 + ai * 128 + (mp * 2 + mm) * 16; const float* xin = row < MP ? XP + (size_t)row * D : XS + (size_t)(row - MP) * D;
#pragma unroll
                    for (int bj = 0; bj < 2; ++bj)
#pragma unroll
                        for (int n = 0; n < 2; ++n) xi[mm][bj][n] = *(const f32x4*)(xin + colt + bj * 128 + wc * 32 + 16 * n + 4 * fq); }
#pragma unroll
                for (int mm = 0; mm < 2; ++mm) { const int m = mp * 2 + mm, row = row0 + ai * 128 + m * 16;
#pragma unroll
                    for (int bj = 0; bj < 2; ++bj)
#pragma unroll
                        for (int n = 0; n < 2; ++n) *(f32x4*)(X + (size_t)row * D + colt + bj * 128 + wc * 32 + 16 * n + 4 * fq) = xi[mm][bj][n] + gv[bj][n] * acc[ai][bj][m][n]; }
                CFENCE;
            }
    }
};

__device__ __forceinline__ void transpose_cvt(LAS float* tile, const float* src, h16* dst, int K, int N, int bid, int G) {
    const int nkt = K / 64, nnt = N / 64, tid = threadIdx.x;
    for (int t = bid; t < nkt * nnt; t += G) {
        const int kt = t / nnt, ntile = t % nnt;
#pragma unroll
        for (int i = 0; i < 8; ++i) { const int idx = tid + i * 512, k = idx >> 6, n = idx & 63; tile[k * 65 + n] = src[(size_t)(kt * 64 + k) * N + ntile * 64 + n]; }
        __syncthreads();
#pragma unroll
        for (int i = 0; i < 8; ++i) { const int idx = tid + i * 512, n = idx >> 6, k = idx & 63; dst[(size_t)(ntile * 64 + n) * K + kt * 64 + k] = (h16)tile[k * 65 + n]; }
        __syncthreads();
    }
}
__device__ __forceinline__ void phase_prologue(const Params& p, LAS unsigned char* lds) {
    const int tid = threadIdx.x, bid = blockIdx.x, G = gridDim.x;
    unsigned char* ws = p.ws;
    {
        const int nitems = DEPTH * (3 * D / 128);
        if (bid < nitems) {
            LAS float* sc = (LAS float*)lds;
            LAS float* red = sc + NMODR * D;
            for (int i = tid; i < NMODR * D; i += NTHREADS) { const int r = i / D, k = i % D; const float c = r == 0 ? p.in[I_CCTX][k] : p.in[I_C][(size_t)(r - 1) * D + k]; sc[i] = siluf(c); }
            __syncthreads();
            for (int it = bid; it < nitems; it += G) {
                const int l = it / (3 * D / 128), j = (it % (3 * D / 128)) * 128 + (tid & 127), kg = tid >> 7;
                float a[NMODR];
#pragma unroll
                for (int r = 0; r < NMODR; ++r) a[r] = 0.f;
                const float* wp = p.in[I_WMOD] + (size_t)l * D * 3 * D + j;
                for (int k = kg * (D / 4); k < (kg + 1) * (D / 4); k += 8) { float w8[8];
#pragma unroll
                    for (int kk = 0; kk < 8; ++kk) w8[kk] = wp[(size_t)(k + kk) * 3 * D];
#pragma unroll
                    for (int kk = 0; kk < 8; ++kk)
#pragma unroll
                        for (int r = 0; r < NMODR; ++r) a[r] += sc[r * D + k + kk] * w8[kk]; }
#pragma unroll
                for (int r = 0; r < NMODR; ++r) red[(kg * NMODR + r) * 128 + (tid & 127)] = a[r];
                __syncthreads();
                for (int i = tid; i < NMODR * 128; i += NTHREADS) { const int r = i / 128, jj = i % 128; const int jcol = (it % (3 * D / 128)) * 128 + jj;
                    const float s = red[(0 * NMODR + r) * 128 + jj] + red[(1 * NMODR + r) * 128 + jj] + red[(2 * NMODR + r) * 128 + jj] + red[(3 * NMODR + r) * 128 + jj];
                    ((float*)(ws + WS_MOD))[((size_t)l * NMODR + r) * 3 * D + jcol] = s + p.in[I_BMOD][(size_t)l * 3 * D + jcol]; }
                __syncthreads();
            }
        }
        __syncthreads();
    }
    for (int i = bid * NTHREADS + tid; i < 2 * W; i += G * NTHREADS) {
        const int dir = i / W, w = i % W; const float* lg = p.in[I_LBL] + (size_t)dir * DEPTH * W + w;
        float mx = -1e30f; for (int l = 0; l < DEPTH; ++l) mx = fmaxf(mx, lg[(size_t)l * W]);
        float den = 0.f; for (int l = 0; l < DEPTH; ++l) den += __expf(lg[(size_t)l * W] - mx);
        float cs = 0.f, first = 0.f;
        for (int l = 0; l < DEPTH; ++l) { cs += __expf(lg[(size_t)l * W] - mx) / den; if (l == 0) first = cs; ((float*)(ws + WS_LB))[((size_t)dir * DEPTH + l) * W + w] = cs - first; }
    }
    for (int i = bid * NTHREADS + tid; i < DEPTH * 2 * S5G * S5P; i += G * NTHREADS) {
        const int gidx = i / S5P;
        const float are = p.in[I_ARE][i], aim = p.in[I_AIM][i], dt = __expf(p.in[I_LDT][gidx]);
        const float mag = expf(are * dt), abr = mag * cosf(aim * dt), abi = mag * sinf(aim * dt);
        const float den = are * are + aim * aim, nre = abr - 1.0f;
        const float cre = (nre * are + abi * aim) / den, cim = (abi * are - nre * aim) / den;
        ((f32x2*)(ws + WS_ABAR))[i] = (f32x2){abr, abi};
        float* bb = (float*)(ws + WS_BBAR) + (size_t)i * 32;
        for (int c = 0; c < 16; ++c) { const float br = p.in[I_BRE][(size_t)i * 16 + c], bi = p.in[I_BIM][(size_t)i * 16 + c]; bb[c] = cre * br - cim * bi; bb[16 + c] = cre * bi + cim * br; }
    }
    for (int i = bid * NTHREADS + tid; i < (DSEQ / 64 + 64) * 32; i += G * NTHREADS) {
        const int pos = i / 32, j = i % 32; const float inv = exp2f(-(float)j * (13.287712379549449f / 32.0f));
        const float ang = (float)(pos < DSEQ / 64 ? pos : pos - DSEQ / 64) * inv;
        ((f32x2*)(ws + WS_ROPE))[i] = (f32x2){cosf(ang), sinf(ang)};
    }
    LAS float* tile = (LAS float*)lds;
    for (int l = 0; l < DEPTH; ++l) {
        transpose_cvt(tile, p.in[I_WIN] + (size_t)l * D * INC, (h16*)(ws + WS_WIN) + (size_t)l * INC * D, D, INC, bid, G);
        transpose_cvt(tile, p.in[I_WGLU] + (size_t)l * W * W, (h16*)(ws + WS_WGLU) + (size_t)l * W * W, W, W, bid, G);
        transpose_cvt(tile, p.in[I_WBRHG] + (size_t)l * W * D, (h16*)(ws + WS_WBR) + (size_t)(l * 3 + 0) * D * W, W, D, bid, G);
        transpose_cvt(tile, p.in[I_WBRAT] + (size_t)l * W * D, (h16*)(ws + WS_WBR) + (size_t)(l * 3 + 1) * D * W, W, D, bid, G);
        transpose_cvt(tile, p.in[I_WBRS5] + (size_t)l * W * D, (h16*)(ws + WS_WBR) + (size_t)(l * 3 + 2) * D * W, W, D, bid, G);
        transpose_cvt(tile, p.in[I_WOUT] + (size_t)l * D * D, (h16*)(ws + WS_WOUT) + (size_t)l * D * D, D, D, bid, G);
    }
}

__device__ __forceinline__ void phase_norm(const Params& p, int l) {
    int tid_ = threadIdx.x; LAUNDER(tid_);
    const int lane = tid_ & 63, gw = blockIdx.x * NWAVES + (tid_ >> 6), nw = gridDim.x * NWAVES;
    const float* nwt = p.in[I_NORMW] + (size_t)l * D;
    const float* MOD = (const float*)(p.ws + WS_MOD) + (size_t)l * NMODR * 3 * D;
    h16* H = (h16*)(p.ws + WS_H);
    for (int row = gw; row < M; row += nw) {
        const float* x = l == 0 ? (row < MP ? p.in[I_XP] + (size_t)row * D : p.in[I_XS] + (size_t)(row - MP) * D) : (const float*)(p.ws + WS_X) + (size_t)row * D;
        f32x4 v[D / 256]; float ss = 0.f;
#pragma unroll
        for (int i = 0; i < D / 256; ++i) { v[i] = *(const f32x4*)(x + i * 256 + lane * 4); ss += v[i][0] * v[i][0] + v[i][1] * v[i][1] + v[i][2] * v[i][2] + v[i][3] * v[i][3]; }
        ss = wave_sum(ss);
        const float rstd = rsqrtf(ss / (float)D + EPS);
        const float* md = MOD + (size_t)mod_row(row) * 3 * D;
#pragma unroll
        for (int i = 0; i < D / 256; ++i) { const int c = i * 256 + lane * 4; const f32x4 wv = *(const f32x4*)(nwt + c), sh = *(const f32x4*)(md + c), scl = *(const f32x4*)(md + D + c);
            h16x4 o;
#pragma unroll
            for (int j = 0; j < 4; ++j) o[j] = (h16)(v[i][j] * rstd * wv[j] * (1.0f + scl[j]) + sh[j]);
            *(h16x4*)(H + (size_t)row * D + c) = o; }
    }
}
__device__ __forceinline__ void phase_final(const Params& p) {
    int tid_ = threadIdx.x; LAUNDER(tid_);
    const int lane = tid_ & 63, gw = blockIdx.x * NWAVES + (tid_ >> 6), nw = gridDim.x * NWAVES;
    const float* fw = p.in[I_FNORM];
    for (int row = gw; row < M; row += nw) {
        const float* x = (const float*)(p.ws + WS_X) + (size_t)row * D;
        f32x4 v[D / 256]; float ss = 0.f;
#pragma unroll
        for (int i = 0; i < D / 256; ++i) { v[i] = *(const f32x4*)(x + i * 256 + lane * 4); ss += v[i][0] * v[i][0] + v[i][1] * v[i][1] + v[i][2] * v[i][2] + v[i][3] * v[i][3]; }
        ss = wave_sum(ss);
        const float rstd = rsqrtf(ss / (float)D + EPS);
#pragma unroll
        for (int i = 0; i < D / 256; ++i) { const int c = i * 256 + lane * 4; const f32x4 wv = *(const f32x4*)(fw + c);
            *(f32x4*)(p.out + O_Y + (size_t)row * D + c) = v[i] * rstd * wv; }
    }
}

constexpr int PV_LS = 264;
__device__ __forceinline__ void prep_vt_store(LAS h16* VL, h16* VTrow0, int NKs, int pos0, int tid) {
#pragma unroll
    for (int i = 0; i < KVW * 8 / NTHREADS; ++i) { const int id = tid + NTHREADS * i, dk = id >> 3, tc = id & 7; h16x8 o;
#pragma unroll
        for (int j = 0; j < 8; ++j) o[j] = VL[(tc * 8 + j) * PV_LS + dk];
        *(h16x8*)(VTrow0 + (size_t)dk * NKs + pos0 + tc * 8) = o; }
}
__device__ __forceinline__ void prep_tile(const Params& p, int l, int tile, LAS unsigned char* lds) {
    int tid = threadIdx.x; LAUNDER(tid);
    const int w = tid >> 6, lane = tid & 63;
    LAS h16* VL = (LAS h16*)lds;
    constexpr int NT_REAL = M / 64;
    if (tile >= NT_REAL) {
        const int ct = tile - NT_REAL, b = ct / (PAST / 64), pos0 = (ct % (PAST / 64)) * 64;
        const float* ck = p.in[I_CK] + (((size_t)b * DEPTH + l) * PAST + pos0) * KVW; const float* cv = p.in[I_CV] + (((size_t)b * DEPTH + l) * PAST + pos0) * KVW;
        h16* kd = (h16*)(p.ws + WS_KBS) + ((size_t)b * KVLEN + pos0) * KVW;
#pragma unroll
        for (int i = 0; i < 64 * KVW / 8 / NTHREADS; ++i) { const int id = tid + NTHREADS * i, row = id / (KVW / 8), c = id % (KVW / 8);
            const f32x4 k0 = *(const f32x4*)(ck + (size_t)row * KVW + c * 8), k1 = *(const f32x4*)(ck + (size_t)row * KVW + c * 8 + 4);
            const f32x4 v0 = *(const f32x4*)(cv + (size_t)row * KVW + c * 8), v1 = *(const f32x4*)(cv + (size_t)row * KVW + c * 8 + 4);
            h16x8 ko, vo;
#pragma unroll
            for (int j = 0; j < 4; ++j) { ko[j] = (h16)k0[j]; ko[4 + j] = (h16)k1[j]; vo[j] = (h16)v0[j]; vo[4 + j] = (h16)v1[j]; }
            *(h16x8*)(kd + (size_t)row * KVW + c * 8) = ko; *(LAS h16x8*)(VL + row * PV_LS + c * 8) = vo; }
        __syncthreads();
        prep_vt_store(VL, (h16*)(p.ws + WS_VBS) + (size_t)b * KVW * KVLEN, KVLEN, pos0, tid);
        __syncthreads();
        return;
    }
    const int r0 = tile * 64; const bool smp = r0 >= MP;
    const int b = smp ? (r0 - MP) / DSEQ : r0 / SEQ, t0 = smp ? (r0 - MP) % DSEQ : r0 % SEQ;
    const h16* Z = (const h16*)(p.ws + WS_Z);
#pragma unroll
    for (int i = 0; i < 64 * KVW / 8 / NTHREADS; ++i) { const int id = tid + NTHREADS * i, row = id / (KVW / 8), c = id % (KVW / 8);
        const h16x8 v = *(const h16x8*)(Z + (size_t)(r0 + row) * INC + C_AV + c * 8);
        *(LAS h16x8*)(VL + row * PV_LS + c * 8) = v;
        if (!smp) { float* cvo = p.out + O_CV + (((size_t)b * DEPTH + l) * SEQ + t0 + row) * KVW + c * 8; f32x4 a, bq;
#pragma unroll
            for (int j = 0; j < 4; ++j) { a[j] = (float)v[j]; bq[j] = (float)v[4 + j]; }
            *(f32x4*)cvo = a; *(f32x4*)(cvo + 4) = bq; } }
    __syncthreads();
    if (smp) prep_vt_store(VL, (h16*)(p.ws + WS_VBS) + (size_t)b * KVW * KVLEN, KVLEN, PAST + t0, tid);
    else prep_vt_store(VL, (h16*)(p.ws + WS_VBC) + (size_t)b * KVW * SEQ, SEQ, t0, tid);
    constexpr int NH = AQH + AKVH;
    const float wq0 = p.in[I_QNORM][(size_t)l * 128 + lane], wq1 = p.in[I_QNORM][(size_t)l * 128 + lane + 64], wk0 = p.in[I_KNORM][(size_t)l * 128 + lane], wk1 = p.in[I_KNORM][(size_t)l * 128 + lane + 64];
    const f32x2* ROPE = (const f32x2*)(p.ws + WS_ROPE);
    constexpr int PQN = 16;
    for (int it0 = w; it0 < 64 * NH; it0 += PQN * NWAVES) {
        float x0[PQN], x1[PQN]; f32x2 cr[PQN], cc[PQN];
#pragma unroll
        for (int k = 0; k < PQN; ++k) { const int it = it0 + k * NWAVES; x0[k] = 0.f; x1[k] = 0.f; if (it >= 64 * NH) continue; const int row = it / NH, hh = it % NH; const bool isq = hh < AQH;
            const h16* src = Z + (size_t)(r0 + row) * INC + (isq ? C_AQ + hh * 128 : C_AK + (hh - AQH) * 128);
            x0[k] = (float)src[lane]; x1[k] = (float)src[lane + 64];
            if (smp) { const int t = t0 + row; cr[k] = ROPE[(t / 64) * 32 + (lane & 31)]; cc[k] = ROPE[(DSEQ / 64 + (t % 64)) * 32 + (lane & 31)]; } }
#pragma unroll
        for (int k = 0; k < PQN; ++k) { const int it = it0 + k * NWAVES; if (it >= 64 * NH) continue; const int row = it / NH, hh = it % NH; const bool isq = hh < AQH; const int t = t0 + row;
            const float ss = wave_sum(x0[k] * x0[k] + x1[k] * x1[k]);
            const float rstd = rsqrtf(ss * (1.0f / 128.0f) + EPS);
            float a0 = x0[k] * rstd * (isq ? wq0 : wk0), a1 = x1[k] * rstd * (isq ? wq1 : wk1);
            if (!isq && !smp) { float* cko = p.out + O_CK + (((size_t)b * DEPTH + l) * SEQ + t) * KVW + (hh - AQH) * 128; cko[lane] = a0; cko[lane + 64] = a1; }
            if (smp) { const float p0 = __shfl_xor(a0, 32), p1 = __shfl_xor(a1, 32);
                a0 = lane < 32 ? a0 * cr[k][0] - p0 * cr[k][1] : a0 * cr[k][0] + p0 * cr[k][1];
                a1 = lane < 32 ? a1 * cc[k][0] - p1 * cc[k][1] : a1 * cc[k][0] + p1 * cc[k][1]; }
            if (isq) { h16* dst = (h16*)(p.ws + WS_AQ2) + (size_t)(r0 + row) * W + hh * 128; const float sc = 0.08838834764831845f; dst[lane] = (h16)(a0 * sc); dst[lane + 64] = (h16)(a1 * sc); }
            else { h16* dst = (smp ? (h16*)(p.ws + WS_KBS) + ((size_t)b * KVLEN + PAST + t) * KVW : (h16*)(p.ws + WS_KBC) + ((size_t)b * SEQ + t) * KVW) + (hh - AQH) * 128; dst[lane] = (h16)a0; dst[lane + 64] = (h16)a1; } }
    }
    __syncthreads();
}
constexpr int S5_STS = 136, S5_WAVE_LDS = 16 * S5_STS * 2;
struct cpx { float r, i; };
__device__ __forceinline__ cpx cmulf(cpx a, cpx b) { return cpx{a.r * b.r - a.i * b.i, a.r * b.i + a.i * b.r}; }
__device__ __forceinline__ cpx cfma(cpx a, cpx b, cpx c) { return cpx{a.r * b.r - a.i * b.i + c.r, a.r * b.i + a.i * b.r + c.i}; }
__device__ __forceinline__ cpx cshfl_up(cpx v, int d) { return cpx{__shfl_up(v.r, d), __shfl_up(v.i, d)}; }
__device__ __forceinline__ void c_s5(const Params& p, int l, int item, int lane, LAS unsigned char* ldsw) {
    const int dir = item & 1, g = (item >> 1) % S5G, sq = (item >> 1) / S5G;
    const bool smp = sq < DBATCH; const int b = smp ? sq : sq - DBATCH;
    const int T = smp ? DSEQ : SEQ, row0 = smp ? MP + b * DSEQ : b * SEQ;
    const h16* Z = (const h16*)(p.ws + WS_Z);
    h16* Y = (h16*)(p.ws + (dir ? WS_YB : WS_YF));
    LAS h16* ST = (LAS h16*)ldsw;
    const int lr = lane & 15, q = lane >> 4;
    const size_t pbase = (((size_t)l * 2 + dir) * S5G + g) * S5P;
    cpx a1[4], a4[4], a8[4], apq[4], sp[4], a4m[4], a8m[4];
    h16x4 bre[4], bim[4]; h16x8 cfr[4];
#pragma unroll
    for (int pt = 0; pt < 4; ++pt) {
        const size_t pi = pbase + lr + 16 * pt;
        const f32x2 ab = ((const f32x2*)(p.ws + WS_ABAR))[pi];
        a1[pt] = cpx{ab[0], ab[1]}; const cpx a2 = cmulf(a1[pt], a1[pt]); a4[pt] = cmulf(a2, a2); a8[pt] = cmulf(a4[pt], a4[pt]);
        const cpx a12 = cmulf(a8[pt], a4[pt]), a16 = cmulf(a8[pt], a8[pt]);
        apq[pt] = q == 0 ? a4[pt] : (q == 1 ? a8[pt] : (q == 2 ? a12 : a16));
        a4m[pt] = q >= 1 ? a4[pt] : cpx{0.f, 0.f}; a8m[pt] = q >= 2 ? a8[pt] : cpx{0.f, 0.f};
        const float* bb = (const float*)(p.ws + WS_BBAR) + pi * 32;
        const f32x4 br4 = *(const f32x4*)(bb + 4 * q), bi4 = *(const f32x4*)(bb + 16 + 4 * q);
#pragma unroll
        for (int j = 0; j < 4; ++j) { bre[pt][j] = (h16)br4[j]; bim[pt][j] = (h16)bi4[j]; }
        sp[pt] = cpx{0.f, 0.f};
        if (smp) { const size_t si0 = (((size_t)b * DEPTH + l) * 2 + dir) * S5G * S5P + (size_t)g * S5P + lr + 16 * pt; sp[pt] = cpx{p.in[I_SR][si0], p.in[I_SI][si0]}; }
        CFENCE;
    }
#pragma unroll
    for (int ks = 0; ks < 4; ++ks)
#pragma unroll
        for (int j = 0; j < 8; ++j) { const int pp = 4 * ks + q + 16 * (j >> 1); const size_t ci = (((size_t)l * S5G + g) * 16 + lr) * S5P + pp;
            cfr[ks][j] = (j & 1) ? (h16)(-p.in[I_CIM][ci]) : (h16)p.in[I_CRE][ci]; if (j == 7) CFENCE; }
#define S5_ULOAD(bk) (*(const h16x4*)(Z + (size_t)(row0 + (dir ? T - 1 - ((bk) * 16 + lr) : ((bk) * 16 + lr))) * INC + C_SU + g * 16 + 4 * q))
    const int NB = T / 16;
    h16x4 un1 = S5_ULOAD(0), un2 = S5_ULOAD(1), un3 = S5_ULOAD(2);
#pragma unroll 1
    for (int blk = 0; blk < NB; ++blk) {
        const h16x4 ufr = un1; un1 = un2; un2 = un3; { const int nb = blk + 3 < NB ? blk + 3 : NB - 1; un3 = S5_ULOAD(nb); }
        h16x8 wr[4];
        f32x4 zr4[4], zi4[4]; cpx z0[4], z1[4], z2[4], z3[4], e[4], E[4], er[4];
#pragma unroll
        for (int pt = 0; pt < 4; ++pt) { zr4[pt] = (f32x4){0.f, 0.f, 0.f, 0.f}; zi4[pt] = (f32x4){0.f, 0.f, 0.f, 0.f}; zr4[pt] = MFMA16K16(ufr, bre[pt], zr4[pt]); zi4[pt] = MFMA16K16(ufr, bim[pt], zi4[pt]); }
#pragma unroll
        for (int pt = 0; pt < 4; ++pt) { z0[pt] = cpx{zr4[pt][0], zi4[pt][0]}; z1[pt] = cfma(a1[pt], z0[pt], cpx{zr4[pt][1], zi4[pt][1]});
            z2[pt] = cfma(a1[pt], z1[pt], cpx{zr4[pt][2], zi4[pt][2]}); z3[pt] = cfma(a1[pt], z2[pt], cpx{zr4[pt][3], zi4[pt][3]}); e[pt] = z3[pt]; }
#pragma unroll
        for (int pt = 0; pt < 4; ++pt) er[pt] = cshfl_up(e[pt], 16);
#pragma unroll
        for (int pt = 0; pt < 4; ++pt) e[pt] = cfma(a4m[pt], er[pt], e[pt]);
#pragma unroll
        for (int pt = 0; pt < 4; ++pt) er[pt] = cshfl_up(e[pt], 32);
#pragma unroll
        for (int pt = 0; pt < 4; ++pt) { e[pt] = cfma(a8m[pt], er[pt], e[pt]); E[pt] = cfma(apq[pt], sp[pt], e[pt]); }
#pragma unroll
        for (int pt = 0; pt < 4; ++pt) er[pt] = cshfl_up(E[pt], 16);
#pragma unroll
        for (int pt = 0; pt < 4; ++pt) { cpx cq; cq.r = q == 0 ? sp[pt].r : er[pt].r; cq.i = q == 0 ? sp[pt].i : er[pt].i;
            cq = cmulf(a1[pt], cq); z0[pt].r += cq.r; z0[pt].i += cq.i;
            cq = cmulf(a1[pt], cq); z1[pt].r += cq.r; z1[pt].i += cq.i;
            cq = cmulf(a1[pt], cq); z2[pt].r += cq.r; z2[pt].i += cq.i;
            cq = cmulf(a1[pt], cq); z3[pt].r += cq.r; z3[pt].i += cq.i; }
#pragma unroll
        for (int pt = 0; pt < 4; ++pt) sp[pt] = cpx{__shfl(E[pt].r, lr + 48), __shfl(E[pt].i, lr + 48)};
#pragma unroll
        for (int pt = 0; pt < 4; ++pt) {
            wr[0][2 * pt] = (h16)z0[pt].r; wr[0][2 * pt + 1] = (h16)z0[pt].i; wr[1][2 * pt] = (h16)z1[pt].r; wr[1][2 * pt + 1] = (h16)z1[pt].i;
            wr[2][2 * pt] = (h16)z2[pt].r; wr[2][2 * pt + 1] = (h16)z2[pt].i; wr[3][2 * pt] = (h16)z3[pt].r; wr[3][2 * pt + 1] = (h16)z3[pt].i; }
#pragma unroll
        for (int i = 0; i < 4; ++i) *(LAS h16x8*)(ST + (4 * q + i) * S5_STS + 8 * lr) = wr[i];
        WAVE_LDS_SYNC();
        f32x4 acc = (f32x4){0.f, 0.f, 0.f, 0.f};
#pragma unroll
        for (int ks = 0; ks < 4; ++ks) { const h16x8 afr = *(const LAS h16x8*)(ST + lr * S5_STS + 32 * ks + 8 * q); acc = MFMA16(afr, cfr[ks], acc); }
#pragma unroll
        for (int i = 0; i < 4; ++i) { const int tt = blk * 16 + 4 * q + i; const int row = row0 + (dir ? T - 1 - tt : tt); Y[(size_t)row * W + g * 16 + lr] = (h16)acc[i]; }
        WAVE_LDS_SYNC();
    }
    if (!smp && q == 0) {
#pragma unroll
        for (int pt = 0; pt < 4; ++pt) { const size_t so = (((size_t)b * DEPTH + l) * 2 + dir) * S5G * S5P + (size_t)g * S5P + lr + 16 * pt; p.out[O_SR + so] = sp[pt].r; p.out[O_SI + so] = sp[pt].i; }
    }
}
typedef __bf16 bf16;
typedef bf16 bf16x8 __attribute__((ext_vector_type(8)));
typedef bf16 bf16x4 __attribute__((ext_vector_type(4)));
#ifdef HOST_SIM
#define MFMA16B(a, b, c) sim::mfma16<0>(&(a), &(b), c)
#else
#define MFMA16B(a, b, c) __builtin_amdgcn_mfma_f32_16x16x32_bf16(a, b, c, 0, 0, 0)
#endif
constexpr int HS_QK = 136, HS_T = 40;
constexpr int HG_QH = 0, HG_KH = HG_QH + 32 * HS_QK * 2, HG_KHT = HG_KH + 32 * HS_QK * 2, HG_VT = HG_KHT + 128 * HS_T * 2, HG_P = HG_VT + 2 * 128 * HS_T * 2,
              HG_SST = HG_P + 2 * 32 * HS_T * 2, HG_END = HG_SST + 128 * HS_QK * 2;
static_assert(HG_END <= STAGE_BYTES, "hgrn LDS");
__device__ __forceinline__ void hgrn_item(const Params& p, int l, int sq, int h, int dir, LAS unsigned char* lds) {
    int tid = threadIdx.x; LAUNDER(tid);
    const int w = tid >> 6, lane = tid & 63, lr = lane & 15, lq = lane >> 4;
    const bool smp = sq < DBATCH; const int b = smp ? sq : sq - DBATCH;
    const int T = smp ? DSEQ : SEQ, row0 = smp ? MP + b * DSEQ : b * SEQ, NC = T / 32;
    const h16* Z = (const h16*)(p.ws + WS_Z); const float* LOGF = (const float*)(p.ws + WS_LOGF);
    h16* O = (h16*)(p.ws + (dir ? WS_OB : WS_OF));
    LAS bf16* QH = (LAS bf16*)(lds + HG_QH); LAS bf16* KH = (LAS bf16*)(lds + HG_KH); LAS bf16* KHT = (LAS bf16*)(lds + HG_KHT);
    LAS bf16* VT = (LAS bf16*)(lds + HG_VT); LAS bf16* PP = (LAS bf16*)(lds + HG_P); LAS bf16* SST = (LAS bf16*)(lds + HG_SST);
    const int dcol = 16 * w + lr;
    f32x4 S[8];
    if (smp) { const float* s0 = p.in[I_SH] + ((((size_t)b * DEPTH + l) * 2 + dir) * HGH + h) * 128 * 128;
#pragma unroll
        for (int vt = 0; vt < 8; ++vt)
#pragma unroll
            for (int i = 0; i < 4; ++i) S[vt][i] = s0[(size_t)(16 * w + 4 * lq + i) * 128 + 16 * vt + lr]; }
    else {
#pragma unroll
        for (int vt = 0; vt < 8; ++vt) S[vt] = (f32x4){0.f, 0.f, 0.f, 0.f}; }
    float lf[8]; h16 qv[8], vv[8];
    const unsigned voffz = (unsigned)(((dir ? 31 - 8 * lq : 8 * lq) * INC + h * 128 + dcol) * 2);
    const unsigned voffl = (unsigned)(((dir ? 31 - 8 * lq : 8 * lq) * 2 * W + dir * W + h * 128 + dcol) * 4);
    const unsigned voffo = (unsigned)(((dir ? 31 - 4 * lq : 4 * lq) * W + h * 128 + 16 * w + lr) * 2);
    const long sgn = dir ? -1 : 1;
#define HG_LOAD(c) do { const int rlo = dir ? row0 + T - 32 * (c) - 32 : row0 + 32 * (c); const char* zb = (const char*)Z + (size_t)rlo * INC * 2; const char* lb = (const char*)LOGF + (size_t)rlo * 2 * W * 4; \
        _Pragma("unroll") for (int i = 0; i < 8; ++i) { const char* zi_ = zb + sgn * i * (long)(INC * 2); const char* li_ = lb + sgn * i * (long)(2 * W * 4); \
            lf[i] = *(const float*)(li_ + voffl); qv[i] = *(const h16*)(zi_ + C_HQ * 2 + voffz); vv[i] = *(const h16*)(zi_ + C_HI * 2 + voffz); } } while (0)
    HG_LOAD(0);
    for (int c = 0; c < NC; ++c) {
        const int buf = c & 1;
        float bc[8]; float run = 0.f;
#pragma unroll
        for (int i = 0; i < 8; ++i) { run += lf[i]; bc[i] = run; }
        const float t0 = __shfl(run, lr), t1 = __shfl(run, lr + 16), t2 = __shfl(run, lr + 32), t3 = __shfl(run, lr + 48);
        const float pre = (lq > 0 ? t0 : 0.f) + (lq > 1 ? t1 : 0.f) + (lq > 2 ? t2 : 0.f), bl = (t0 + t1) + (t2 + t3);
        bf16x8 kht, vtv;
#pragma unroll
        for (int i = 0; i < 8; ++i) { const float bi = pre + bc[i]; const float kk = (1.0f - __expf(lf[i])) * __expf(bl - bi), qq = (float)qv[i] * __expf(bi - bl);
            const int t = 8 * lq + i; QH[t * HS_QK + dcol] = (bf16)qq; KH[t * HS_QK + dcol] = (bf16)kk; kht[i] = (bf16)kk; vtv[i] = (bf16)(float)vv[i]; }
        *(LAS bf16x8*)(KHT + dcol * HS_T + 8 * lq) = kht;
        *(LAS bf16x8*)(VT + buf * 128 * HS_T + dcol * HS_T + 8 * lq) = vtv;
        const float ebl = __expf(bl);
#pragma unroll
        for (int i = 0; i < 4; ++i) { const float e = __shfl(ebl, 4 * lq + i);
#pragma unroll
            for (int vt = 0; vt < 8; ++vt) S[vt][i] *= e; }
#pragma unroll
        for (int vt = 0; vt < 8; ++vt) { bf16x4 sv; sv[0] = (bf16)S[vt][0]; sv[1] = (bf16)S[vt][1]; sv[2] = (bf16)S[vt][2]; sv[3] = (bf16)S[vt][3];
            *(LAS bf16x4*)(SST + (16 * vt + lr) * HS_QK + 16 * w + 4 * lq) = sv; }
        if (c + 1 < NC) HG_LOAD(c + 1);
        __syncthreads();
        f32x4 oi[2] = {(f32x4){0.f, 0.f, 0.f, 0.f}, (f32x4){0.f, 0.f, 0.f, 0.f}};
#pragma unroll
        for (int ks = 0; ks < 4; ++ks) { const bf16x8 bfr = *(const LAS bf16x8*)(SST + (16 * w + lr) * HS_QK + 32 * ks + 8 * lq);
#pragma unroll
            for (int ti = 0; ti < 2; ++ti) { const bf16x8 afr = *(const LAS bf16x8*)(QH + (16 * ti + lr) * HS_QK + 32 * ks + 8 * lq); oi[ti] = MFMA16B(afr, bfr, oi[ti]); } }
        if (w < 3) { const int ti = (w + 1) >> 1, si = w >> 1;
            f32x4 sc = (f32x4){0.f, 0.f, 0.f, 0.f};
#pragma unroll
            for (int ks = 0; ks < 4; ++ks) { const bf16x8 afr = *(const LAS bf16x8*)(QH + (16 * ti + lr) * HS_QK + 32 * ks + 8 * lq), bfr = *(const LAS bf16x8*)(KH + (16 * si + lr) * HS_QK + 32 * ks + 8 * lq);
                sc = MFMA16B(afr, bfr, sc); }
#pragma unroll
            for (int i = 0; i < 4; ++i) { const int t = 16 * ti + 4 * lq + i, s_ = 16 * si + lr; PP[buf * 32 * HS_T + t * HS_T + s_] = (bf16)(s_ <= t ? sc[i] : 0.f); }
        } else if (w == 3) {
#pragma unroll
            for (int i = 0; i < 4; ++i) PP[buf * 32 * HS_T + (4 * lq + i) * HS_T + 16 + lr] = (bf16)0.f;
        }
        { const bf16x8 afr = *(const LAS bf16x8*)(KHT + (16 * w + lr) * HS_T + 8 * lq);
#pragma unroll
          for (int vt = 0; vt < 8; ++vt) { const bf16x8 bfr = *(const LAS bf16x8*)(VT + buf * 128 * HS_T + (16 * vt + lr) * HS_T + 8 * lq); S[vt] = MFMA16B(afr, bfr, S[vt]); } }
        __syncthreads();
        { const bf16x8 bfr = *(const LAS bf16x8*)(VT + buf * 128 * HS_T + (16 * w + lr) * HS_T + 8 * lq);
#pragma unroll
          for (int ti = 0; ti < 2; ++ti) { const bf16x8 afr = *(const LAS bf16x8*)(PP + buf * 32 * HS_T + (16 * ti + lr) * HS_T + 8 * lq); oi[ti] = MFMA16B(afr, bfr, oi[ti]); } }
        { const int rlo = dir ? row0 + T - 32 * c - 32 : row0 + 32 * c; char* ob = (char*)O + (size_t)rlo * W * 2;
#pragma unroll
          for (int ti = 0; ti < 2; ++ti)
#pragma unroll
            for (int i = 0; i < 4; ++i) *(h16*)(ob + sgn * (16 * ti + i) * (long)(W * 2) + voffo) = (h16)oi[ti][i]; }
    }
#undef HG_LOAD
    if (!smp) { float* so = p.out + O_SH + ((((size_t)b * DEPTH + l) * 2 + dir) * HGH + h) * 128 * 128;
#pragma unroll
        for (int vt = 0; vt < 8; ++vt)
#pragma unroll
            for (int i = 0; i < 4; ++i) so[(size_t)(16 * w + 4 * lq + i) * 128 + 16 * vt + lr] = S[vt][i]; }
    __syncthreads();
}
template <int PARTS> __device__ __forceinline__ void phase_scans(const Params& p, int l, LAS unsigned char* lds) {
    int tid_ = threadIdx.x; LAUNDER(tid_);
    const int lane = tid_ & 63, gw = blockIdx.x * NWAVES + (tid_ >> 6), nw = gridDim.x * NWAVES;
    if (PARTS & 1) {
        constexpr int NL = DBATCH * HGH * 2, NS = BATCH * HGH * 2;
        const int G = gridDim.x, bid = blockIdx.x;
        for (int it = bid; it < NL; it += G) hgrn_item(p, l, it / (HGH * 2), (it >> 1) % HGH, it & 1, lds);
        if (NL < G) { if (bid >= NL) for (int it = bid - NL; it < NS; it += G - NL) hgrn_item(p, l, DBATCH + it / (HGH * 2), (it >> 1) % HGH, it & 1, lds); }
        else { for (int it = bid; it < NS; it += G) hgrn_item(p, l, DBATCH + it / (HGH * 2), (it >> 1) % HGH, it & 1, lds); }
    }
    constexpr int N_S5S = DBATCH * S5G * 2, N_S5C = BATCH * S5G * 2;
    LAS unsigned char* ldsw = lds + (tid_ >> 6) * S5_WAVE_LDS;
    if (PARTS & 2) {
    for (int it = gw; it < N_S5S; it += nw) c_s5(p, l, it, lane, ldsw);
    if (N_S5S < nw) { if (gw >= N_S5S) for (int it = gw - N_S5S; it < N_S5C; it += nw - N_S5S) c_s5(p, l, N_S5S + it, lane, ldsw); }
    else { for (int it = gw; it < N_S5C; it += nw) c_s5(p, l, N_S5S + it, lane, ldsw); }
    }
    if (PARTS & 4) { __syncthreads(); for (int t = blockIdx.x; t < M / 64 + DBATCH * PAST / 64; t += gridDim.x) prep_tile(p, l, t, lds); }
}

typedef float f32x16 __attribute__((ext_vector_type(16)));
typedef unsigned u32x4 __attribute__((ext_vector_type(4)));
__device__ __forceinline__ int crow(int r, int hi) { return (r & 3) + 8 * (r >> 2) + 4 * hi; }
__device__ __forceinline__ unsigned cvtpk_h(float lo, float hi) { h16x2 v; v[0] = (h16)lo; v[1] = (h16)hi; return __builtin_bit_cast(unsigned, v); }
constexpr int AT_K = 0, AT_V = 32768, AT_OS = 136, AT_WS = 8 * 32 * AT_OS * 2;
__device__ __forceinline__ void attn_unit(const h16* Qb, const h16* Kb, const h16* VTb, int NK, const h16* Gb, h16* Ob, LAS unsigned char* lds, unsigned char* PS_WS) {
    int tid = threadIdx.x; LAUNDER(tid);
    const int wid = tid >> 6, lane = tid & 63, r32 = lane & 31, hi = lane >> 5;
    LAS float* wsf = (LAS float*)(lds + AT_WS) + wid * 64; LAS float* al_l = wsf; LAS float* li_l = wsf + 32;
    constexpr float C = 1.4426950408889634f;
    float m_reg = -1e30f, l_reg = 0.f;
    f32x16 o[4];
#pragma unroll
    for (int d = 0; d < 4; ++d)
#pragma unroll
        for (int r = 0; r < 16; ++r) o[d][r] = 0.f;
    h16x8 qr[8];
    { const h16* Qw = Qb + (size_t)(wid * 32 + r32) * W + hi * 8;
#pragma unroll
      for (int d0 = 0; d0 < 8; ++d0) qr[d0] = *(const h16x8*)(Qw + d0 * 16); }
    const int kr_ = tid >> 4, kc_ = tid & 15, vr_ = tid >> 3, vc_ = tid & 7;
    const int kst0 = kr_ * 256 + ((kc_ * 16) ^ ((kr_ & 15) << 4)), kst1 = (kr_ + 32) * 256 + ((kc_ * 16) ^ (((kr_ + 32) & 15) << 4));
    const int vst0 = vr_ * 128 + ((vc_ * 16) ^ (((vr_ >> 1) & 7) << 4)), vst1 = (vr_ + 64) * 128 + ((vc_ * 16) ^ ((((vr_ + 64) >> 1) & 7) << 4));
    const h16* kg0 = Kb + (size_t)kr_ * KVW + kc_ * 8; const h16* kg1 = Kb + (size_t)(kr_ + 32) * KVW + kc_ * 8;
    const h16* vg0 = VTb + (size_t)vr_ * NK + vc_ * 8; const h16* vg1 = VTb + (size_t)(vr_ + 64) * NK + vc_ * 8;
    const int NT = NK / 64;
    h16x8 ka = *(const h16x8*)kg0, kb = *(const h16x8*)kg1, va = *(const h16x8*)vg0, vb = *(const h16x8*)vg1;
    *(LAS h16x8*)(lds + AT_K + kst0) = ka; *(LAS h16x8*)(lds + AT_K + kst1) = kb; *(LAS h16x8*)(lds + AT_V + vst0) = va; *(LAS h16x8*)(lds + AT_V + vst1) = vb;
    __syncthreads();
    PSPIN_T0(1)
    for (int j = 0; j < NT; ++j) {
        const int buf = j & 1;
        if (j + 1 < NT) { ka = *(const h16x8*)(kg0 + (size_t)(j + 1) * 64 * KVW); kb = *(const h16x8*)(kg1 + (size_t)(j + 1) * 64 * KVW); va = *(const h16x8*)(vg0 + (j + 1) * 64); vb = *(const h16x8*)(vg1 + (j + 1) * 64); }
        const LAS unsigned char* Kl = lds + AT_K + buf * 16384; const LAS unsigned char* Vl = lds + AT_V + buf * 16384;
        f32x16 p0, p1;
#pragma unroll
        for (int r = 0; r < 16; ++r) { p0[r] = 0.f; p1[r] = 0.f; }
#pragma unroll
        for (int d0 = 0; d0 < 8; ++d0) { const int cb = (d0 * 16 + hi * 8) * 2;
            const h16x8 b0 = *(const LAS h16x8*)(Kl + r32 * 256 + (cb ^ ((r32 & 15) << 4)));
            const h16x8 b1 = *(const LAS h16x8*)(Kl + (32 + r32) * 256 + (cb ^ ((r32 & 15) << 4)));
            p0 = MFMA32(b0, qr[d0], p0); p1 = MFMA32(b1, qr[d0], p1); }
        float pmax = p0[0];
#pragma unroll
        for (int r = 1; r < 16; ++r) pmax = fmaxf(pmax, p0[r]);
#pragma unroll
        for (int r = 0; r < 16; ++r) pmax = fmaxf(pmax, p1[r]);
        { unsigned ra, rb; permlane32_swap_u(__builtin_bit_cast(unsigned, pmax), __builtin_bit_cast(unsigned, pmax), ra, rb); pmax = fmaxf(__builtin_bit_cast(float, ra), __builtin_bit_cast(float, rb)); }
        const float mn = fmaxf(m_reg, pmax), alpha = EXP2F((m_reg - mn) * C), mnC = -mn * C; m_reg = mn;
        float ps = 0.f;
#pragma unroll
        for (int r = 0; r < 16; ++r) { p0[r] = EXP2F(fmaf(p0[r], C, mnC)); p1[r] = EXP2F(fmaf(p1[r], C, mnC)); ps += p0[r] + p1[r]; }
        { unsigned ra, rb; permlane32_swap_u(__builtin_bit_cast(unsigned, ps), __builtin_bit_cast(unsigned, ps), ra, rb); ps = __builtin_bit_cast(float, ra) + __builtin_bit_cast(float, rb); }
        l_reg = l_reg * alpha + ps;
        if (hi == 0) al_l[r32] = alpha;
        WAVE_LDS_SYNC();
#pragma unroll
        for (int r = 0; r < 16; ++r) { const float a = al_l[crow(r, hi)];
#pragma unroll
            for (int d = 0; d < 4; ++d) o[d][r] *= a; }
        WAVE_LDS_SYNC();
        h16x8 pa[4];
#define PK4(P, BASE, OUT) do { const unsigned a0 = cvtpk_h(P[BASE + 0], P[BASE + 1]), a1 = cvtpk_h(P[BASE + 2], P[BASE + 3]), b0_ = cvtpk_h(P[BASE + 4], P[BASE + 5]), b1_ = cvtpk_h(P[BASE + 6], P[BASE + 7]); \
        unsigned r00, r01, r10, r11; permlane32_swap_u(a0, b0_, r00, r01); permlane32_swap_u(a1, b1_, r10, r11); u32x4 w_ = {r00, r10, r01, r11}; OUT = __builtin_bit_cast(h16x8, w_); } while (0)
        PK4(p0, 0, pa[0]); PK4(p0, 8, pa[1]); PK4(p1, 0, pa[2]); PK4(p1, 8, pa[3]);
#undef PK4
#pragma unroll
        for (int d0 = 0; d0 < 4; ++d0) { const int vrow = d0 * 32 + r32;
#pragma unroll
            for (int ks = 0; ks < 4; ++ks) { const int cb = (ks * 16 + hi * 8) * 2;
                const h16x8 vf = *(const LAS h16x8*)(Vl + vrow * 128 + (cb ^ (((vrow >> 1) & 7) << 4)));
                o[d0] = MFMA32(pa[ks], vf, o[d0]); } }
        if (j + 1 < NT) { const int nb = (buf ^ 1) * 16384;
            *(LAS h16x8*)(lds + AT_K + nb + kst0) = ka; *(LAS h16x8*)(lds + AT_K + nb + kst1) = kb; *(LAS h16x8*)(lds + AT_V + nb + vst0) = va; *(LAS h16x8*)(lds + AT_V + nb + vst1) = vb; }
        __syncthreads();
    }
    PSPIN_T1(1, PS_WS)
    if (hi == 0) li_l[r32] = l_reg;
    WAVE_LDS_SYNC();
    LAS h16* OT = (LAS h16*)(lds + wid * (32 * AT_OS * 2));
#pragma unroll
    for (int r = 0; r < 16; ++r) { const float rl = RCPF(li_l[crow(r, hi)]);
#pragma unroll
        for (int d0 = 0; d0 < 4; ++d0) OT[crow(r, hi) * AT_OS + d0 * 32 + r32] = (h16)(o[d0][r] * rl); }
    WAVE_LDS_SYNC();
#pragma unroll
    for (int k = 0; k < 8; ++k) { const int ch = lane + 64 * k, row = ch >> 4, c = ch & 15; const int orow = wid * 32 + row;
        const h16x8 v = *(const LAS h16x8*)(OT + row * AT_OS + c * 8), g = *(const h16x8*)(Gb + (size_t)orow * INC + c * 8);
        h16x8 ov;
#pragma unroll
        for (int j = 0; j < 8; ++j) ov[j] = (h16)((float)v[j] * (float)g[j]);
        *(h16x8*)(Ob + (size_t)orow * W + c * 8) = ov; }
    __syncthreads();
}
constexpr int HGP_N = 8;
__device__ __forceinline__ void d_hgpost4(const Params& p, int l, int item0, int stride, int nitems, int lane) {
    const h16* OF = (const h16*)(p.ws + WS_OF); const h16* OB = (const h16*)(p.ws + WS_OB);
    const float* wn = p.in[I_ONORM] + (size_t)l * 128; const float w0 = wn[lane], w1 = wn[lane + 64];
    float a0[HGP_N], a1[HGP_N]; h16 g0[HGP_N], g1[HGP_N];
#pragma unroll
    for (int k = 0; k < HGP_N; ++k) { const int item = item0 + k * stride; if (item < nitems) { const int row = item / HGH, h = item % HGH; const size_t o0 = (size_t)row * W + h * 128;
        a0[k] = (float)OF[o0 + lane] + (float)OB[o0 + lane]; a1[k] = (float)OF[o0 + lane + 64] + (float)OB[o0 + lane + 64];
        const h16* gz = (const h16*)(p.ws + WS_Z) + (size_t)row * INC + C_HGG + h * 128; g0[k] = gz[lane]; g1[k] = gz[lane + 64]; } else { a0[k] = 0.f; a1[k] = 0.f; g0[k] = (h16)0.f; g1[k] = (h16)0.f; } }
#pragma unroll
    for (int k = 0; k < HGP_N; ++k) { const int item = item0 + k * stride; const float ss = wave_sum(a0[k] * a0[k] + a1[k] * a1[k]);
        if (item < nitems) { const int row = item / HGH, h = item % HGH; const float rstd = rsqrtf(ss * (1.0f / 128.0f) + EPS);
            h16* dst = (h16*)(p.ws + WS_OHG) + (size_t)row * W + h * 128; dst[lane] = (h16)(a0[k] * rstd * w0 * (float)g0[k]); dst[lane + 64] = (h16)(a1[k] * rstd * w1 * (float)g1[k]); } }
}
template <int PARTS> __device__ __forceinline__ void phase_attn(const Params& p, int l, LAS unsigned char* lds) {
    int tid_ = threadIdx.x; LAUNDER(tid_);
    const int lane = tid_ & 63, gw = blockIdx.x * NWAVES + (tid_ >> 6), nw = gridDim.x * NWAVES;
    constexpr int NU_S = DBATCH * AQH * (DSEQ / 256), NU_C = BATCH * AQH * (SEQ / 256);
    if (PARTS & 1)
    for (int u = blockIdx.x; u < NU_S + NU_C; u += gridDim.x) {
        const bool smp = u < NU_S; const int uu = smp ? u : u - NU_S;
        const int T = smp ? DSEQ : SEQ, NK = smp ? KVLEN : SEQ;
        const int qb = uu % (T / 256), qh = (uu / (T / 256)) % AQH, b = uu / ((T / 256) * AQH), kh = qh / 4;
        const int row0 = (smp ? MP + b * DSEQ : b * SEQ) + qb * 256;
        const h16* Kb = (smp ? (const h16*)(p.ws + WS_KBS) : (const h16*)(p.ws + WS_KBC)) + (size_t)b * NK * KVW + kh * 128;
        const h16* VTb = (smp ? (const h16*)(p.ws + WS_VBS) : (const h16*)(p.ws + WS_VBC)) + (size_t)(b * AKVH + kh) * 128 * NK;
        attn_unit((const h16*)(p.ws + WS_AQ2) + (size_t)row0 * W + qh * 128, Kb, VTb, NK, (const h16*)(p.ws + WS_Z) + (size_t)row0 * INC + C_AG + qh * 128,
                  (h16*)(p.ws + WS_OAT) + (size_t)row0 * W + qh * 128, lds, p.ws);
    }
    constexpr int N_HP = M * HGH;
    if (PARTS & 2)
    for (int it = gw; it < N_HP; it += HGP_N * nw) d_hgpost4(p, l, it, nw, N_HP, lane);
    if (!(PARTS & 4)) return;
    const h16* YF = (const h16*)(p.ws + WS_YF); const h16* YB = (const h16*)(p.ws + WS_YB); const h16* Z = (const h16*)(p.ws + WS_Z);
    const float* dd = p.in[I_S5D] + (size_t)l * W; h16* YS = (h16*)(p.ws + WS_YS);
    const size_t nth = (size_t)gridDim.x * NTHREADS;
    constexpr int SPN = 8;
    for (size_t i0 = ((size_t)blockIdx.x * NTHREADS + tid_) * 4; i0 < (size_t)M * W; i0 += nth * 4 * SPN) {
        h16x4 a[SPN], b[SPN]; h16x4 u[SPN]; f32x4 dv[SPN];
#pragma unroll
        for (int k = 0; k < SPN; ++k) { const size_t i = i0 + k * nth * 4; if (i < (size_t)M * W) { const size_t row = i / W; const int c = (int)(i % W);
            a[k] = *(const h16x4*)(YF + i); b[k] = *(const h16x4*)(YB + i); dv[k] = *(const f32x4*)(dd + c); u[k] = *(const h16x4*)(Z + row * INC + C_SU + c); } }
#pragma unroll
        for (int k = 0; k < SPN; ++k) { const size_t i = i0 + k * nth * 4; if (i < (size_t)M * W) { h16x4 o;
#pragma unroll
            for (int j = 0; j < 4; ++j) o[j] = (h16)geluf((float)a[k][j] + (float)b[k][j] + dv[k][j] * (float)u[k][j]);
            *(h16x4*)(YS + i) = o; } }
    }
}

constexpr int NPL = 7, PH_FINAL = 1 + DEPTH * NPL, N_PHASES = PH_FINAL + 1;

__global__ void __launch_bounds__(NTHREADS, 2) fwd_kernel(Params p) {
#ifdef HOST_SIM
    unsigned char* lds = sim::cur->blk->lds;
#else
    extern __shared__ __attribute__((aligned(16))) unsigned char lds_raw[];
    LAS unsigned char* lds = (LAS unsigned char*)lds_raw;
#endif
    const int lo = p.ph_lo, hi = p.ph_hi;
#ifndef HOST_SIM
    if (threadIdx.x < 4) ((LAS unsigned*)(lds + MISC_OFF))[threadIdx.x] = 0u;
    __syncthreads();
    XcdBarrier bar; bar.bar = (unsigned*)(p.ws + WS_BAR); bar.x = 0; bar.st = nullptr;
    if (hi - lo > 1) bar = xcd_barrier_post((unsigned*)(p.ws + WS_BAR), (volatile LAS unsigned*)(lds + MISC_OFF));
#else
    XcdBarrier bar{0};
#endif
#define IN(k) (lo <= (k) && (k) < hi)
#define SEAM(k) do { if (IN(k) && IN((k) + 1)) xcd_barrier(bar); } while (0)

    unsigned char* ws = p.ws;
    const int G = gridDim.x, bid = blockIdx.x;
    if (IN(0)) { phase_prologue(p, lds); if (PROBE_REP == 0) { xcd_barrier(bar); phase_prologue(p, lds); } } SEAM(0);
    for (int l = 0; l < DEPTH; ++l) {
        const int pb = 1 + l * NPL;
        if (IN(pb + 0)) { phase_norm(p, l); } SEAM(pb + 0);
        if (IN(pb + 1)) {
            pg8::Gemm g{(const h16*)(ws + WS_H), (const h16*)(ws + WS_WIN) + (size_t)l * INC * D, 0, 0, M, INC, D};
            pg8::StaticOrder S; S.init(M, INC, G, bid);
            EpiIn E{(h16*)(ws + WS_Z), (float*)(ws + WS_LOGF), (const float*)(ws + WS_LB) + (size_t)l * W};
            pg8::gemm_phase<EpiIn, pg8::StaticOrder>(lds, g, S, E);
            if (PROBE_REP == 1) { xcd_barrier(bar); pg8::gemm_phase<EpiIn, pg8::StaticOrder>(lds, g, S, E); }
        } SEAM(pb + 1);
        if (IN(pb + 2)) { phase_scans<7>(p, l, lds); if (PROBE_REP == 2) { xcd_barrier(bar); phase_scans<7>(p, l, lds); } if (PROBE_REP == 21) { xcd_barrier(bar); phase_scans<1>(p, l, lds); } if (PROBE_REP == 22) { xcd_barrier(bar); phase_scans<2>(p, l, lds); } if (PROBE_REP == 23) { xcd_barrier(bar); phase_scans<4>(p, l, lds); } } SEAM(pb + 2);
        if (IN(pb + 3)) { phase_attn<7>(p, l, lds); if (PROBE_REP == 3) { xcd_barrier(bar); phase_attn<7>(p, l, lds); } if (PROBE_REP == 31) { xcd_barrier(bar); phase_attn<1>(p, l, lds); } if (PROBE_REP == 32) { xcd_barrier(bar); phase_attn<2>(p, l, lds); } if (PROBE_REP == 33) { xcd_barrier(bar); phase_attn<4>(p, l, lds); } } SEAM(pb + 3);
        if (IN(pb + 4)) {
            pg8::Gemm g{(const h16*)(ws + WS_YS), (const h16*)(ws + WS_WGLU) + (size_t)l * W * W, 0, 0, M, W, W};
            pg8::StaticOrder S; S.init(M, W, G, bid);
            EpiGlu E{(const h16*)(ws + WS_YS), (const h16*)(ws + WS_Z), (h16*)(ws + WS_OS5)};
            pg8::gemm_phase<EpiGlu, pg8::StaticOrder>(lds, g, S, E);
        } SEAM(pb + 4);
        if (IN(pb + 5)) {
            const h16* wbr = (const h16*)(ws + WS_WBR) + (size_t)l * 3 * D * W;
            pg8::Gemm g{(const h16*)(ws + WS_OHG), wbr, (size_t)M * W, (size_t)D * W, M, D, W};
            pg8::MultiOrder<3> S; S.init(M, D, G, bid);
            EpiBr E{(const h16*)(ws + WS_Z), (h16*)(ws + WS_MG)};
            pg8::gemm_phase<EpiBr, pg8::MultiOrder<3>>(lds, g, S, E);
            if (PROBE_REP == 5) { xcd_barrier(bar); pg8::gemm_phase<EpiBr, pg8::MultiOrder<3>>(lds, g, S, E); }
        } SEAM(pb + 5);
        if (IN(pb + 6)) {
            pg8::Gemm g{(const h16*)(ws + WS_MG), (const h16*)(ws + WS_WOUT) + (size_t)l * D * D, 0, 0, M, D, D};
            pg8::StaticOrder S; S.init(M, D, G, bid);
            const float* X = (const float*)(ws + WS_X);
            EpiOut E{l == 0 ? p.in[I_XP] : X, l == 0 ? p.in[I_XS] : X + (size_t)MP * D, (float*)(ws + WS_X), (const float*)(ws + WS_MOD) + (size_t)l * NMODR * 3 * D};
            pg8::gemm_phase<EpiOut, pg8::StaticOrder>(lds, g, S, E);
        } SEAM(pb + 6);
    }
    if (IN(PH_FINAL)) { phase_final(p); }
#if !defined(HOST_SIM) && PROBE_SPIN
    if (blockIdx.x == 0 && threadIdx.x == 0) { const unsigned T = __hip_atomic_load((unsigned*)p.ws + 64, __ATOMIC_RELAXED, __HIP_MEMORY_SCOPE_AGENT); const unsigned long long t0 = __builtin_amdgcn_s_memrealtime(); while (__builtin_amdgcn_s_memrealtime() - t0 < (unsigned long long)T) __builtin_amdgcn_s_sleep(8); }
#endif
#undef IN
#undef SEAM
}

#ifndef HOST_SIM
extern "C" void kernel_launch(void* const* d_in, const int* in_sizes, int n_in, void* d_out, int out_size, void* d_ws, size_t ws_size, hipStream_t stream) {
    static int grid = 0;
    if (grid == 0) {
        if (n_in != N_IN || (size_t)out_size != O_END || ws_size < WS_END) { grid = -1; return; }
        int dev = 0, cus = 0;
        if (hipGetDevice(&dev) != hipSuccess || hipDeviceGetAttribute(&cus, hipDeviceAttributeMultiprocessorCount, dev) != hipSuccess) { grid = -1; return; }
        if (hipFuncSetAttribute((const void*)fwd_kernel, hipFuncAttributeMaxDynamicSharedMemorySize, LDS_BYTES) != hipSuccess) { grid = -1; return; }
        int per_cu = 0; (void)hipOccupancyMaxActiveBlocksPerMultiprocessor(&per_cu, (const void*)fwd_kernel, NTHREADS, LDS_BYTES); (void)hipGetLastError();
        grid = cus;
    }
    if (grid < 0) return;
    (void)hipMemsetAsync((char*)d_ws + WS_BAR, 0, 16384, stream);
    Params p{};
    for (int i = 0; i < N_IN; ++i) p.in[i] = (const float*)d_in[i];
    p.out = (float*)d_out; p.ws = (unsigned char*)d_ws;
#if N_LAUNCH_MODE == 1
    p.ph_lo = 0; p.ph_hi = N_PHASES;
    hipLaunchKernelGGL(fwd_kernel, dim3(grid), dim3(NTHREADS), LDS_BYTES, stream, p);
#else
    for (int k = 0; k < N_PHASES; ++k) { p.ph_lo = k; p.ph_hi = k + 1; hipLaunchKernelGGL(fwd_kernel, dim3(grid), dim3(NTHREADS), LDS_BYTES, stream, p); }
#endif
}
#endif
```

```cpp
#ifndef HOST_SIM
#include <hip/hip_runtime.h>
#endif

#ifndef CFG_D
#define CFG_D 2048
#define CFG_BATCH 32
#define CFG_SEQ 256
#define CFG_DEPTH 4
#define CFG_DBATCH 8
#define CFG_DSEQ 1024
#define CFG_PAST 256
#endif
#ifndef PROBE_REP
#define PROBE_REP -1
#endif
#ifndef PROBE_SPIN
#define PROBE_SPIN 0
#endif
#ifndef N_LAUNCH_MODE
#define N_LAUNCH_MODE 1
#endif

constexpr int D = CFG_D, BATCH = CFG_BATCH, SEQ = CFG_SEQ, DEPTH = CFG_DEPTH, DBATCH = CFG_DBATCH, DSEQ = CFG_DSEQ, PAST = CFG_PAST;
constexpr int W = D / 2;
constexpr int HGH = W / 128;
constexpr int AQH = W / 128, AKVH = AQH / 4, KVW = AKVH * 128;
constexpr int S5G = W / 16, S5P = 64;
constexpr int C_HQ = 0, C_HI = W, C_FF = 2 * W, C_FB = 3 * W, C_HGG = 4 * W, C_AQ = 5 * W, C_AK = 6 * W, C_AV = 6 * W + KVW, C_AG = 6 * W + 2 * KVW,
              C_SU = 7 * W + 2 * KVW, C_SG = 8 * W + 2 * KVW, C_MG = 9 * W + 2 * KVW, INC = C_MG + 3 * D;
constexpr int MP = BATCH * SEQ, MS = DBATCH * DSEQ, M = MP + MS;
constexpr int KVLEN = PAST + DSEQ;
constexpr int NMODR = 1 + DBATCH;
constexpr float EPS = 1e-6f;
static_assert(INC % 256 == 0 && MP % 256 == 0 && MS % 256 == 0 && W % 256 == 0, "tile shapes");

typedef _Float16 h16;
typedef h16 h16x8 __attribute__((ext_vector_type(8)));
typedef h16 h16x4 __attribute__((ext_vector_type(4)));
typedef h16 h16x2 __attribute__((ext_vector_type(2)));
typedef float f32x4 __attribute__((ext_vector_type(4)));
typedef float f32x2 __attribute__((ext_vector_type(2)));
typedef float f32x16 __attribute__((ext_vector_type(16)));
typedef unsigned u32x4 __attribute__((ext_vector_type(4)));

constexpr size_t al256(size_t x) { return (x + 255) & ~(size_t)255; }
constexpr size_t WS_BAR = 0;
constexpr size_t WS_MOD = 16384;
constexpr size_t WS_LB = al256(WS_MOD + (size_t)DEPTH * NMODR * 3 * D * 4);
constexpr size_t WS_ABAR = al256(WS_LB + (size_t)2 * DEPTH * W * 4);
constexpr size_t WS_BBAR = al256(WS_ABAR + (size_t)DEPTH * 2 * S5G * S5P * 8);
constexpr size_t WS_S5T = al256(WS_BBAR + (size_t)DEPTH * 2 * S5G * S5P * 32 * 4);
constexpr size_t WS_S5C = al256(WS_S5T + (size_t)DEPTH * 2 * S5G * 256 * 48);
constexpr size_t WS_ROPE = al256(WS_S5C + (size_t)DEPTH * S5G * 256 * 16);
constexpr size_t WS_WIN = al256(WS_ROPE + (size_t)(DSEQ / 64 + 64) * 32 * 8);
constexpr size_t WS_WGLU = al256(WS_WIN + (size_t)DEPTH * INC * D * 2);
constexpr size_t WS_WBR = al256(WS_WGLU + (size_t)DEPTH * W * W * 2);
constexpr size_t WS_WOUT = al256(WS_WBR + (size_t)DEPTH * 3 * D * W * 2);
constexpr size_t WS_X = al256(WS_WOUT + (size_t)DEPTH * D * D * 2);
constexpr size_t WS_H = al256(WS_X + (size_t)M * D * 4);
constexpr size_t WS_Z = al256(WS_H + (size_t)M * D * 2);
constexpr size_t WS_LOGF = al256(WS_Z + (size_t)M * INC * 2);
constexpr size_t WS_AQ2 = al256(WS_LOGF + (size_t)M * 2 * W * 4);
constexpr size_t WS_KBC = al256(WS_AQ2 + (size_t)M * W * 2);
constexpr size_t WS_VBC = al256(WS_KBC + (size_t)MP * KVW * 2);
constexpr size_t WS_KBS = al256(WS_VBC + (size_t)MP * KVW * 2);
constexpr size_t WS_VBS = al256(WS_KBS + (size_t)DBATCH * KVLEN * KVW * 2);
constexpr size_t WS_OF = al256(WS_VBS + (size_t)DBATCH * KVLEN * KVW * 2);
constexpr size_t WS_OB = al256(WS_OF + (size_t)M * W * 4);
constexpr size_t WS_YF = al256(WS_OB + (size_t)M * W * 4);
constexpr size_t WS_YB = al256(WS_YF + (size_t)M * W * 4);
constexpr size_t WS_OHG = al256(WS_YB + (size_t)M * W * 4);
constexpr size_t WS_OAT = al256(WS_OHG + (size_t)M * W * 2);
constexpr size_t WS_OS5 = al256(WS_OAT + (size_t)M * W * 2);
constexpr size_t WS_YS = al256(WS_OS5 + (size_t)M * W * 2);
constexpr size_t WS_MG = al256(WS_YS + (size_t)M * W * 2);
static_assert(WS_OAT - WS_OHG == (size_t)M * W * 2 && WS_OS5 - WS_OAT == (size_t)M * W * 2, "branch operands must be equally spaced");
constexpr size_t WS_END = al256(WS_MG + (size_t)M * D * 2);

constexpr size_t O_Y = 0;
constexpr size_t O_CK = (size_t)M * D;
constexpr size_t O_CV = O_CK + (size_t)BATCH * DEPTH * SEQ * KVW;
constexpr size_t O_SH = O_CV + (size_t)BATCH * DEPTH * SEQ * KVW;
constexpr size_t O_SR = O_SH + (size_t)BATCH * DEPTH * 2 * HGH * 128 * 128;
constexpr size_t O_SI = O_SR + (size_t)BATCH * DEPTH * 2 * S5G * S5P;
constexpr size_t O_END = O_SI + (size_t)BATCH * DEPTH * 2 * S5G * S5P;

enum { I_XP = 0, I_XS, I_CK, I_CV, I_SH, I_SR, I_SI, I_C, I_CCTX, I_NORMW, I_WMOD, I_BMOD, I_WIN, I_LBL, I_ONORM, I_QNORM, I_KNORM,
       I_ARE, I_AIM, I_LDT, I_BRE, I_BIM, I_CRE, I_CIM, I_S5D, I_WGLU, I_WBRHG, I_WBRAT, I_WBRS5, I_WOUT, I_FNORM, N_IN };

struct Params { const float* in[N_IN]; float* out; unsigned char* ws; int ph_lo, ph_hi; };

constexpr int NTHREADS = 512, NWAVES = 8;
constexpr int STAGE_BYTES = 131072, LDS_BYTES = 147456, MISC_OFF = LDS_BYTES - 64;

#ifdef HOST_SIM
#define LAS
static inline void sim_glds16(const void* g, void* l) { memcpy((char*)l + sim::cur->lane * 16, g, 16); }
#define GLDS16(g, l) sim_glds16((const void*)(g), (void*)(l))
#define WAIT_V(n) ((void)0)
#define WAIT_L(n) ((void)0)
#define SBAR sim::block_sync()
#define SCHED ((void)0)
#define SETPRIO(x) ((void)0)
#define CFENCE ((void)0)
#define LAUNDER(x) ((void)0)
#define PIN4(a, b, c, d) ((void)0)
#define MFMA16(a, b, c) sim::mfma16<1>(&(a), &(b), c)
#define MFMA16K16(a, b, c) sim::mfma16k16_f16(&(a), &(b), c)
static inline float readlane_f(float v, int l) { return sim::shfl<float>(v, l); }
#else
#define LAS __attribute__((address_space(3)))
#define GLDS16(g, l) __builtin_amdgcn_global_load_lds((const unsigned*)(g), (LAS unsigned*)(l), 16, 0, 0)
#define WAIT_V(n) asm volatile("s_waitcnt vmcnt(" #n ")" ::: "memory")
#define WAIT_L(n) asm volatile("s_waitcnt lgkmcnt(" #n ")" ::: "memory")
#define SBAR __builtin_amdgcn_s_barrier()
#define SCHED __builtin_amdgcn_sched_barrier(0)
#define SETPRIO(x) __builtin_amdgcn_s_setprio(x)
#define CFENCE asm volatile("" ::: "memory")
#define LAUNDER(x) asm volatile("" : "+v"(x))
#define PIN4(a, b, c, d) asm volatile("" : "+v"(a), "+v"(b), "+v"(c), "+v"(d) :: "memory")
#define MFMA16(a, b, c) __builtin_amdgcn_mfma_f32_16x16x32_f16(a, b, c, 0, 0, 0)
#define MFMA16K16(a, b, c) __builtin_amdgcn_mfma_f32_16x16x16f16(a, b, c, 0, 0, 0)
__device__ __forceinline__ float readlane_f(float v, int l) { return __builtin_bit_cast(float, __builtin_amdgcn_readlane(__builtin_bit_cast(int, v), l)); }
#endif

#ifdef HOST_SIM
#define MFMA32(a, b, c) sim::mfma32<1>(&(a), &(b), c)
#define WAVE_LDS_SYNC() sim::wave_sync()
#define EXP2F(x) exp2f(x)
#define RCPF(x) (1.0f / (x))
static inline void permlane32_swap_u(unsigned a, unsigned b, unsigned& ra, unsigned& rb) { sim_permlane32_swap(a, b, ra, rb); }
#else
#define MFMA32(a, b, c) __builtin_amdgcn_mfma_f32_32x32x16_f16(a, b, c, 0, 0, 0)
#define WAVE_LDS_SYNC() asm volatile("s_waitcnt lgkmcnt(0)" ::: "memory")
#define EXP2F(x) __builtin_amdgcn_exp2f(x)
#define RCPF(x) __builtin_amdgcn_rcpf(x)
__device__ __forceinline__ void permlane32_swap_u(unsigned a, unsigned b, unsigned& ra, unsigned& rb) { auto r = __builtin_amdgcn_permlane32_swap(a, b, false, false); ra = r[0]; rb = r[1]; }
#endif
#if !defined(HOST_SIM) && PROBE_SPIN
#define PSPIN_T0(id) unsigned long long _pt0 = 0; if (PROBE_SPIN == (id) && blockIdx.x == 0 && threadIdx.x == 0) _pt0 = __builtin_amdgcn_s_memrealtime();
#define PSPIN_T1(id, wsp) if (PROBE_SPIN == (id) && blockIdx.x == 0 && threadIdx.x == 0) { const unsigned long long _d = __builtin_amdgcn_s_memrealtime() - _pt0; atomicAdd((unsigned*)(wsp) + 64, (unsigned)_d); }
#else
#define PSPIN_T0(id)
#define PSPIN_T1(id, wsp)
#endif
__device__ __forceinline__ unsigned cvtpk_h(float lo, float hi) { h16x2 v; v[0] = (h16)lo; v[1] = (h16)hi; return __builtin_bit_cast(unsigned, v); }
__device__ __forceinline__ float sigm(float x) { return RCPF(1.0f + __expf(-x)); }
__device__ __forceinline__ float siluf(float x) { return x * sigm(x); }
__device__ __forceinline__ float geluf(float x) { const float u = 0.7978845608028654f * (x + 0.044715f * x * x * x); const float t = 1.0f - 2.0f * RCPF(1.0f + __expf(2.0f * u)); return 0.5f * x * (1.0f + t); }
#ifdef HOST_SIM
static inline float shfl_xor_l(float v, int m, int lane) { (void)lane; return __shfl_xor(v, m); }
static inline float shfl_l(float v, int src) { return __shfl(v, src); }
static inline float shfl_up_l(float v, int d, int lane) { (void)lane; return __shfl_up(v, d); }
#else
__device__ __forceinline__ float shfl_xor_l(float v, int m, int lane) { return __builtin_bit_cast(float, __builtin_amdgcn_ds_bpermute((lane ^ m) << 2, __builtin_bit_cast(int, v))); }
__device__ __forceinline__ float shfl_l(float v, int src) { return __builtin_bit_cast(float, __builtin_amdgcn_ds_bpermute(src << 2, __builtin_bit_cast(int, v))); }
__device__ __forceinline__ float shfl_up_l(float v, int d, int lane) { const float r = __builtin_bit_cast(float, __builtin_amdgcn_ds_bpermute((lane - d) << 2, __builtin_bit_cast(int, v))); return lane >= d ? r : v; }
#endif
__device__ __forceinline__ float wave_sum(float v, int lane) { v += shfl_xor_l(v, 32, lane); v += shfl_xor_l(v, 16, lane); v += shfl_xor_l(v, 8, lane); v += shfl_xor_l(v, 4, lane); v += shfl_xor_l(v, 2, lane); v += shfl_xor_l(v, 1, lane); return v; }

#ifndef HOST_SIM
#define XB_TMO      128
#define XB_XCNT(j)  (256  + 64 * (j))
#define XB_XSUB(j)  (1280 + 64 * (j))
#define XB_XGEN(j)  (2304 + 64 * (j))
#define XB_TOP      3328
#define XB_TOPGEN   3392
#define XCD_BAR_WORDS 3456
#define XB_SPIN_CAP (1u << 24)
__device__ __forceinline__ unsigned xb_ld(unsigned* p)              { return __hip_atomic_load(p, __ATOMIC_RELAXED, __HIP_MEMORY_SCOPE_AGENT); }
__device__ __forceinline__ unsigned xb_add(unsigned* p, unsigned v) { return __hip_atomic_fetch_add(p, v, __ATOMIC_RELAXED, __HIP_MEMORY_SCOPE_AGENT); }
__device__ __forceinline__ unsigned xb_xcc_id() { return (unsigned)__builtin_amdgcn_s_getreg((3 << 11) | 20) & 0xFu; }
#define XB_SPIN(cond, bar) do { unsigned _sp = 0; while (cond) { __builtin_amdgcn_s_sleep(1); \
    if ((++_sp & 255u) == 0u) { if (xb_ld(&(bar)[XB_TMO])) break; if (_sp > XB_SPIN_CAP) { atomicAdd(&(bar)[XB_TMO], 1u); break; } } } } while (0)
struct XcdBarrier { unsigned* bar; unsigned x; volatile LAS unsigned* st; };
__device__ __forceinline__ XcdBarrier xcd_barrier_post(unsigned* bar, volatile LAS unsigned* st) {
    XcdBarrier b; b.bar = bar; b.x = xb_xcc_id(); b.st = st;
    if (threadIdx.x == 0) (void)xb_add(&bar[XB_XCNT(b.x)], 1u);
    return b;
}
__device__ __forceinline__ void xcd_barrier_complete(unsigned* bar, unsigned x, unsigned& nloc, unsigned& nx) {
    const unsigned G = gridDim.x * gridDim.y * gridDim.z;
    unsigned sum, cnt, mine, sp = 0u;
    for (;;) {
        sum = 0u; cnt = 0u; mine = 0u;
#pragma unroll
        for (unsigned j = 0; j < 16; ++j) { const unsigned c = xb_ld(&bar[XB_XCNT(j)]); sum += c; cnt += (c > 0u) ? 1u : 0u; mine = (j == x) ? c : mine; }
        if (sum == G) break;
        __builtin_amdgcn_s_sleep(1);
        if ((++sp & 255u) == 0u) { if (xb_ld(&bar[XB_TMO])) break; if (sp > XB_SPIN_CAP) { atomicAdd(&bar[XB_TMO], 1u); break; } }
    }
    nloc = mine > 0u ? mine : 1u; nx = cnt > 0u ? cnt : 1u;
}
__device__ __forceinline__ void xcd_barrier(const XcdBarrier& b) {
    asm volatile("s_waitcnt vmcnt(0)" ::: "memory");
    __syncthreads();
    if (threadIdx.x == 0) {
        unsigned* bar = b.bar;
        __builtin_amdgcn_s_waitcnt(0);
        unsigned nloc = b.st[0], nx = b.st[1];
        if (nloc == 0u) { xcd_barrier_complete(bar, b.x, nloc, nx); b.st[0] = nloc; b.st[1] = nx; }
        const unsigned old = xb_add(&bar[XB_XSUB(b.x)], 1u);
        const unsigned gen = old / nloc;
        if (old + 1u == (gen + 1u) * nloc) {
            __builtin_amdgcn_fence(__ATOMIC_RELEASE, "agent");
            asm volatile("s_waitcnt vmcnt(0)" ::: "memory");
            const unsigned og = xb_add(&bar[XB_TOP], 1u);
            const unsigned tg = og / nx;
            if (og + 1u == (tg + 1u) * nx) xb_add(&bar[XB_TOPGEN], 1u);
            else XB_SPIN(xb_ld(&bar[XB_TOPGEN]) == tg, bar);
            __builtin_amdgcn_fence(__ATOMIC_ACQUIRE, "agent");
            xb_add(&bar[XB_XGEN(b.x)], 1u);
            asm volatile("s_waitcnt vmcnt(0)" ::: "memory");
        } else {
            XB_SPIN(xb_ld(&bar[XB_XGEN(b.x)]) == gen, bar);
            __builtin_amdgcn_fence(__ATOMIC_ACQUIRE, "agent");
            asm volatile("s_waitcnt vmcnt(0)" ::: "memory");
        }
    }
    __syncthreads();
}
#else
#define XCD_BAR_WORDS 3456
struct XcdBarrier { int dummy; };
static inline void xcd_barrier(const XcdBarrier&) { sim::grid_sync(); }
#endif

namespace pg8 {
constexpr int BM = 256, BK = 64, HALF = 128, HTB = HALF * BK * 2, NXCD = 8, WGM = 8;
__host__ __device__ __forceinline__ int lds_byte(int r, int c) { const int st = (r >> 4) * 2 + (c >> 5), rr = r & 15, cc = c & 31, ob = rr * 64 + cc * 2; return st * 1024 + (ob ^ (((ob >> 9) & 1) << 5)); }
__host__ __device__ __forceinline__ void stage_rc(int b, int& R, int& C) { const int st = b / 1024, sb = b % 1024, swz = sb ^ (((sb >> 9) & 1) << 5); R = (st >> 1) * 16 + swz / 64; C = (st & 1) * 32 + (swz % 64) / 2; }
__host__ __device__ __forceinline__ int perm32(int rho) { const int n = rho >> 4, i = rho & 15; return 8 * (i >> 2) + 4 * n + (i & 3); }
struct Unit { int pm, pn, sel; };
struct Gemm { const h16* A; const h16* Bt; size_t sa, sb; int M, N, K;
    __device__ __forceinline__ const char* a(int s) const { return (const char*)(A + (size_t)s * sa); }
    __device__ __forceinline__ const char* b(int s) const { return (const char*)(Bt + (size_t)s * sb); } };
struct StaticOrder {
    int nM, nN, nwg, G, c;
    __host__ __device__ void init(int M_, int N_, int G_, int c_) { nM = M_ / BM; nN = N_ / BM; nwg = nM * nN; G = G_; c = c_; }
    __host__ __device__ bool next(int i, Unit& u) const {
        const long L = (long)i * G + c; if (L >= nwg) return false;
        int wgid = (int)L; { const int q = nwg / NXCD, r = nwg % NXCD, xcd = wgid % NXCD, off = wgid / NXCD; wgid = (xcd < r ? xcd * (q + 1) : r * (q + 1) + (xcd - r) * q) + off; }
        const int nig = WGM * nN, gid = wgid / nig, fm = gid * WGM, gsz = (nM - fm) < WGM ? (nM - fm) : WGM;
        u.pm = fm + ((wgid % nig) % gsz); u.pn = (wgid % nig) / gsz; u.sel = 0; return true;
    }
};
template <int NSEL> struct MultiOrder {
    StaticOrder S;
    __host__ __device__ void init(int M_, int N_, int G_, int c_) { S.init(M_, N_, G_, c_); }
    __host__ __device__ bool next(int i, Unit& u) const { const bool ok = S.next(i / NSEL, u); u.sel = i % NSEL; return ok; }
};

template <class Epi, class Sched>
__device__ __forceinline__ void gemm_phase(LAS unsigned char* lds, const Gemm g, const Sched& S, const Epi& E) {
    int tid = threadIdx.x; LAUNDER(tid);
    const int wid = __builtin_amdgcn_readfirstlane(tid >> 6), lane = tid & 63, wr = wid >> 2, wc = wid & 3, fr = lane & 15, fq = lane >> 4;
    const int K = g.K, nt = K / BK;
    unsigned voffA[2], voffB[2];
#pragma unroll
    for (int i = 0; i < 2; ++i) { int R, C; stage_rc(tid * 16 + i * 8192, R, C); const int Rb = Epi::PERM ? ((R & ~31) + perm32(R & 31)) : R;
        voffA[i] = (unsigned)(R * K + C) * 2u; voffB[i] = (unsigned)(Rb * K + C) * 2u; }
    const size_t kstep = (size_t)(BK * 2);
    const size_t hstep = (size_t)HALF * K * 2;
    const size_t tstep = 2 * hstep;
    const unsigned ldsw = (unsigned)wid * 1024u;
    const int aoff = lds_byte(wr * 64 + fr, fq * 8), boff = lds_byte(wc * 32 + fr, fq * 8);
#define PG8_SA(b, h) (((b) * 2 + (h)) * HTB)
#define PG8_SB(b, h) ((4 + (b) * 2 + (h)) * HTB)
#define PG8_STAGE(bufoff, gbase, voff) do { _Pragma("unroll") for (int _i = 0; _i < 2; ++_i) \
        GLDS16((const char*)(gbase) + (voff)[_i], lds + (bufoff) + ldsw + _i * 8192); } while (0)
#define PG8_LDA(dst, b, h) do { _Pragma("unroll") for (int m = 0; m < 4; ++m) _Pragma("unroll") for (int k = 0; k < 2; ++k) dst[m][k] = *(const LAS h16x8*)(lds + PG8_SA(b, h) + aoff + m * 2048 + k * 1024); } while (0)
#define PG8_LDB(dst, b, h) do { _Pragma("unroll") for (int n = 0; n < 2; ++n) _Pragma("unroll") for (int k = 0; k < 2; ++k) dst[n][k] = *(const LAS h16x8*)(lds + PG8_SB(b, h) + boff + n * 2048 + k * 1024); } while (0)
#define PG8_MMA(ai, bj, At, Bt) do { SETPRIO(1); _Pragma("unroll") for (int m = 0; m < 4; ++m) _Pragma("unroll") for (int n = 0; n < 2; ++n) _Pragma("unroll") for (int k = 0; k < 2; ++k) \
        acc[ai][bj][m][n] = MFMA16(Bt[n][k], At[m][k], acc[ai][bj][m][n]); SETPRIO(0); } while (0)
    Unit cur, nxt; int ui = 0;
    if (!S.next(0, cur)) return;
    f32x4 acc[2][2][4][2];
#if defined(HOST_SIM) && defined(SIM_FAST_GEMM)
    for (;; ++ui) {
        if (!S.next(ui, cur)) break;
        const h16* Ap = (const h16*)g.a(cur.sel); const h16* Bp = (const h16*)g.b(cur.sel);
        for (int ai = 0; ai < 2; ++ai) for (int bj = 0; bj < 2; ++bj) for (int m = 0; m < 4; ++m) for (int n = 0; n < 2; ++n) for (int j = 0; j < 4; ++j) {
            const int row = cur.pm * 256 + ai * 128 + wr * 64 + m * 16 + fr;
            const int col = cur.pn * 256 + bj * 128 + wc * 32 + (Epi::PERM ? 8 * fq + 4 * n + j : 16 * n + 4 * fq + j);
            float sacc = 0.f; for (int k = 0; k < K; ++k) sacc += (float)Ap[(size_t)row * K + k] * (float)Bp[(size_t)col * K + k];
            acc[ai][bj][m][n][j] = sacc; }
        E(acc, cur, wr, wc, fr, fq);
    }
    (void)nxt; (void)voffA; (void)voffB; (void)aoff; (void)boff; (void)ldsw; (void)kstep; (void)tstep; (void)nt;
    return;
#endif
#pragma unroll
    for (int a = 0; a < 2; ++a)
#pragma unroll
        for (int b = 0; b < 2; ++b)
#pragma unroll
            for (int m = 0; m < 4; ++m)
#pragma unroll
                for (int n = 0; n < 2; ++n) acc[a][b][m][n] = (f32x4){0.f, 0.f, 0.f, 0.f};
    h16x8 At[4][2], B0[2][2], B1[2][2];
    const char* cA = g.a(cur.sel) + (size_t)cur.pm * tstep; const char* cB = g.b(cur.sel) + (size_t)cur.pn * tstep;
    PG8_STAGE(PG8_SB(0, 0), cB, voffB); PG8_STAGE(PG8_SA(0, 0), cA, voffA); PG8_STAGE(PG8_SB(0, 1), cB + hstep, voffB); PG8_STAGE(PG8_SA(0, 1), cA + hstep, voffA);
    if (wr == 1) SBAR;
    WAIT_V(4); SBAR;
    PG8_STAGE(PG8_SB(1, 0), cB + kstep, voffB); PG8_STAGE(PG8_SA(1, 0), cA + kstep, voffA); PG8_STAGE(PG8_SB(1, 1), cB + hstep + kstep, voffB);
    WAIT_V(6); SBAR;
    for (;;) {
        const bool has_next = S.next(ui + 1, nxt);
        const char* nA = has_next ? g.a(nxt.sel) + (size_t)nxt.pm * tstep : cA; const char* nB = has_next ? g.b(nxt.sel) + (size_t)nxt.pn * tstep : cB;
        for (int t = 0; t < nt; t += 2) {
            const bool last = (t == nt - 2);
            const char* a1 = cA + (size_t)(t + 1) * kstep;
            const char* a2 = last ? nA : cA + (size_t)(t + 2) * kstep; const char* b2 = last ? nB : cB + (size_t)(t + 2) * kstep;
            const char* a3 = a2 + kstep; const char* b3 = b2 + kstep;
            PG8_LDB(B0, 0, 0); SCHED; PG8_LDA(At, 0, 0); PG8_STAGE(PG8_SA(1, 1), a1 + hstep, voffA);
            WAIT_L(8); SBAR; WAIT_L(0); PG8_MMA(0, 0, At, B0); SBAR; SCHED;
            PG8_LDB(B1, 0, 1); PG8_STAGE(PG8_SB(0, 0), b2, voffB);
            SBAR; WAIT_L(0); PG8_MMA(0, 1, At, B1); SBAR;
            PG8_LDA(At, 0, 1); PG8_STAGE(PG8_SA(0, 0), a2, voffA);
            SBAR; WAIT_L(0); PG8_MMA(1, 0, At, B0); SBAR; SCHED;
            PG8_STAGE(PG8_SB(0, 1), b2 + hstep, voffB);
            WAIT_V(6); SBAR; PG8_MMA(1, 1, At, B1); SBAR;
            PG8_LDB(B0, 1, 0); SCHED; PG8_LDA(At, 1, 0); PG8_STAGE(PG8_SA(0, 1), a2 + hstep, voffA);
            WAIT_L(8); SBAR; WAIT_L(0); PG8_MMA(0, 0, At, B0); SBAR; SCHED;
            PG8_LDB(B1, 1, 1); PG8_STAGE(PG8_SB(1, 0), b3, voffB);
            SBAR; WAIT_L(0); PG8_MMA(0, 1, At, B1); SBAR;
            PG8_LDA(At, 1, 1); PG8_STAGE(PG8_SA(1, 0), a3, voffA);
            SBAR; WAIT_L(0); PG8_MMA(1, 0, At, B0); SBAR; SCHED;
            PG8_STAGE(PG8_SB(1, 1), b3 + hstep, voffB);
            WAIT_V(6); SBAR; PG8_MMA(1, 1, At, B1); SBAR;
        }
        E(acc, cur, wr, wc, fr, fq);
        if (!has_next) break;
#pragma unroll
        for (int a = 0; a < 2; ++a)
#pragma unroll
            for (int b = 0; b < 2; ++b)
#pragma unroll
                for (int m = 0; m < 4; ++m)
#pragma unroll
                    for (int n = 0; n < 2; ++n) acc[a][b][m][n] = (f32x4){0.f, 0.f, 0.f, 0.f};
        cur = nxt; cA = nA; cB = nB; ++ui;
    }
    WAIT_V(0);
    if (wr == 0) SBAR;
    SBAR;
#undef PG8_SA
#undef PG8_SB
#undef PG8_STAGE
#undef PG8_LDA
#undef PG8_LDB
#undef PG8_MMA
}
}

__device__ __forceinline__ int mod_row(int row) { return row < MP ? 0 : 1 + (row - MP) / DSEQ; }

struct EpiIn {
    static constexpr bool PERM = true;
    h16* Z; float* LOGF; const float* LB;
    __device__ __forceinline__ void operator()(const f32x4 (&acc)[2][2][4][2], const pg8::Unit& u, int wr, int wc, int fr, int fq) const {
        const int colt = u.pn * 256;
        int kind;
        if (colt < 2 * W) kind = 0; else if (colt < 4 * W) kind = 1; else if (colt < 5 * W) kind = 2; else if (colt < C_AG) kind = 0; else if (colt < C_SU) kind = 2;
        else if (colt < C_SG) kind = 0; else if (colt < C_MG) kind = 2; else kind = 3;
        const int row0 = u.pm * 256 + wr * 64 + fr;
        if (kind == 1) {
            const int dir = colt >= 3 * W ? 1 : 0;
#pragma unroll
            for (int bj = 0; bj < 2; ++bj) {
                const int c0 = colt + bj * 128 + wc * 32 + 8 * fq;
                const float* lbp = LB + (size_t)dir * DEPTH * W + (c0 - (2 + dir) * W);
                const f32x4 l0 = *(const f32x4*)lbp, l1 = *(const f32x4*)(lbp + 4);
#pragma unroll
                for (int ai = 0; ai < 2; ++ai)
#pragma unroll
                    for (int m = 0; m < 4; ++m) {
                        const int row = row0 + ai * 128 + m * 16;
                        f32x4 o0, o1;
#pragma unroll
                        for (int j = 0; j < 4; ++j) { o0[j] = __logf(l0[j] + (1.0f - l0[j]) * sigm(acc[ai][bj][m][0][j])); o1[j] = __logf(l1[j] + (1.0f - l1[j]) * sigm(acc[ai][bj][m][1][j])); }
                        float* dst = LOGF + (size_t)row * (2 * W) + (c0 - 2 * W);
                        *(f32x4*)dst = o0; *(f32x4*)(dst + 4) = o1;
                    }
            }
            return;
        }
#pragma unroll
        for (int ai = 0; ai < 2; ++ai)
#pragma unroll
            for (int m = 0; m < 4; ++m) {
                const int row = row0 + ai * 128 + m * 16;
#pragma unroll
                for (int bj = 0; bj < 2; ++bj) {
                    const int c0 = colt + bj * 128 + wc * 32 + 8 * fq;
                    h16x8 o;
#pragma unroll
                    for (int j = 0; j < 4; ++j) {
                        float a = acc[ai][bj][m][0][j], b = acc[ai][bj][m][1][j];
                        if (kind == 2) { a = siluf(a); b = siluf(b); } else if (kind == 3) { a = sigm(a); b = sigm(b); }
                        o[j] = (h16)a; o[4 + j] = (h16)b;
                    }
                    *(h16x8*)(Z + (size_t)row * INC + c0) = o;
                }
            }
    }
};
struct EpiGlu {
    static constexpr bool PERM = true;
    const h16* YS; const h16* Z; h16* OS5;
    __device__ __forceinline__ void operator()(const f32x4 (&acc)[2][2][4][2], const pg8::Unit& u, int wr, int wc, int fr, int fq) const {
        const int colt = u.pn * 256, row0 = u.pm * 256 + wr * 64 + fr;
#pragma unroll
        for (int ai = 0; ai < 2; ++ai) {
            h16x8 ys[4][2], sg[4][2];
#pragma unroll
            for (int m = 0; m < 4; ++m)
#pragma unroll
                for (int bj = 0; bj < 2; ++bj) { const int row = row0 + ai * 128 + m * 16, c0 = colt + bj * 128 + wc * 32 + 8 * fq;
                    ys[m][bj] = *(const h16x8*)(YS + (size_t)row * W + c0); sg[m][bj] = *(const h16x8*)(Z + (size_t)row * INC + C_SG + c0); }
#pragma unroll
            for (int m = 0; m < 4; ++m)
#pragma unroll
                for (int bj = 0; bj < 2; ++bj) { const int row = row0 + ai * 128 + m * 16, c0 = colt + bj * 128 + wc * 32 + 8 * fq;
                    h16x8 o;
#pragma unroll
                    for (int j = 0; j < 4; ++j) { o[j] = (h16)((float)ys[m][bj][j] * sigm(acc[ai][bj][m][0][j]) * (float)sg[m][bj][j]); o[4 + j] = (h16)((float)ys[m][bj][4 + j] * sigm(acc[ai][bj][m][1][j]) * (float)sg[m][bj][4 + j]); }
                    *(h16x8*)(OS5 + (size_t)row * W + c0) = o; }
            CFENCE;
        }
    }
};
struct EpiBr {
    static constexpr bool PERM = true;
    const h16* Z; h16* MG;
    __device__ __forceinline__ void operator()(const f32x4 (&acc)[2][2][4][2], const pg8::Unit& u, int wr, int wc, int fr, int fq) const {
        const int colt = u.pn * 256, row0 = u.pm * 256 + wr * 64 + fr, b = u.sel;
#pragma unroll
        for (int ai = 0; ai < 2; ++ai) {
            h16x8 gt[4][2], pv[4][2];
#pragma unroll
            for (int m = 0; m < 4; ++m)
#pragma unroll
                for (int bj = 0; bj < 2; ++bj) { const int row = row0 + ai * 128 + m * 16, c0 = colt + bj * 128 + wc * 32 + 8 * fq;
                    gt[m][bj] = *(const h16x8*)(Z + (size_t)row * INC + C_MG + (size_t)b * D + c0);
                    pv[m][bj] = gt[m][bj]; if (b > 0) pv[m][bj] = *(const h16x8*)(MG + (size_t)row * D + c0); }
#pragma unroll
            for (int m = 0; m < 4; ++m)
#pragma unroll
                for (int bj = 0; bj < 2; ++bj) { const int row = row0 + ai * 128 + m * 16, c0 = colt + bj * 128 + wc * 32 + 8 * fq;
                    h16x8 a16;
#pragma unroll
                    for (int j = 0; j < 4; ++j) { a16[j] = (h16)acc[ai][bj][m][0][j]; a16[4 + j] = (h16)acc[ai][bj][m][1][j]; }
                    h16x8 o = gt[m][bj] * a16;
                    if (b > 0) o = o + pv[m][bj];
                    *(h16x8*)(MG + (size_t)row * D + c0) = o; }
            CFENCE;
        }
    }
};
struct EpiOut {
    static constexpr bool PERM = false;
    const float* XP; const float* XS; float* X; const float* MOD;
    __device__ __forceinline__ void operator()(const f32x4 (&acc)[2][2][4][2], const pg8::Unit& u, int wr, int wc, int fr, int fq) const {
        const int colt = u.pn * 256, row0 = u.pm * 256 + wr * 64 + fr;
        const float* gate = MOD + (size_t)mod_row(u.pm * 256) * 3 * D + 2 * D;
        f32x4 gv[2][2];
#pragma unroll
        for (int bj = 0; bj < 2; ++bj)
#pragma unroll
            for (int n = 0; n < 2; ++n) gv[bj][n] = *(const f32x4*)(gate + colt + bj * 128 + wc * 32 + 16 * n + 4 * fq);
#pragma unroll
        for (int ai = 0; ai < 2; ++ai)
#pragma unroll
            for (int mp = 0; mp < 2; ++mp) {
                f32x4 xi[2][2][2];
#pragma unroll
                for (int mm = 0; mm < 2; ++mm) { const int row = row0 + ai * 128 + (mp * 2 + mm) * 16; const float* xin = row < MP ? XP + (size_t)row * D : XS + (size_t)(row - MP) * D;
#pragma unroll
                    for (int bj = 0; bj < 2; ++bj)
#pragma unroll
                        for (int n = 0; n < 2; ++n) xi[mm][bj][n] = *(const f32x4*)(xin + colt + bj * 128 + wc * 32 + 16 * n + 4 * fq); }
#pragma unroll
                for (int mm = 0; mm < 2; ++mm) { const int m = mp * 2 + mm, row = row0 + ai * 128 + m * 16;
#pragma unroll
                    for (int bj = 0; bj < 2; ++bj)
#pragma unroll
                        for (int n = 0; n < 2; ++n) *(f32x4*)(X + (size_t)row * D + colt + bj * 128 + wc * 32 + 16 * n + 4 * fq) = xi[mm][bj][n] + gv[bj][n] * acc[ai][bj][m][n]; }
                CFENCE;
            }
    }
};

__device__ __forceinline__ void transpose_cvt(LAS float* tile, const float* src, h16* dst, int K, int N, int bid, int G) {
    const int nkt = K / 64, nnt = N / 64, tid = threadIdx.x;
    for (int t = bid; t < nkt * nnt; t += G) {
        const int kt = t / nnt, ntile = t % nnt;
#pragma unroll
        for (int i = 0; i < 8; ++i) { const int idx = tid + i * 512, k = idx >> 6, n = idx & 63; tile[k * 65 + n] = src[(size_t)(kt * 64 + k) * N + ntile * 64 + n]; }
        __syncthreads();
#pragma unroll
        for (int i = 0; i < 8; ++i) { const int idx = tid + i * 512, n = idx >> 6, k = idx & 63; dst[(size_t)(ntile * 64 + n) * K + kt * 64 + k] = (h16)tile[k * 65 + n]; }
        __syncthreads();
    }
}
__device__ __forceinline__ void phase_prologue(const Params& p, LAS unsigned char* lds) {
    const int tid = threadIdx.x, bid = blockIdx.x, G = gridDim.x;
    unsigned char* ws = p.ws;
    {
        const int nitems = DEPTH * (3 * D / 128);
        if (bid < nitems) {
            LAS float* sc = (LAS float*)lds;
            LAS float* red = sc + NMODR * D;
            for (int i = tid; i < NMODR * D; i += NTHREADS) { const int r = i / D, k = i % D; const float c = r == 0 ? p.in[I_CCTX][k] : p.in[I_C][(size_t)(r - 1) * D + k]; sc[i] = siluf(c); }
            __syncthreads();
            for (int it = bid; it < nitems; it += G) {
                const int l = it / (3 * D / 128), j = (it % (3 * D / 128)) * 128 + (tid & 127), kg = tid >> 7;
                float a[NMODR];
#pragma unroll
                for (int r = 0; r < NMODR; ++r) a[r] = 0.f;
                const float* wp = p.in[I_WMOD] + (size_t)l * D * 3 * D + j;
                for (int k = kg * (D / 4); k < (kg + 1) * (D / 4); k += 8) { float w8[8];
#pragma unroll
                    for (int kk = 0; kk < 8; ++kk) w8[kk] = wp[(size_t)(k + kk) * 3 * D];
#pragma unroll
                    for (int kk = 0; kk < 8; ++kk)
#pragma unroll
                        for (int r = 0; r < NMODR; ++r) a[r] += sc[r * D + k + kk] * w8[kk]; }
#pragma unroll
                for (int r = 0; r < NMODR; ++r) red[(kg * NMODR + r) * 128 + (tid & 127)] = a[r];
                __syncthreads();
                for (int i = tid; i < NMODR * 128; i += NTHREADS) { const int r = i / 128, jj = i % 128; const int jcol = (it % (3 * D / 128)) * 128 + jj;
                    const float s = red[(0 * NMODR + r) * 128 + jj] + red[(1 * NMODR + r) * 128 + jj] + red[(2 * NMODR + r) * 128 + jj] + red[(3 * NMODR + r) * 128 + jj];
                    ((float*)(ws + WS_MOD))[((size_t)l * NMODR + r) * 3 * D + jcol] = s + p.in[I_BMOD][(size_t)l * 3 * D + jcol]; }
                __syncthreads();
            }
        }
        __syncthreads();
    }
    for (int i = bid * NTHREADS + tid; i < 2 * W; i += G * NTHREADS) {
        const int dir = i / W, w = i % W; const float* lg = p.in[I_LBL] + (size_t)dir * DEPTH * W + w;
        float mx = -1e30f; for (int l = 0; l < DEPTH; ++l) mx = fmaxf(mx, lg[(size_t)l * W]);
        float den = 0.f; for (int l = 0; l < DEPTH; ++l) den += __expf(lg[(size_t)l * W] - mx);
        float cs = 0.f, first = 0.f;
        for (int l = 0; l < DEPTH; ++l) { cs += __expf(lg[(size_t)l * W] - mx) / den; if (l == 0) first = cs; ((float*)(ws + WS_LB))[((size_t)dir * DEPTH + l) * W + w] = cs - first; }
    }
    for (int i = bid * NTHREADS + tid; i < DEPTH * 2 * S5G * S5P; i += G * NTHREADS) {
        const int gidx = i / S5P;
        const float are = p.in[I_ARE][i], aim = p.in[I_AIM][i], dt = __expf(p.in[I_LDT][gidx]);
        const float mag = expf(are * dt), abr = mag * cosf(aim * dt), abi = mag * sinf(aim * dt);
        const float den = are * are + aim * aim, nre = abr - 1.0f;
        const float cre = (nre * are + abi * aim) / den, cim = (abi * are - nre * aim) / den;
        ((f32x2*)(ws + WS_ABAR))[i] = (f32x2){abr, abi};
        h16* bb = (h16*)(ws + WS_BBAR) + (size_t)i * 32;
        for (int c = 0; c < 16; ++c) { const float br = p.in[I_BRE][(size_t)i * 16 + c], bi = p.in[I_BIM][(size_t)i * 16 + c]; bb[c] = (h16)(cre * br - cim * bi); bb[16 + c] = (h16)(cre * bi + cim * br); }
    }
    for (int i = bid * NTHREADS + tid; i < DEPTH * 2 * S5G * 256; i += G * NTHREADS) {
        const int lane = i & 63, pt = (i >> 6) & 3, ldg = i >> 8, lr = lane & 15, q = lane >> 4;
        const int pi = ldg * S5P + lr + 16 * pt;
        const float are = p.in[I_ARE][pi], aim = p.in[I_AIM][pi], dt = __expf(p.in[I_LDT][ldg]);
        const float mag = expf(are * dt), abr = mag * cosf(aim * dt), abi = mag * sinf(aim * dt);
        const float den = are * are + aim * aim, nre = abr - 1.0f;
        const float cre = (nre * are + abi * aim) / den, cim = (abi * are - nre * aim) / den;
        float pr = abr, pim = abi;
        float a16r, a16i, a32r, a32i;
        for (int k = 0; k < 4; ++k) { const float nr = pr * pr - pim * pim, ni = 2.0f * pr * pim; pr = nr; pim = ni; }
        a16r = pr; a16i = pim; a32r = pr * pr - pim * pim; a32i = 2.0f * pr * pim;
        const float a48r = a32r * a16r - a32i * a16i, a48i = a32r * a16i + a32i * a16r, a64r = a32r * a32r - a32i * a32i, a64i = 2.0f * a32r * a32i;
        float* tb = (float*)(ws + WS_S5T) + (size_t)i * 12;
        tb[0] = abr; tb[1] = abi; tb[2] = a16r; tb[3] = a16i; tb[4] = a32r; tb[5] = a32i;
        tb[6] = q == 0 ? a16r : (q == 1 ? a32r : (q == 2 ? a48r : a64r)); tb[7] = q == 0 ? a16i : (q == 1 ? a32i : (q == 2 ? a48i : a64i));
        h16* hb = (h16*)(tb + 8);
        for (int j = 0; j < 4; ++j) { const float br = p.in[I_BRE][(size_t)pi * 16 + 4 * q + j], bi = p.in[I_BIM][(size_t)pi * 16 + 4 * q + j]; hb[j] = (h16)(cre * br - cim * bi); hb[4 + j] = (h16)(cre * bi + cim * br); }
    }
    for (int i = bid * NTHREADS + tid; i < DEPTH * S5G * 256; i += G * NTHREADS) {
        const int ks = i & 3, lane = (i >> 2) & 63, lg = i >> 8, lr = lane & 15, q = lane >> 4;
        h16* cb = (h16*)(ws + WS_S5C) + (size_t)i * 8;
        for (int j = 0; j < 8; ++j) { const int pp = 4 * ks + q + 16 * (j >> 1); const size_t ci = ((size_t)lg * 16 + lr) * S5P + pp; cb[j] = (j & 1) ? (h16)(-p.in[I_CIM][ci]) : (h16)p.in[I_CRE][ci]; }
    }
    for (int i = bid * NTHREADS + tid; i < (DSEQ / 64 + 64) * 32; i += G * NTHREADS) {
        const int pos = i / 32, j = i % 32; const float inv = exp2f(-(float)j * (13.287712379549449f / 32.0f));
        const float ang = (float)(pos < DSEQ / 64 ? pos : pos - DSEQ / 64) * inv;
        ((f32x2*)(ws + WS_ROPE))[i] = (f32x2){cosf(ang), sinf(ang)};
    }
    LAS float* tile = (LAS float*)lds;
    for (int l = 0; l < DEPTH; ++l) {
        transpose_cvt(tile, p.in[I_WIN] + (size_t)l * D * INC, (h16*)(ws + WS_WIN) + (size_t)l * INC * D, D, INC, bid, G);
        transpose_cvt(tile, p.in[I_WGLU] + (size_t)l * W * W, (h16*)(ws + WS_WGLU) + (size_t)l * W * W, W, W, bid, G);
        transpose_cvt(tile, p.in[I_WBRHG] + (size_t)l * W * D, (h16*)(ws + WS_WBR) + (size_t)(l * 3 + 0) * D * W, W, D, bid, G);
        transpose_cvt(tile, p.in[I_WBRAT] + (size_t)l * W * D, (h16*)(ws + WS_WBR) + (size_t)(l * 3 + 1) * D * W, W, D, bid, G);
        transpose_cvt(tile, p.in[I_WBRS5] + (size_t)l * W * D, (h16*)(ws + WS_WBR) + (size_t)(l * 3 + 2) * D * W, W, D, bid, G);
        transpose_cvt(tile, p.in[I_WOUT] + (size_t)l * D * D, (h16*)(ws + WS_WOUT) + (size_t)l * D * D, D, D, bid, G);
    }
}

__device__ __forceinline__ void phase_norm(const Params& p, int l) {
    int tid_ = threadIdx.x; LAUNDER(tid_);
    const int lane = tid_ & 63, gw = blockIdx.x * NWAVES + (tid_ >> 6), nw = gridDim.x * NWAVES;
    const float* nwt = p.in[I_NORMW] + (size_t)l * D;
    const float* MOD = (const float*)(p.ws + WS_MOD) + (size_t)l * NMODR * 3 * D;
    h16* H = (h16*)(p.ws + WS_H);
    for (int row = gw; row < M; row += nw) {
        const float* x = l == 0 ? (row < MP ? p.in[I_XP] + (size_t)row * D : p.in[I_XS] + (size_t)(row - MP) * D) : (const float*)(p.ws + WS_X) + (size_t)row * D;
        f32x4 v[D / 256]; float ss = 0.f;
#pragma unroll
        for (int i = 0; i < D / 256; ++i) { v[i] = *(const f32x4*)(x + i * 256 + lane * 4); ss += v[i][0] * v[i][0] + v[i][1] * v[i][1] + v[i][2] * v[i][2] + v[i][3] * v[i][3]; }
        ss = wave_sum(ss, lane);
        const float rstd = rsqrtf(ss / (float)D + EPS);
        const float* md = MOD + (size_t)mod_row(row) * 3 * D;
#pragma unroll
        for (int i = 0; i < D / 256; ++i) { const int c = i * 256 + lane * 4; const f32x4 wv = *(const f32x4*)(nwt + c), sh = *(const f32x4*)(md + c), scl = *(const f32x4*)(md + D + c);
            h16x4 o;
#pragma unroll
            for (int j = 0; j < 4; ++j) o[j] = (h16)(v[i][j] * rstd * wv[j] * (1.0f + scl[j]) + sh[j]);
            *(h16x4*)(H + (size_t)row * D + c) = o; }
    }
}
__device__ __forceinline__ void phase_final(const Params& p) {
    int tid_ = threadIdx.x; LAUNDER(tid_);
    const int lane = tid_ & 63, gw = blockIdx.x * NWAVES + (tid_ >> 6), nw = gridDim.x * NWAVES;
    const float* fw = p.in[I_FNORM];
    for (int row = gw; row < M; row += nw) {
        const float* x = (const float*)(p.ws + WS_X) + (size_t)row * D;
        f32x4 v[D / 256]; float ss = 0.f;
#pragma unroll
        for (int i = 0; i < D / 256; ++i) { v[i] = *(const f32x4*)(x + i * 256 + lane * 4); ss += v[i][0] * v[i][0] + v[i][1] * v[i][1] + v[i][2] * v[i][2] + v[i][3] * v[i][3]; }
        ss = wave_sum(ss, lane);
        const float rstd = rsqrtf(ss / (float)D + EPS);
#pragma unroll
        for (int i = 0; i < D / 256; ++i) { const int c = i * 256 + lane * 4; const f32x4 wv = *(const f32x4*)(fw + c);
            *(f32x4*)(p.out + O_Y + (size_t)row * D + c) = v[i] * rstd * wv; }
    }
}

constexpr int PV_LS = 264;
__device__ __forceinline__ void prep_vt_store(LAS h16* VL, h16* VTrow0, int NKs, int pos0, int tid) {
#pragma unroll
    for (int i = 0; i < KVW * 8 / NTHREADS; ++i) { const int id = tid + NTHREADS * i, dk = id >> 3, tc = id & 7; h16x8 o;
#pragma unroll
        for (int j = 0; j < 8; ++j) o[j] = VL[(tc * 8 + j) * PV_LS + dk];
        *(h16x8*)(VTrow0 + (size_t)dk * NKs + pos0 + tc * 8) = o; }
}
__device__ __forceinline__ void prep_tile(const Params& p, int l, int tile, LAS unsigned char* lds) {
    int tid = threadIdx.x; LAUNDER(tid);
    const int w = tid >> 6, lane = tid & 63;
    LAS h16* VL = (LAS h16*)lds;
    constexpr int NT_REAL = M / 64;
    if (tile >= NT_REAL) {
        const int ct = tile - NT_REAL, b = ct / (PAST / 64), pos0 = (ct % (PAST / 64)) * 64;
        const float* ck = p.in[I_CK] + (((size_t)b * DEPTH + l) * PAST + pos0) * KVW; const float* cv = p.in[I_CV] + (((size_t)b * DEPTH + l) * PAST + pos0) * KVW;
        h16* kd = (h16*)(p.ws + WS_KBS) + ((size_t)b * KVLEN + pos0) * KVW;
#pragma unroll
        for (int i = 0; i < 64 * KVW / 8 / NTHREADS; ++i) { const int id = tid + NTHREADS * i, row = id / (KVW / 8), c = id % (KVW / 8);
            const f32x4 k0 = *(const f32x4*)(ck + (size_t)row * KVW + c * 8), k1 = *(const f32x4*)(ck + (size_t)row * KVW + c * 8 + 4);
            const f32x4 v0 = *(const f32x4*)(cv + (size_t)row * KVW + c * 8), v1 = *(const f32x4*)(cv + (size_t)row * KVW + c * 8 + 4);
            h16x8 ko, vo;
#pragma unroll
            for (int j = 0; j < 4; ++j) { ko[j] = (h16)k0[j]; ko[4 + j] = (h16)k1[j]; vo[j] = (h16)v0[j]; vo[4 + j] = (h16)v1[j]; }
            *(h16x8*)(kd + (size_t)row * KVW + c * 8) = ko; *(LAS h16x8*)(VL + row * PV_LS + c * 8) = vo; }
        __syncthreads();
        prep_vt_store(VL, (h16*)(p.ws + WS_VBS) + (size_t)b * KVW * KVLEN, KVLEN, pos0, tid);
        __syncthreads();
        return;
    }
    const int r0 = tile * 64; const bool smp = r0 >= MP;
    const int b = smp ? (r0 - MP) / DSEQ : r0 / SEQ, t0 = smp ? (r0 - MP) % DSEQ : r0 % SEQ;
    const h16* Z = (const h16*)(p.ws + WS_Z);
#pragma unroll
    for (int i = 0; i < 64 * KVW / 8 / NTHREADS; ++i) { const int id = tid + NTHREADS * i, row = id / (KVW / 8), c = id % (KVW / 8);
        const h16x8 v = *(const h16x8*)(Z + (size_t)(r0 + row) * INC + C_AV + c * 8);
        *(LAS h16x8*)(VL + row * PV_LS + c * 8) = v;
        if (!smp) { float* cvo = p.out + O_CV + (((size_t)b * DEPTH + l) * SEQ + t0 + row) * KVW + c * 8; f32x4 a, bq;
#pragma unroll
            for (int j = 0; j < 4; ++j) { a[j] = (float)v[j]; bq[j] = (float)v[4 + j]; }
            *(f32x4*)cvo = a; *(f32x4*)(cvo + 4) = bq; } }
    __syncthreads();
    if (smp) prep_vt_store(VL, (h16*)(p.ws + WS_VBS) + (size_t)b * KVW * KVLEN, KVLEN, PAST + t0, tid);
    else prep_vt_store(VL, (h16*)(p.ws + WS_VBC) + (size_t)b * KVW * SEQ, SEQ, t0, tid);
    constexpr int NH = AQH + AKVH;
    const float wq0 = p.in[I_QNORM][(size_t)l * 128 + lane], wq1 = p.in[I_QNORM][(size_t)l * 128 + lane + 64], wk0 = p.in[I_KNORM][(size_t)l * 128 + lane], wk1 = p.in[I_KNORM][(size_t)l * 128 + lane + 64];
    const f32x2* ROPE = (const f32x2*)(p.ws + WS_ROPE);
    constexpr int PQN = 16;
    for (int it0 = w; it0 < 64 * NH; it0 += PQN * NWAVES) {
        float x0[PQN], x1[PQN]; f32x2 cr[PQN], cc[PQN];
#pragma unroll
        for (int k = 0; k < PQN; ++k) { const int it = it0 + k * NWAVES; x0[k] = 0.f; x1[k] = 0.f; if (it >= 64 * NH) continue; const int row = it / NH, hh = it % NH; const bool isq = hh < AQH;
            const h16* src = Z + (size_t)(r0 + row) * INC + (isq ? C_AQ + hh * 128 : C_AK + (hh - AQH) * 128);
            x0[k] = (float)src[lane]; x1[k] = (float)src[lane + 64];
            if (smp) { const int t = t0 + row; cr[k] = ROPE[(t / 64) * 32 + (lane & 31)]; cc[k] = ROPE[(DSEQ / 64 + (t % 64)) * 32 + (lane & 31)]; } }
#pragma unroll
        for (int k = 0; k < PQN; ++k) { const int it = it0 + k * NWAVES; if (it >= 64 * NH) continue; const int row = it / NH, hh = it % NH; const bool isq = hh < AQH; const int t = t0 + row;
            const float ss = wave_sum(x0[k] * x0[k] + x1[k] * x1[k], lane);
            const float rstd = rsqrtf(ss * (1.0f / 128.0f) + EPS);
            float a0 = x0[k] * rstd * (isq ? wq0 : wk0), a1 = x1[k] * rstd * (isq ? wq1 : wk1);
            if (!isq && !smp) { float* cko = p.out + O_CK + (((size_t)b * DEPTH + l) * SEQ + t) * KVW + (hh - AQH) * 128; cko[lane] = a0; cko[lane + 64] = a1; }
            if (smp) { const float p0 = shfl_xor_l(a0, 32, lane), p1 = shfl_xor_l(a1, 32, lane);
                a0 = lane < 32 ? a0 * cr[k][0] - p0 * cr[k][1] : a0 * cr[k][0] + p0 * cr[k][1];
                a1 = lane < 32 ? a1 * cc[k][0] - p1 * cc[k][1] : a1 * cc[k][0] + p1 * cc[k][1]; }
            if (isq) { h16* dst = (h16*)(p.ws + WS_AQ2) + (size_t)(r0 + row) * W + hh * 128; const float sc = 0.08838834764831845f; dst[lane] = (h16)(a0 * sc); dst[lane + 64] = (h16)(a1 * sc); }
            else { h16* dst = (smp ? (h16*)(p.ws + WS_KBS) + ((size_t)b * KVLEN + PAST + t) * KVW : (h16*)(p.ws + WS_KBC) + ((size_t)b * SEQ + t) * KVW) + (hh - AQH) * 128; dst[lane] = (h16)a0; dst[lane + 64] = (h16)a1; } }
    }
    __syncthreads();
}
constexpr int S5_STS = 136, S5_WAVE_LDS = 64 * S5_STS * 2;
static_assert(NWAVES * S5_WAVE_LDS <= MISC_OFF, "S5 LDS");
struct cpx { float r, i; };
__device__ __forceinline__ cpx cmulf(cpx a, cpx b) { return cpx{a.r * b.r - a.i * b.i, a.r * b.i + a.i * b.r}; }
__device__ __forceinline__ cpx cfma(cpx a, cpx b, cpx c) { return cpx{a.r * b.r - a.i * b.i + c.r, a.r * b.i + a.i * b.r + c.i}; }
__device__ __forceinline__ cpx cshfl_up(cpx v, int d, int lane) { return cpx{shfl_up_l(v.r, d, lane), shfl_up_l(v.i, d, lane)}; }
__device__ __forceinline__ void c_s5(const Params& p, int l, int item, int lane, LAS unsigned char* ldsw) {
    const int dir = item & 1, g = (item >> 1) % S5G, sq = (item >> 1) / S5G;
    const bool smp = sq < DBATCH; const int b = smp ? sq : sq - DBATCH;
    const int T = smp ? DSEQ : SEQ, row0 = smp ? MP + b * DSEQ : b * SEQ;
    const h16* Z = (const h16*)(p.ws + WS_Z);
    h16* Y = (h16*)(p.ws + (dir ? WS_YB : WS_YF));
    LAS h16* ST = (LAS h16*)ldsw;
    const int lr = lane & 15, q = lane >> 4;
    cpx sp0 = cpx{0.f, 0.f}, sp1 = sp0, sp2 = sp0, sp3 = sp0;
    h16x8 cfr[4];
    if (smp) { const size_t si0 = (((size_t)b * DEPTH + l) * 2 + dir) * S5G * S5P + (size_t)g * S5P + lr;
        sp0 = cpx{p.in[I_SR][si0], p.in[I_SI][si0]}; sp1 = cpx{p.in[I_SR][si0 + 16], p.in[I_SI][si0 + 16]}; sp2 = cpx{p.in[I_SR][si0 + 32], p.in[I_SI][si0 + 32]}; sp3 = cpx{p.in[I_SR][si0 + 48], p.in[I_SI][si0 + 48]}; }
    { const h16x8* cb = (const h16x8*)(p.ws + WS_S5C) + (((size_t)l * S5G + g) * 64 + lane) * 4;
#pragma unroll
      for (int ks = 0; ks < 4; ++ks) cfr[ks] = cb[ks]; }
    const f32x4* tab = (const f32x4*)(p.ws + WS_S5T) + ((((size_t)l * 2 + dir) * S5G + g) * 256 + lane) * 3;
    f32x4 tn0 = tab[0], tn1 = tab[1], tn2 = tab[2];
    const int NB = T / 64;
    const int tb0 = 16 * (lr >> 2) + (lr & 3);
    h16x4 uf[4], un[4];
#define S5_ULOAD(U, bk) do { _Pragma("unroll") for (int k = 0; k < 4; ++k) { const int tt = (bk) * 64 + tb0 + 4 * k; const int row = row0 + (dir ? T - 1 - tt : tt); \
        U[k] = *(const h16x4*)(Z + (size_t)row * INC + C_SU + g * 16 + 4 * q); } } while (0)
    S5_ULOAD(un, 0);
#pragma unroll 1
    for (int blk = 0; blk < NB; ++blk) {
#pragma unroll
        for (int k = 0; k < 4; ++k) uf[k] = un[k];
        { const int nb = blk + 1 < NB ? blk + 1 : blk; S5_ULOAD(un, nb); }
#pragma unroll 1
        for (int pt = 0; pt < 4; ++pt) {
            const f32x4 tc0 = tn0, tc1 = tn1, tc2 = tn2;
            { const f32x4* tp = tab + (size_t)((pt + 1) & 3) * 192; tn0 = tp[0]; tn1 = tp[1]; tn2 = tp[2]; }
            const cpx a1 = cpx{tc0[0], tc0[1]}, a16 = cpx{tc0[2], tc0[3]}, a32 = cpx{tc1[0], tc1[1]}, apq = cpx{tc1[2], tc1[3]};
            const h16x8 bfr = __builtin_bit_cast(h16x8, tc2);
            const h16x4 bre = {bfr[0], bfr[1], bfr[2], bfr[3]}, bim = {bfr[4], bfr[5], bfr[6], bfr[7]};
            const cpx a16m = cpx{q >= 1 ? a16.r : 0.f, q >= 1 ? a16.i : 0.f}, a32m = cpx{q >= 2 ? a32.r : 0.f, q >= 2 ? a32.i : 0.f};
            const cpx sp = cpx{pt == 0 ? sp0.r : (pt == 1 ? sp1.r : (pt == 2 ? sp2.r : sp3.r)), pt == 0 ? sp0.i : (pt == 1 ? sp1.i : (pt == 2 ? sp2.i : sp3.i))};
            f32x4 zr[4], zi[4];
#pragma unroll
            for (int k = 0; k < 4; ++k) { zr[k] = (f32x4){0.f, 0.f, 0.f, 0.f}; zi[k] = (f32x4){0.f, 0.f, 0.f, 0.f}; zr[k] = MFMA16K16(uf[k], bre, zr[k]); zi[k] = MFMA16K16(uf[k], bim, zi[k]); }
            cpx e = cpx{zr[0][0], zi[0][0]};
#pragma unroll
            for (int j = 1; j < 16; ++j) e = cfma(a1, e, cpx{zr[j >> 2][j & 3], zi[j >> 2][j & 3]});
            { const cpx er = cshfl_up(e, 16, lane); e = cfma(a16m, er, e); }
            { const cpx er = cshfl_up(e, 32, lane); e = cfma(a32m, er, e); }
            const cpx E = cfma(apq, sp, e);
            const cpx Eup = cshfl_up(E, 16, lane);
            cpx zc = cpx{q == 0 ? sp.r : Eup.r, q == 0 ? sp.i : Eup.i};
            const cpx spn = cpx{shfl_l(E.r, lr + 48), shfl_l(E.i, lr + 48)};
            if (pt == 0) sp0 = spn; else if (pt == 1) sp1 = spn; else if (pt == 2) sp2 = spn; else sp3 = spn;
#pragma unroll
            for (int j = 0; j < 16; ++j) { zc = cfma(a1, zc, cpx{zr[j >> 2][j & 3], zi[j >> 2][j & 3]});
                *(LAS unsigned*)(ST + (16 * q + j) * S5_STS + 8 * lr + 2 * pt) = cvtpk_h(zc.r, zc.i); }
        }
        WAVE_LDS_SYNC();
#pragma unroll
        for (int m = 0; m < 4; ++m) {
            f32x4 acc = (f32x4){0.f, 0.f, 0.f, 0.f};
#pragma unroll
            for (int ks = 0; ks < 4; ++ks) { const h16x8 afr = *(const LAS h16x8*)(ST + (16 * m + lr) * S5_STS + 32 * ks + 8 * q); acc = MFMA16(afr, cfr[ks], acc); }
#pragma unroll
            for (int i = 0; i < 4; ++i) { const int tt = blk * 64 + 16 * m + 4 * q + i; const int row = row0 + (dir ? T - 1 - tt : tt); Y[(size_t)row * W + g * 16 + lr] = (h16)acc[i]; }
        }
        WAVE_LDS_SYNC();
    }
#undef S5_ULOAD
    if (!smp && q == 0) {
#pragma unroll
        for (int pt = 0; pt < 4; ++pt) { const size_t so = (((size_t)b * DEPTH + l) * 2 + dir) * S5G * S5P + (size_t)g * S5P + lr + 16 * pt; const cpx sv = pt == 0 ? sp0 : (pt == 1 ? sp1 : (pt == 2 ? sp2 : sp3)); p.out[O_SR + so] = sv.r; p.out[O_SI + so] = sv.i; }
    }
}
typedef __bf16 bf16;
typedef bf16 bf16x8 __attribute__((ext_vector_type(8)));
typedef bf16 bf16x4 __attribute__((ext_vector_type(4)));
#ifdef HOST_SIM
#define MFMA16B(a, b, c) sim::mfma16<0>(&(a), &(b), c)
#else
#define MFMA16B(a, b, c) __builtin_amdgcn_mfma_f32_16x16x32_bf16(a, b, c, 0, 0, 0)
#endif
constexpr int HS_QK = 136, HS_T = 40;
constexpr int HG_QH = 0, HG_KH = HG_QH + 32 * HS_QK * 2, HG_KHT = HG_KH + 32 * HS_QK * 2, HG_VT = HG_KHT + 128 * HS_T * 2, HG_P = HG_VT + 2 * 128 * HS_T * 2,
              HG_SST = HG_P + 2 * 32 * HS_T * 2, HG_END = HG_SST + 128 * HS_QK * 2;
static_assert(HG_END <= STAGE_BYTES, "hgrn LDS");
__device__ __forceinline__ void hgrn_item(const Params& p, int l, int sq, int h, int dir, LAS unsigned char* lds) {
    int tid = threadIdx.x; LAUNDER(tid);
    const int w = tid >> 6, lane = tid & 63, lr = lane & 15, lq = lane >> 4;
    const bool smp = sq < DBATCH; const int b = smp ? sq : sq - DBATCH;
    const int T = smp ? DSEQ : SEQ, row0 = smp ? MP + b * DSEQ : b * SEQ, NC = T / 32;
    const h16* Z = (const h16*)(p.ws + WS_Z); const float* LOGF = (const float*)(p.ws + WS_LOGF);
    h16* O = (h16*)(p.ws + (dir ? WS_OB : WS_OF));
    LAS bf16* QH = (LAS bf16*)(lds + HG_QH); LAS bf16* KH = (LAS bf16*)(lds + HG_KH); LAS bf16* KHT = (LAS bf16*)(lds + HG_KHT);
    LAS bf16* VT = (LAS bf16*)(lds + HG_VT); LAS bf16* PP = (LAS bf16*)(lds + HG_P); LAS bf16* SST = (LAS bf16*)(lds + HG_SST);
    const int dcol = 16 * w + lr;
    f32x4 S[8];
    if (smp) { const float* s0 = p.in[I_SH] + ((((size_t)b * DEPTH + l) * 2 + dir) * HGH + h) * 128 * 128;
#pragma unroll
        for (int vt = 0; vt < 8; ++vt)
#pragma unroll
            for (int i = 0; i < 4; ++i) S[vt][i] = s0[(size_t)(16 * w + 4 * lq + i) * 128 + 16 * vt + lr]; }
    else {
#pragma unroll
        for (int vt = 0; vt < 8; ++vt) S[vt] = (f32x4){0.f, 0.f, 0.f, 0.f}; }
    float lf[8]; h16 qv[8], vv[8];
    const unsigned voffz = (unsigned)(((dir ? 31 - 8 * lq : 8 * lq) * INC + h * 128 + dcol) * 2);
    const unsigned voffl = (unsigned)(((dir ? 31 - 8 * lq : 8 * lq) * 2 * W + dir * W + h * 128 + dcol) * 4);
    const unsigned voffo = (unsigned)(((dir ? 31 - 4 * lq : 4 * lq) * W + h * 128 + 16 * w + lr) * 2);
    const long sgn = dir ? -1 : 1;
#define HG_LOAD(c) do { const int rlo = dir ? row0 + T - 32 * (c) - 32 : row0 + 32 * (c); const char* zb = (const char*)Z + (size_t)rlo * INC * 2; const char* lb = (const char*)LOGF + (size_t)rlo * 2 * W * 4; \
        _Pragma("unroll") for (int i = 0; i < 8; ++i) { const char* zi_ = zb + sgn * i * (long)(INC * 2); const char* li_ = lb + sgn * i * (long)(2 * W * 4); \
            lf[i] = *(const float*)(li_ + voffl); qv[i] = *(const h16*)(zi_ + C_HQ * 2 + voffz); vv[i] = *(const h16*)(zi_ + C_HI * 2 + voffz); } } while (0)
    HG_LOAD(0);
    for (int c = 0; c < NC; ++c) {
        const int buf = c & 1;
        float bc[8]; float run = 0.f;
#pragma unroll
        for (int i = 0; i < 8; ++i) { run += lf[i]; bc[i] = run; }
        const float t0 = shfl_l(run, lr), t1 = shfl_l(run, lr + 16), t2 = shfl_l(run, lr + 32), t3 = shfl_l(run, lr + 48);
        const float pre = (lq > 0 ? t0 : 0.f) + (lq > 1 ? t1 : 0.f) + (lq > 2 ? t2 : 0.f), bl = (t0 + t1) + (t2 + t3);
        bf16x8 kht, vtv;
#pragma unroll
        for (int i = 0; i < 8; ++i) { const float bi = pre + bc[i]; const float kk = (1.0f - __expf(lf[i])) * __expf(bl - bi), qq = (float)qv[i] * __expf(bi - bl);
            const int t = 8 * lq + i; QH[t * HS_QK + dcol] = (bf16)qq; KH[t * HS_QK + dcol] = (bf16)kk; kht[i] = (bf16)kk; vtv[i] = (bf16)(float)vv[i]; }
        *(LAS bf16x8*)(KHT + dcol * HS_T + 8 * lq) = kht;
        *(LAS bf16x8*)(VT + buf * 128 * HS_T + dcol * HS_T + 8 * lq) = vtv;
        const float ebl = __expf(bl);
#pragma unroll
        for (int i = 0; i < 4; ++i) { const float e = shfl_l(ebl, 4 * lq + i);
#pragma unroll
            for (int vt = 0; vt < 8; ++vt) S[vt][i] *= e; }
#pragma unroll
        for (int vt = 0; vt < 8; ++vt) { bf16x4 sv; sv[0] = (bf16)S[vt][0]; sv[1] = (bf16)S[vt][1]; sv[2] = (bf16)S[vt][2]; sv[3] = (bf16)S[vt][3];
            *(LAS bf16x4*)(SST + (16 * vt + lr) * HS_QK + 16 * w + 4 * lq) = sv; }
        if (c + 1 < NC) HG_LOAD(c + 1);
        __syncthreads();
        f32x4 oi[2] = {(f32x4){0.f, 0.f, 0.f, 0.f}, (f32x4){0.f, 0.f, 0.f, 0.f}};
#pragma unroll
        for (int ks = 0; ks < 4; ++ks) { const bf16x8 bfr = *(const LAS bf16x8*)(SST + (16 * w + lr) * HS_QK + 32 * ks + 8 * lq);
#pragma unroll
            for (int ti = 0; ti < 2; ++ti) { const bf16x8 afr = *(const LAS bf16x8*)(QH + (16 * ti + lr) * HS_QK + 32 * ks + 8 * lq); oi[ti] = MFMA16B(afr, bfr, oi[ti]); } }
        if (w < 3) { const int ti = (w + 1) >> 1, si = w >> 1;
            f32x4 sc = (f32x4){0.f, 0.f, 0.f, 0.f};
#pragma unroll
            for (int ks = 0; ks < 4; ++ks) { const bf16x8 afr = *(const LAS bf16x8*)(QH + (16 * ti + lr) * HS_QK + 32 * ks + 8 * lq), bfr = *(const LAS bf16x8*)(KH + (16 * si + lr) * HS_QK + 32 * ks + 8 * lq);
                sc = MFMA16B(afr, bfr, sc); }
#pragma unroll
            for (int i = 0; i < 4; ++i) { const int t = 16 * ti + 4 * lq + i, s_ = 16 * si + lr; PP[buf * 32 * HS_T + t * HS_T + s_] = (bf16)(s_ <= t ? sc[i] : 0.f); }
        } else if (w == 3) {
#pragma unroll
            for (int i = 0; i < 4; ++i) PP[buf * 32 * HS_T + (4 * lq + i) * HS_T + 16 + lr] = (bf16)0.f;
        }
        { const bf16x8 afr = *(const LAS bf16x8*)(KHT + (16 * w + lr) * HS_T + 8 * lq);
#pragma unroll
          for (int vt = 0; vt < 8; ++vt) { const bf16x8 bfr = *(const LAS bf16x8*)(VT + buf * 128 * HS_T + (16 * vt + lr) * HS_T + 8 * lq); S[vt] = MFMA16B(afr, bfr, S[vt]); } }
        __syncthreads();
        { const bf16x8 bfr = *(const LAS bf16x8*)(VT + buf * 128 * HS_T + (16 * w + lr) * HS_T + 8 * lq);
#pragma unroll
          for (int ti = 0; ti < 2; ++ti) { const bf16x8 afr = *(const LAS bf16x8*)(PP + buf * 32 * HS_T + (16 * ti + lr) * HS_T + 8 * lq); oi[ti] = MFMA16B(afr, bfr, oi[ti]); } }
        { const int rlo = dir ? row0 + T - 32 * c - 32 : row0 + 32 * c; char* ob = (char*)O + (size_t)rlo * W * 2;
#pragma unroll
          for (int ti = 0; ti < 2; ++ti)
#pragma unroll
            for (int i = 0; i < 4; ++i) *(h16*)(ob + sgn * (16 * ti + i) * (long)(W * 2) + voffo) = (h16)oi[ti][i]; }
    }
#undef HG_LOAD
    if (!smp) { float* so = p.out + O_SH + ((((size_t)b * DEPTH + l) * 2 + dir) * HGH + h) * 128 * 128;
#pragma unroll
        for (int vt = 0; vt < 8; ++vt)
#pragma unroll
            for (int i = 0; i < 4; ++i) so[(size_t)(16 * w + 4 * lq + i) * 128 + 16 * vt + lr] = S[vt][i]; }
    __syncthreads();
}
template <int PARTS> __device__ __forceinline__ void phase_scans(const Params& p, int l, LAS unsigned char* lds) {
    int tid_ = threadIdx.x; LAUNDER(tid_);
    const int lane = tid_ & 63, gw = blockIdx.x * NWAVES + (tid_ >> 6), nw = gridDim.x * NWAVES;
    if (PARTS & 1) {
        constexpr int NL = DBATCH * HGH * 2, NS = BATCH * HGH * 2;
        const int G = gridDim.x, bid = blockIdx.x;
        for (int it = bid; it < NL; it += G) hgrn_item(p, l, it / (HGH * 2), (it >> 1) % HGH, it & 1, lds);
        if (NL < G) { if (bid >= NL) for (int it = bid - NL; it < NS; it += G - NL) hgrn_item(p, l, DBATCH + it / (HGH * 2), (it >> 1) % HGH, it & 1, lds); }
        else { for (int it = bid; it < NS; it += G) hgrn_item(p, l, DBATCH + it / (HGH * 2), (it >> 1) % HGH, it & 1, lds); }
    }
    constexpr int N_S5S = DBATCH * S5G * 2, N_S5C = BATCH * S5G * 2;
    LAS unsigned char* ldsw = lds + (tid_ >> 6) * S5_WAVE_LDS;
    if (PARTS & 2) {
    for (int it = gw; it < N_S5S; it += nw) c_s5(p, l, it, lane, ldsw);
    if (N_S5S < nw) { if (gw >= N_S5S) for (int it = gw - N_S5S; it < N_S5C; it += nw - N_S5S) c_s5(p, l, N_S5S + it, lane, ldsw); }
    else { for (int it = gw; it < N_S5C; it += nw) c_s5(p, l, N_S5S + it, lane, ldsw); }
    }
    if (PARTS & 4) { __syncthreads(); for (int t = blockIdx.x; t < M / 64 + DBATCH * PAST / 64; t += gridDim.x) prep_tile(p, l, t, lds); }
}

__device__ __forceinline__ int crow(int r, int hi) { return (r & 3) + 8 * (r >> 2) + 4 * hi; }
constexpr int AT_K = 0, AT_V = 32768, AT_OS = 136, AT_WS = 8 * 32 * AT_OS * 2;
__device__ __forceinline__ void attn_unit(const h16* Qb, const h16* Kb, const h16* VTb, int NK, const h16* Gb, h16* Ob, LAS unsigned char* lds, unsigned char* PS_WS) {
    int tid = threadIdx.x; LAUNDER(tid);
    const int wid = tid >> 6, lane = tid & 63, r32 = lane & 31, hi = lane >> 5;
    LAS float* wsf = (LAS float*)(lds + AT_WS) + wid * 64; LAS float* al_l = wsf; LAS float* li_l = wsf + 32;
    constexpr float C = 1.4426950408889634f;
    float m_reg = -1e30f, l_reg = 0.f;
    f32x16 o[4];
#pragma unroll
    for (int d = 0; d < 4; ++d)
#pragma unroll
        for (int r = 0; r < 16; ++r) o[d][r] = 0.f;
    h16x8 qr[8];
    { const h16* Qw = Qb + (size_t)(wid * 32 + r32) * W + hi * 8;
#pragma unroll
      for (int d0 = 0; d0 < 8; ++d0) qr[d0] = *(const h16x8*)(Qw + d0 * 16); }
    const int kr_ = tid >> 4, kc_ = tid & 15, vr_ = tid >> 3, vc_ = tid & 7;
    const int kst0 = kr_ * 256 + ((kc_ * 16) ^ ((kr_ & 15) << 4)), kst1 = (kr_ + 32) * 256 + ((kc_ * 16) ^ (((kr_ + 32) & 15) << 4));
    const int vst0 = vr_ * 128 + ((vc_ * 16) ^ (((vr_ >> 1) & 7) << 4)), vst1 = (vr_ + 64) * 128 + ((vc_ * 16) ^ ((((vr_ + 64) >> 1) & 7) << 4));
    const h16* kg0 = Kb + (size_t)kr_ * KVW + kc_ * 8; const h16* kg1 = Kb + (size_t)(kr_ + 32) * KVW + kc_ * 8;
    const h16* vg0 = VTb + (size_t)vr_ * NK + vc_ * 8; const h16* vg1 = VTb + (size_t)(vr_ + 64) * NK + vc_ * 8;
    const int NT = NK / 64;
    h16x8 kaA = *(const h16x8*)kg0, kbA = *(const h16x8*)kg1, vaA = *(const h16x8*)vg0, vbA = *(const h16x8*)vg1;
    *(LAS h16x8*)(lds + AT_K + kst0) = kaA; *(LAS h16x8*)(lds + AT_K + kst1) = kbA; *(LAS h16x8*)(lds + AT_V + vst0) = vaA; *(LAS h16x8*)(lds + AT_V + vst1) = vbA;
    h16x8 kaB, kbB, vaB, vbB;
#define AT_GLOAD(S, t) do { ka##S = *(const h16x8*)(kg0 + (size_t)(t) * 64 * KVW); kb##S = *(const h16x8*)(kg1 + (size_t)(t) * 64 * KVW); va##S = *(const h16x8*)(vg0 + (t) * 64); vb##S = *(const h16x8*)(vg1 + (t) * 64); } while (0)
#define AT_LWRITE(S, nb) do { *(LAS h16x8*)(lds + AT_K + (nb) + kst0) = ka##S; *(LAS h16x8*)(lds + AT_K + (nb) + kst1) = kb##S; *(LAS h16x8*)(lds + AT_V + (nb) + vst0) = va##S; *(LAS h16x8*)(lds + AT_V + (nb) + vst1) = vb##S; } while (0)
    AT_GLOAD(A, 1); AT_GLOAD(B, (2 < NT ? 2 : 1));
    __syncthreads();
    PSPIN_T0(1)
#define AT_TILE(j, S) do { \
        const int buf = (j) & 1; \
        const LAS unsigned char* Kl = lds + AT_K + buf * 16384; const LAS unsigned char* Vl = lds + AT_V + buf * 16384; \
        f32x16 p0, p1; \
        _Pragma("unroll") for (int r = 0; r < 16; ++r) { p0[r] = 0.f; p1[r] = 0.f; } \
        _Pragma("unroll") for (int d0 = 0; d0 < 8; ++d0) { const int cb = (d0 * 16 + hi * 8) * 2; \
            const h16x8 b0 = *(const LAS h16x8*)(Kl + r32 * 256 + (cb ^ ((r32 & 15) << 4))); \
            const h16x8 b1 = *(const LAS h16x8*)(Kl + (32 + r32) * 256 + (cb ^ ((r32 & 15) << 4))); \
            p0 = MFMA32(b0, qr[d0], p0); p1 = MFMA32(b1, qr[d0], p1); } \
        float pmax = p0[0]; \
        _Pragma("unroll") for (int r = 1; r < 16; ++r) pmax = fmaxf(pmax, p0[r]); \
        _Pragma("unroll") for (int r = 0; r < 16; ++r) pmax = fmaxf(pmax, p1[r]); \
        { unsigned ra, rb; permlane32_swap_u(__builtin_bit_cast(unsigned, pmax), __builtin_bit_cast(unsigned, pmax), ra, rb); pmax = fmaxf(__builtin_bit_cast(float, ra), __builtin_bit_cast(float, rb)); } \
        const float mn = fmaxf(m_reg, pmax), alpha = EXP2F((m_reg - mn) * C), mnC = -mn * C; m_reg = mn; \
        float ps = 0.f; \
        _Pragma("unroll") for (int r = 0; r < 16; ++r) { p0[r] = EXP2F(fmaf(p0[r], C, mnC)); p1[r] = EXP2F(fmaf(p1[r], C, mnC)); ps += p0[r] + p1[r]; } \
        { unsigned ra, rb; permlane32_swap_u(__builtin_bit_cast(unsigned, ps), __builtin_bit_cast(unsigned, ps), ra, rb); ps = __builtin_bit_cast(float, ra) + __builtin_bit_cast(float, rb); } \
        l_reg = l_reg * alpha + ps; \
        if (hi == 0) al_l[r32] = alpha; \
        WAVE_LDS_SYNC(); \
        _Pragma("unroll") for (int r = 0; r < 16; ++r) { const float a = al_l[crow(r, hi)]; \
            _Pragma("unroll") for (int d = 0; d < 4; ++d) o[d][r] *= a; } \
        WAVE_LDS_SYNC(); \
        h16x8 pa[4]; \
        PK4(p0, 0, pa[0]); PK4(p0, 8, pa[1]); PK4(p1, 0, pa[2]); PK4(p1, 8, pa[3]); \
        _Pragma("unroll") for (int d0 = 0; d0 < 4; ++d0) { const int vrow = d0 * 32 + r32; \
            _Pragma("unroll") for (int ks = 0; ks < 4; ++ks) { const int cb = (ks * 16 + hi * 8) * 2; \
                const h16x8 vf = *(const LAS h16x8*)(Vl + vrow * 128 + (cb ^ (((vrow >> 1) & 7) << 4))); \
                o[d0] = MFMA32(pa[ks], vf, o[d0]); } } \
        if ((j) + 1 < NT) AT_LWRITE(S, (buf ^ 1) * 16384); \
        if ((j) + 3 < NT) AT_GLOAD(S, (j) + 3); \
        __syncthreads(); \
    } while (0)
#define PK4(P, BASE, OUT) do { const unsigned a0 = cvtpk_h(P[BASE + 0], P[BASE + 1]), a1 = cvtpk_h(P[BASE + 2], P[BASE + 3]), b0_ = cvtpk_h(P[BASE + 4], P[BASE + 5]), b1_ = cvtpk_h(P[BASE + 6], P[BASE + 7]); \
        unsigned r00, r01, r10, r11; permlane32_swap_u(a0, b0_, r00, r01); permlane32_swap_u(a1, b1_, r10, r11); u32x4 w_ = {r00, r10, r01, r11}; OUT = __builtin_bit_cast(h16x8, w_); } while (0)
    for (int j = 0; j < NT; j += 2) { AT_TILE(j, A); AT_TILE(j + 1, B); }
#undef PK4
#undef AT_TILE
#undef AT_GLOAD
#undef AT_LWRITE
    PSPIN_T1(1, PS_WS)
    if (hi == 0) li_l[r32] = l_reg;
    WAVE_LDS_SYNC();
    LAS h16* OT = (LAS h16*)(lds + wid * (32 * AT_OS * 2));
#pragma unroll
    for (int r = 0; r < 16; ++r) { const float rl = RCPF(li_l[crow(r, hi)]);
#pragma unroll
        for (int d0 = 0; d0 < 4; ++d0) OT[crow(r, hi) * AT_OS + d0 * 32 + r32] = (h16)(o[d0][r] * rl); }
    WAVE_LDS_SYNC();
#pragma unroll
    for (int k = 0; k < 8; ++k) { const int ch = lane + 64 * k, row = ch >> 4, c = ch & 15; const int orow = wid * 32 + row;
        const h16x8 v = *(const LAS h16x8*)(OT + row * AT_OS + c * 8), g = *(const h16x8*)(Gb + (size_t)orow * INC + c * 8);
        h16x8 ov;
#pragma unroll
        for (int j = 0; j < 8; ++j) ov[j] = (h16)((float)v[j] * (float)g[j]);
        *(h16x8*)(Ob + (size_t)orow * W + c * 8) = ov; }
    __syncthreads();
}
constexpr int HGP_N = 8;
__device__ __forceinline__ void d_hgpost4(const Params& p, int l, int item0, int stride, int nitems, int lane) {
    const h16* OF = (const h16*)(p.ws + WS_OF); const h16* OB = (const h16*)(p.ws + WS_OB);
    const float* wn = p.in[I_ONORM] + (size_t)l * 128; const float w0 = wn[lane], w1 = wn[lane + 64];
    float a0[HGP_N], a1[HGP_N]; h16 g0[HGP_N], g1[HGP_N];
#pragma unroll
    for (int k = 0; k < HGP_N; ++k) { const int item = item0 + k * stride; if (item < nitems) { const int row = item / HGH, h = item % HGH; const size_t o0 = (size_t)row * W + h * 128;
        a0[k] = (float)OF[o0 + lane] + (float)OB[o0 + lane]; a1[k] = (float)OF[o0 + lane + 64] + (float)OB[o0 + lane + 64];
        const h16* gz = (const h16*)(p.ws + WS_Z) + (size_t)row * INC + C_HGG + h * 128; g0[k] = gz[lane]; g1[k] = gz[lane + 64]; } else { a0[k] = 0.f; a1[k] = 0.f; g0[k] = (h16)0.f; g1[k] = (h16)0.f; } }
#pragma unroll
    for (int k = 0; k < HGP_N; ++k) { const int item = item0 + k * stride; const float ss = wave_sum(a0[k] * a0[k] + a1[k] * a1[k], lane);
        if (item < nitems) { const int row = item / HGH, h = item % HGH; const float rstd = rsqrtf(ss * (1.0f / 128.0f) + EPS);
            h16* dst = (h16*)(p.ws + WS_OHG) + (size_t)row * W + h * 128; dst[lane] = (h16)(a0[k] * rstd * w0 * (float)g0[k]); dst[lane + 64] = (h16)(a1[k] * rstd * w1 * (float)g1[k]); } }
}
template <int PARTS> __device__ __forceinline__ void phase_attn(const Params& p, int l, LAS unsigned char* lds) {
    int tid_ = threadIdx.x; LAUNDER(tid_);
    const int lane = tid_ & 63, gw = blockIdx.x * NWAVES + (tid_ >> 6), nw = gridDim.x * NWAVES;
    constexpr int NU_S = DBATCH * AQH * (DSEQ / 256), NU_C = BATCH * AQH * (SEQ / 256);
    if (PARTS & 1)
    for (int u = blockIdx.x; u < NU_S + NU_C; u += gridDim.x) {
        const bool smp = u < NU_S; const int uu = smp ? u : u - NU_S;
        const int T = smp ? DSEQ : SEQ, NK = smp ? KVLEN : SEQ;
        const int qb = uu % (T / 256), qh = (uu / (T / 256)) % AQH, b = uu / ((T / 256) * AQH), kh = qh / 4;
        const int row0 = (smp ? MP + b * DSEQ : b * SEQ) + qb * 256;
        const h16* Kb = (smp ? (const h16*)(p.ws + WS_KBS) : (const h16*)(p.ws + WS_KBC)) + (size_t)b * NK * KVW + kh * 128;
        const h16* VTb = (smp ? (const h16*)(p.ws + WS_VBS) : (const h16*)(p.ws + WS_VBC)) + (size_t)(b * AKVH + kh) * 128 * NK;
        attn_unit((const h16*)(p.ws + WS_AQ2) + (size_t)row0 * W + qh * 128, Kb, VTb, NK, (const h16*)(p.ws + WS_Z) + (size_t)row0 * INC + C_AG + qh * 128,
                  (h16*)(p.ws + WS_OAT) + (size_t)row0 * W + qh * 128, lds, p.ws);
    }
    constexpr int N_HP = M * HGH;
    if (PARTS & 2)
    for (int it = gw; it < N_HP; it += HGP_N * nw) d_hgpost4(p, l, it, nw, N_HP, lane);
    if (!(PARTS & 4)) return;
    const h16* YF = (const h16*)(p.ws + WS_YF); const h16* YB = (const h16*)(p.ws + WS_YB); const h16* Z = (const h16*)(p.ws + WS_Z);
    const float* dd = p.in[I_S5D] + (size_t)l * W; h16* YS = (h16*)(p.ws + WS_YS);
    const size_t nth = (size_t)gridDim.x * NTHREADS;
    constexpr int SPN = 8;
    for (size_t i0 = ((size_t)blockIdx.x * NTHREADS + tid_) * 4; i0 < (size_t)M * W; i0 += nth * 4 * SPN) {
        h16x4 a[SPN], b[SPN]; h16x4 u[SPN]; f32x4 dv[SPN];
#pragma unroll
        for (int k = 0; k < SPN; ++k) { const size_t i = i0 + k * nth * 4; if (i < (size_t)M * W) { const size_t row = i / W; const int c = (int)(i % W);
            a[k] = *(const h16x4*)(YF + i); b[k] = *(const h16x4*)(YB + i); dv[k] = *(const f32x4*)(dd + c); u[k] = *(const h16x4*)(Z + row * INC + C_SU + c); } }
#pragma unroll
        for (int k = 0; k < SPN; ++k) { const size_t i = i0 + k * nth * 4; if (i < (size_t)M * W) { h16x4 o;
#pragma unroll
            for (int j = 0; j < 4; ++j) o[j] = (h16)geluf((float)a[k][j] + (float)b[k][j] + dv[k][j] * (float)u[k][j]);
            *(h16x4*)(YS + i) = o; } }
    }
}

constexpr int NPL = 7, PH_FINAL = 1 + DEPTH * NPL, N_PHASES = PH_FINAL + 1;

__global__ void __launch_bounds__(NTHREADS, 2) fwd_kernel(Params p) {
#ifdef HOST_SIM
    unsigned char* lds = sim::cur->blk->lds;
#else
    extern __shared__ __attribute__((aligned(16))) unsigned char lds_raw[];
    LAS unsigned char* lds = (LAS unsigned char*)lds_raw;
#endif
    const int lo = p.ph_lo, hi = p.ph_hi;
#ifndef HOST_SIM
    if (threadIdx.x < 4) ((LAS unsigned*)(lds + MISC_OFF))[threadIdx.x] = 0u;
    __syncthreads();
    XcdBarrier bar; bar.bar = (unsigned*)(p.ws + WS_BAR); bar.x = 0; bar.st = nullptr;
    if (hi - lo > 1) bar = xcd_barrier_post((unsigned*)(p.ws + WS_BAR), (volatile LAS unsigned*)(lds + MISC_OFF));
#else
    XcdBarrier bar{0};
#endif
#define IN(k) (lo <= (k) && (k) < hi)
#define SEAM(k) do { if (IN(k) && IN((k) + 1)) xcd_barrier(bar); } while (0)

    unsigned char* ws = p.ws;
    const int G = gridDim.x, bid = blockIdx.x;
    if (IN(0)) { phase_prologue(p, lds); if (PROBE_REP == 0) { xcd_barrier(bar); phase_prologue(p, lds); } } SEAM(0);
    for (int l = 0; l < DEPTH; ++l) {
        const int pb = 1 + l * NPL;
        if (IN(pb + 0)) { phase_norm(p, l); } SEAM(pb + 0);
        if (IN(pb + 1)) {
            pg8::Gemm g{(const h16*)(ws + WS_H), (const h16*)(ws + WS_WIN) + (size_t)l * INC * D, 0, 0, M, INC, D};
            pg8::StaticOrder S; S.init(M, INC, G, bid);
            EpiIn E{(h16*)(ws + WS_Z), (float*)(ws + WS_LOGF), (const float*)(ws + WS_LB) + (size_t)l * W};
            pg8::gemm_phase<EpiIn, pg8::StaticOrder>(lds, g, S, E);
            if (PROBE_REP == 1) { xcd_barrier(bar); pg8::gemm_phase<EpiIn, pg8::StaticOrder>(lds, g, S, E); }
        } SEAM(pb + 1);
        if (IN(pb + 2)) { phase_scans<7>(p, l, lds); if (PROBE_REP == 2) { xcd_barrier(bar); phase_scans<7>(p, l, lds); } if (PROBE_REP == 21) { xcd_barrier(bar); phase_scans<1>(p, l, lds); } if (PROBE_REP == 22) { xcd_barrier(bar); phase_scans<2>(p, l, lds); } if (PROBE_REP == 23) { xcd_barrier(bar); phase_scans<4>(p, l, lds); } } SEAM(pb + 2);
        if (IN(pb + 3)) { phase_attn<7>(p, l, lds); if (PROBE_REP == 3) { xcd_barrier(bar); phase_attn<7>(p, l, lds); } if (PROBE_REP == 31) { xcd_barrier(bar); phase_attn<1>(p, l, lds); } if (PROBE_REP == 32) { xcd_barrier(bar); phase_attn<2>(p, l, lds); } if (PROBE_REP == 33) { xcd_barrier(bar); phase_attn<4>(p, l, lds); } } SEAM(pb + 3);
        if (IN(pb + 4)) {
            pg8::Gemm g{(const h16*)(ws + WS_YS), (const h16*)(ws + WS_WGLU) + (size_t)l * W * W, 0, 0, M, W, W};
            pg8::StaticOrder S; S.init(M, W, G, bid);
            EpiGlu E{(const h16*)(ws + WS_YS), (const h16*)(ws + WS_Z), (h16*)(ws + WS_OS5)};
            pg8::gemm_phase<EpiGlu, pg8::StaticOrder>(lds, g, S, E);
        } SEAM(pb + 4);
        if (IN(pb + 5)) {
            const h16* wbr = (const h16*)(ws + WS_WBR) + (size_t)l * 3 * D * W;
            pg8::Gemm g{(const h16*)(ws + WS_OHG), wbr, (size_t)M * W, (size_t)D * W, M, D, W};
            pg8::MultiOrder<3> S; S.init(M, D, G, bid);
            EpiBr E{(const h16*)(ws + WS_Z), (h16*)(ws + WS_MG)};
            pg8::gemm_phase<EpiBr, pg8::MultiOrder<3>>(lds, g, S, E);
            if (PROBE_REP == 5) { xcd_barrier(bar); pg8::gemm_phase<EpiBr, pg8::MultiOrder<3>>(lds, g, S, E); }
        } SEAM(pb + 5);
        if (IN(pb + 6)) {
            pg8::Gemm g{(const h16*)(ws + WS_MG), (const h16*)(ws + WS_WOUT) + (size_t)l * D * D, 0, 0, M, D, D};
            pg8::StaticOrder S; S.init(M, D, G, bid);
            const float* X = (const float*)(ws + WS_X);
            EpiOut E{l == 0 ? p.in[I_XP] : X, l == 0 ? p.in[I_XS] : X + (size_t)MP * D, (float*)(ws + WS_X), (const float*)(ws + WS_MOD) + (size_t)l * NMODR * 3 * D};
            pg8::gemm_phase<EpiOut, pg8::StaticOrder>(lds, g, S, E);
        } SEAM(pb + 6);
    }
    if (IN(PH_FINAL)) { phase_final(p); }
#if !defined(HOST_SIM) && PROBE_SPIN
    if (blockIdx.x == 0 && threadIdx.x == 0) { const unsigned T = __hip_atomic_load((unsigned*)p.ws + 64, __ATOMIC_RELAXED, __HIP_MEMORY_SCOPE_AGENT); const unsigned long long t0 = __builtin_amdgcn_s_memrealtime(); while (__builtin_amdgcn_s_memrealtime() - t0 < (unsigned long long)T) __builtin_amdgcn_s_sleep(8); }
#endif
#undef IN
#undef SEAM
}

#ifndef HOST_SIM
extern "C" void kernel_launch(void* const* d_in, const int* in_sizes, int n_in, void* d_out, int out_size, void* d_ws, size_t ws_size, hipStream_t stream) {
    static int grid = 0;
    if (grid == 0) {
        if (n_in != N_IN || (size_t)out_size != O_END || ws_size < WS_END) { grid = -1; return; }
        int dev = 0, cus = 0;
        if (hipGetDevice(&dev) != hipSuccess || hipDeviceGetAttribute(&cus, hipDeviceAttributeMultiprocessorCount, dev) != hipSuccess) { grid = -1; return; }
        if (hipFuncSetAttribute((const void*)fwd_kernel, hipFuncAttributeMaxDynamicSharedMemorySize, LDS_BYTES) != hipSuccess) { grid = -1; return; }
        int per_cu = 0; (void)hipOccupancyMaxActiveBlocksPerMultiprocessor(&per_cu, (const void*)fwd_kernel, NTHREADS, LDS_BYTES); (void)hipGetLastError();
        grid = cus;
    }
    if (grid < 0) return;
    (void)hipMemsetAsync((char*)d_ws + WS_BAR, 0, 16384, stream);
    Params p{};
    for (int i = 0; i < N_IN; ++i) p.in[i] = (const float*)d_in[i];
    p.out = (float*)d_out; p.ws = (unsigned char*)d_ws;
#if N_LAUNCH_MODE == 1
    p.ph_lo = 0; p.ph_hi = N_PHASES;
    hipLaunchKernelGGL(fwd_kernel, dim3(grid), dim3(NTHREADS), LDS_BYTES, stream, p);
#else
    for (int k = 0; k < N_PHASES; ++k) { p.ph_lo = k; p.ph_hi = k + 1; hipLaunchKernelGGL(fwd_kernel, dim3(grid), dim3(NTHREADS), LDS_BYTES, stream, p); }
#endif
}
#endif
```

```cpp
#ifndef HOST_SIM
#include <hip/hip_runtime.h>
#endif

#ifndef CFG_D
#define CFG_D 2048
#define CFG_BATCH 32
#define CFG_SEQ 256
#define CFG_DEPTH 4
#define CFG_DBATCH 8
#define CFG_DSEQ 1024
#define CFG_PAST 256
#endif
#ifndef PROBE_REP
#define PROBE_REP -1
#endif
#ifndef PROBE_SPIN
#define PROBE_SPIN 0
#endif
#ifndef N_LAUNCH_MODE
#define N_LAUNCH_MODE 1
#endif

constexpr int D = CFG_D, BATCH = CFG_BATCH, SEQ = CFG_SEQ, DEPTH = CFG_DEPTH, DBATCH = CFG_DBATCH, DSEQ = CFG_DSEQ, PAST = CFG_PAST;
constexpr int W = D / 2;
constexpr int HGH = W / 128;
constexpr int AQH = W / 128, AKVH = AQH / 4, KVW = AKVH * 128;
constexpr int S5G = W / 16, S5P = 64;
constexpr int C_HQ = 0, C_HI = W, C_FF = 2 * W, C_FB = 3 * W, C_HGG = 4 * W, C_AQ = 5 * W, C_AK = 6 * W, C_AV = 6 * W + KVW, C_AG = 6 * W + 2 * KVW,
              C_SU = 7 * W + 2 * KVW, C_SG = 8 * W + 2 * KVW, C_MG = 9 * W + 2 * KVW, INC = C_MG + 3 * D;
constexpr int MP = BATCH * SEQ, MS = DBATCH * DSEQ, M = MP + MS;
constexpr int KVLEN = PAST + DSEQ;
constexpr int NMODR = 1 + DBATCH;
constexpr float EPS = 1e-6f;
static_assert(INC % 256 == 0 && MP % 256 == 0 && MS % 256 == 0 && W % 256 == 0, "tile shapes");

typedef _Float16 h16;
typedef h16 h16x8 __attribute__((ext_vector_type(8)));
typedef h16 h16x4 __attribute__((ext_vector_type(4)));
typedef h16 h16x2 __attribute__((ext_vector_type(2)));
typedef float f32x4 __attribute__((ext_vector_type(4)));
typedef float f32x2 __attribute__((ext_vector_type(2)));
typedef float f32x16 __attribute__((ext_vector_type(16)));
typedef unsigned u32x4 __attribute__((ext_vector_type(4)));

constexpr size_t al256(size_t x) { return (x + 255) & ~(size_t)255; }
constexpr size_t WS_BAR = 0;
constexpr size_t WS_MOD = 16384;
constexpr size_t WS_LB = al256(WS_MOD + (size_t)DEPTH * NMODR * 3 * D * 4);
constexpr size_t WS_ABAR = al256(WS_LB + (size_t)2 * DEPTH * W * 4);
constexpr size_t WS_BBAR = al256(WS_ABAR + (size_t)DEPTH * 2 * S5G * S5P * 8);
constexpr size_t WS_S5T = al256(WS_BBAR + (size_t)DEPTH * 2 * S5G * S5P * 32 * 4);
constexpr size_t WS_S5C = al256(WS_S5T + (size_t)DEPTH * 2 * S5G * 256 * 48);
constexpr size_t WS_ROPE = al256(WS_S5C + (size_t)DEPTH * S5G * 256 * 16);
constexpr size_t WS_WIN = al256(WS_ROPE + (size_t)(DSEQ / 64 + 64) * 32 * 8);
constexpr size_t WS_WGLU = al256(WS_WIN + (size_t)DEPTH * INC * D * 2);
constexpr size_t WS_WBR = al256(WS_WGLU + (size_t)DEPTH * W * W * 2);
constexpr size_t WS_WOUT = al256(WS_WBR + (size_t)DEPTH * 3 * D * W * 2);
constexpr size_t WS_X = al256(WS_WOUT + (size_t)DEPTH * D * D * 2);
constexpr size_t WS_H = al256(WS_X + (size_t)M * D * 4);
constexpr size_t WS_Z = al256(WS_H + (size_t)M * D * 2);
constexpr size_t WS_LOGF = al256(WS_Z + (size_t)M * INC * 2);
constexpr size_t WS_AQ2 = al256(WS_LOGF + (size_t)M * 2 * W * 4);
constexpr size_t WS_KBC = al256(WS_AQ2 + (size_t)M * W * 2);
constexpr size_t WS_VBC = al256(WS_KBC + (size_t)MP * KVW * 2);
constexpr size_t WS_KBS = al256(WS_VBC + (size_t)MP * KVW * 2);
constexpr size_t WS_VBS = al256(WS_KBS + (size_t)DBATCH * KVLEN * KVW * 2);
constexpr size_t WS_OF = al256(WS_VBS + (size_t)DBATCH * KVLEN * KVW * 2);
constexpr size_t WS_OB = al256(WS_OF + (size_t)M * W * 4);
constexpr size_t WS_YF = al256(WS_OB + (size_t)M * W * 4);
constexpr size_t WS_YB = al256(WS_YF + (size_t)M * W * 4);
constexpr size_t WS_OHG = al256(WS_YB + (size_t)M * W * 4);
constexpr size_t WS_OAT = al256(WS_OHG + (size_t)M * W * 2);
constexpr size_t WS_OS5 = al256(WS_OAT + (size_t)M * W * 2);
constexpr size_t WS_YS = al256(WS_OS5 + (size_t)M * W * 2);
constexpr size_t WS_MG = al256(WS_YS + (size_t)M * W * 2);
static_assert(WS_OAT - WS_OHG == (size_t)M * W * 2 && WS_OS5 - WS_OAT == (size_t)M * W * 2, "branch operands must be equally spaced");
constexpr size_t WS_END = al256(WS_MG + (size_t)M * D * 2);

constexpr size_t O_Y = 0;
constexpr size_t O_CK = (size_t)M * D;
constexpr size_t O_CV = O_CK + (size_t)BATCH * DEPTH * SEQ * KVW;
constexpr size_t O_SH = O_CV + (size_t)BATCH * DEPTH * SEQ * KVW;
constexpr size_t O_SR = O_SH + (size_t)BATCH * DEPTH * 2 * HGH * 128 * 128;
constexpr size_t O_SI = O_SR + (size_t)BATCH * DEPTH * 2 * S5G * S5P;
constexpr size_t O_END = O_SI + (size_t)BATCH * DEPTH * 2 * S5G * S5P;

enum { I_XP = 0, I_XS, I_CK, I_CV, I_SH, I_SR, I_SI, I_C, I_CCTX, I_NORMW, I_WMOD, I_BMOD, I_WIN, I_LBL, I_ONORM, I_QNORM, I_KNORM,
       I_ARE, I_AIM, I_LDT, I_BRE, I_BIM, I_CRE, I_CIM, I_S5D, I_WGLU, I_WBRHG, I_WBRAT, I_WBRS5, I_WOUT, I_FNORM, N_IN };

struct Params { const float* in[N_IN]; float* out; unsigned char* ws; int ph_lo, ph_hi; };

constexpr int NTHREADS = 512, NWAVES = 8;
constexpr int STAGE_BYTES = 131072, LDS_BYTES = 147456, MISC_OFF = LDS_BYTES - 64;

#ifdef HOST_SIM
#define LAS
static inline void sim_glds16(const void* g, void* l) { memcpy((char*)l + sim::cur->lane * 16, g, 16); }
#define GLDS16(g, l) sim_glds16((const void*)(g), (void*)(l))
#define WAIT_V(n) ((void)0)
#define WAIT_L(n) ((void)0)
#define SBAR sim::block_sync()
#define SCHED ((void)0)
#define SETPRIO(x) ((void)0)
#define CFENCE ((void)0)
#define LAUNDER(x) ((void)0)
#define PIN4(a, b, c, d) ((void)0)
#define MFMA16(a, b, c) sim::mfma16<1>(&(a), &(b), c)
#define MFMA16K16(a, b, c) sim::mfma16k16_f16(&(a), &(b), c)
static inline float readlane_f(float v, int l) { return sim::shfl<float>(v, l); }
#else
#define LAS __attribute__((address_space(3)))
#define GLDS16(g, l) __builtin_amdgcn_global_load_lds((const unsigned*)(g), (LAS unsigned*)(l), 16, 0, 0)
#define WAIT_V(n) asm volatile("s_waitcnt vmcnt(" #n ")" ::: "memory")
#define WAIT_L(n) asm volatile("s_waitcnt lgkmcnt(" #n ")" ::: "memory")
#define SBAR __builtin_amdgcn_s_barrier()
#define SCHED __builtin_amdgcn_sched_barrier(0)
#define SETPRIO(x) __builtin_amdgcn_s_setprio(x)
#define CFENCE asm volatile("" ::: "memory")
#define LAUNDER(x) asm volatile("" : "+v"(x))
#define PIN4(a, b, c, d) asm volatile("" : "+v"(a), "+v"(b), "+v"(c), "+v"(d) :: "memory")
#define MFMA16(a, b, c) __builtin_amdgcn_mfma_f32_16x16x32_f16(a, b, c, 0, 0, 0)
#define MFMA16K16(a, b, c) __builtin_amdgcn_mfma_f32_16x16x16f16(a, b, c, 0, 0, 0)
__device__ __forceinline__ float readlane_f(float v, int l) { return __builtin_bit_cast(float, __builtin_amdgcn_readlane(__builtin_bit_cast(int, v), l)); }
#endif

#ifdef HOST_SIM
#define MFMA32(a, b, c) sim::mfma32<1>(&(a), &(b), c)
#define WAVE_LDS_SYNC() sim::wave_sync()
#define WAVE_ALL(p) sim_wave_all(p)
#define EXP2F(x) exp2f(x)
#define RCPF(x) (1.0f / (x))
static inline void permlane32_swap_u(unsigned a, unsigned b, unsigned& ra, unsigned& rb) { sim_permlane32_swap(a, b, ra, rb); }
#else
#define MFMA32(a, b, c) __builtin_amdgcn_mfma_f32_32x32x16_f16(a, b, c, 0, 0, 0)
#define WAVE_LDS_SYNC() asm volatile("s_waitcnt lgkmcnt(0)" ::: "memory")
#define WAVE_ALL(p) (__all(p) != 0)
#define EXP2F(x) __builtin_amdgcn_exp2f(x)
#define RCPF(x) __builtin_amdgcn_rcpf(x)
__device__ __forceinline__ void permlane32_swap_u(unsigned a, unsigned b, unsigned& ra, unsigned& rb) { auto r = __builtin_amdgcn_permlane32_swap(a, b, false, false); ra = r[0]; rb = r[1]; }
#endif
#if !defined(HOST_SIM) && PROBE_SPIN
#define PSPIN_T0(id) unsigned long long _pt0 = 0; if (PROBE_SPIN == (id) && blockIdx.x == 0 && threadIdx.x == 0) _pt0 = __builtin_amdgcn_s_memrealtime();
#define PSPIN_T1(id, wsp) if (PROBE_SPIN == (id) && blockIdx.x == 0 && threadIdx.x == 0) { const unsigned long long _d = __builtin_amdgcn_s_memrealtime() - _pt0; atomicAdd((unsigned*)(wsp) + 64, (unsigned)_d); }
#else
#define PSPIN_T0(id)
#define PSPIN_T1(id, wsp)
#endif
__device__ __forceinline__ unsigned cvtpk_h(float lo, float hi) { h16x2 v; v[0] = (h16)lo; v[1] = (h16)hi; return __builtin_bit_cast(unsigned, v); }
__device__ __forceinline__ float sigm(float x) { return RCPF(1.0f + __expf(-x)); }
__device__ __forceinline__ float siluf(float x) { return x * sigm(x); }
__device__ __forceinline__ float geluf(float x) { const float u = 0.7978845608028654f * (x + 0.044715f * x * x * x); const float t = 1.0f - 2.0f * RCPF(1.0f + __expf(2.0f * u)); return 0.5f * x * (1.0f + t); }
#ifdef HOST_SIM
static inline float shfl_xor_l(float v, int m, int lane) { (void)lane; return __shfl_xor(v, m); }
static inline float shfl_l(float v, int src) { return __shfl(v, src); }
static inline float shfl_up_l(float v, int d, int lane) { (void)lane; return __shfl_up(v, d); }
#else
__device__ __forceinline__ float shfl_xor_l(float v, int m, int lane) { return __builtin_bit_cast(float, __builtin_amdgcn_ds_bpermute((lane ^ m) << 2, __builtin_bit_cast(int, v))); }
__device__ __forceinline__ float shfl_l(float v, int src) { return __builtin_bit_cast(float, __builtin_amdgcn_ds_bpermute(src << 2, __builtin_bit_cast(int, v))); }
__device__ __forceinline__ float shfl_up_l(float v, int d, int lane) { const float r = __builtin_bit_cast(float, __builtin_amdgcn_ds_bpermute((lane - d) << 2, __builtin_bit_cast(int, v))); return lane >= d ? r : v; }
#endif
__device__ __forceinline__ float wave_sum(float v, int lane) { v += shfl_xor_l(v, 32, lane); v += shfl_xor_l(v, 16, lane); v += shfl_xor_l(v, 8, lane); v += shfl_xor_l(v, 4, lane); v += shfl_xor_l(v, 2, lane); v += shfl_xor_l(v, 1, lane); return v; }

#ifndef HOST_SIM
#define XB_TMO      128
#define XB_XCNT(j)  (256  + 64 * (j))
#define XB_XSUB(j)  (1280 + 64 * (j))
#define XB_XGEN(j)  (2304 + 64 * (j))
#define XB_TOP      3328
#define XB_TOPGEN   3392
#define XCD_BAR_WORDS 3456
#define XB_SPIN_CAP (1u << 24)
__device__ __forceinline__ unsigned xb_ld(unsigned* p)              { return __hip_atomic_load(p, __ATOMIC_RELAXED, __HIP_MEMORY_SCOPE_AGENT); }
__device__ __forceinline__ unsigned xb_add(unsigned* p, unsigned v) { return __hip_atomic_fetch_add(p, v, __ATOMIC_RELAXED, __HIP_MEMORY_SCOPE_AGENT); }
__device__ __forceinline__ unsigned xb_xcc_id() { return (unsigned)__builtin_amdgcn_s_getreg((3 << 11) | 20) & 0xFu; }
#define XB_SPIN(cond, bar) do { unsigned _sp = 0; while (cond) { __builtin_amdgcn_s_sleep(1); \
    if ((++_sp & 255u) == 0u) { if (xb_ld(&(bar)[XB_TMO])) break; if (_sp > XB_SPIN_CAP) { atomicAdd(&(bar)[XB_TMO], 1u); break; } } } } while (0)
struct XcdBarrier { unsigned* bar; unsigned x; volatile LAS unsigned* st; };
__device__ __forceinline__ XcdBarrier xcd_barrier_post(unsigned* bar, volatile LAS unsigned* st) {
    XcdBarrier b; b.bar = bar; b.x = xb_xcc_id(); b.st = st;
    if (threadIdx.x == 0) (void)xb_add(&bar[XB_XCNT(b.x)], 1u);
    return b;
}
__device__ __forceinline__ void xcd_barrier_complete(unsigned* bar, unsigned x, unsigned& nloc, unsigned& nx) {
    const unsigned G = gridDim.x * gridDim.y * gridDim.z;
    unsigned sum, cnt, mine, sp = 0u;
    for (;;) {
        sum = 0u; cnt = 0u; mine = 0u;
#pragma unroll
        for (unsigned j = 0; j < 16; ++j) { const unsigned c = xb_ld(&bar[XB_XCNT(j)]); sum += c; cnt += (c > 0u) ? 1u : 0u; mine = (j == x) ? c : mine; }
        if (sum == G) break;
        __builtin_amdgcn_s_sleep(1);
        if ((++sp & 255u) == 0u) { if (xb_ld(&bar[XB_TMO])) break; if (sp > XB_SPIN_CAP) { atomicAdd(&bar[XB_TMO], 1u); break; } }
    }
    nloc = mine > 0u ? mine : 1u; nx = cnt > 0u ? cnt : 1u;
}
__device__ __forceinline__ void xcd_barrier(const XcdBarrier& b) {
    asm volatile("s_waitcnt vmcnt(0)" ::: "memory");
    __syncthreads();
    if (threadIdx.x == 0) {
        unsigned* bar = b.bar;
        __builtin_amdgcn_s_waitcnt(0);
        unsigned nloc = b.st[0], nx = b.st[1];
        if (nloc == 0u) { xcd_barrier_complete(bar, b.x, nloc, nx); b.st[0] = nloc; b.st[1] = nx; }
        const unsigned old = xb_add(&bar[XB_XSUB(b.x)], 1u);
        const unsigned gen = old / nloc;
        if (old + 1u == (gen + 1u) * nloc) {
            __builtin_amdgcn_fence(__ATOMIC_RELEASE, "agent");
            asm volatile("s_waitcnt vmcnt(0)" ::: "memory");
            const unsigned og = xb_add(&bar[XB_TOP], 1u);
            const unsigned tg = og / nx;
            if (og + 1u == (tg + 1u) * nx) xb_add(&bar[XB_TOPGEN], 1u);
            else XB_SPIN(xb_ld(&bar[XB_TOPGEN]) == tg, bar);
            __builtin_amdgcn_fence(__ATOMIC_ACQUIRE, "agent");
            xb_add(&bar[XB_XGEN(b.x)], 1u);
            asm volatile("s_waitcnt vmcnt(0)" ::: "memory");
        } else {
            XB_SPIN(xb_ld(&bar[XB_XGEN(b.x)]) == gen, bar);
            __builtin_amdgcn_fence(__ATOMIC_ACQUIRE, "agent");
            asm volatile("s_waitcnt vmcnt(0)" ::: "memory");
        }
    }
    __syncthreads();
}
#else
#define XCD_BAR_WORDS 3456
struct XcdBarrier { int dummy; };
static inline void xcd_barrier(const XcdBarrier&) { sim::grid_sync(); }
#endif

namespace pg8 {
constexpr int BM = 256, BK = 64, HALF = 128, HTB = HALF * BK * 2, NXCD = 8, WGM = 8;
__host__ __device__ __forceinline__ int lds_byte(int r, int c) { const int st = (r >> 4) * 2 + (c >> 5), rr = r & 15, cc = c & 31, ob = rr * 64 + cc * 2; return st * 1024 + (ob ^ (((ob >> 9) & 1) << 5)); }
__host__ __device__ __forceinline__ void stage_rc(int b, int& R, int& C) { const int st = b / 1024, sb = b % 1024, swz = sb ^ (((sb >> 9) & 1) << 5); R = (st >> 1) * 16 + swz / 64; C = (st & 1) * 32 + (swz % 64) / 2; }
__host__ __device__ __forceinline__ int perm32(int rho) { const int n = rho >> 4, i = rho & 15; return 8 * (i >> 2) + 4 * n + (i & 3); }
struct Unit { int pm, pn, sel; };
struct Gemm { const h16* A; const h16* Bt; size_t sa, sb; int M, N, K;
    __device__ __forceinline__ const char* a(int s) const { return (const char*)(A + (size_t)s * sa); }
    __device__ __forceinline__ const char* b(int s) const { return (const char*)(Bt + (size_t)s * sb); } };
struct StaticOrder {
    int nM, nN, nwg, G, c;
    __host__ __device__ void init(int M_, int N_, int G_, int c_) { nM = M_ / BM; nN = N_ / BM; nwg = nM * nN; G = G_; c = c_; }
    __host__ __device__ bool next(int i, Unit& u) const {
        const long L = (long)i * G + c; if (L >= nwg) return false;
        int wgid = (int)L; { const int q = nwg / NXCD, r = nwg % NXCD, xcd = wgid % NXCD, off = wgid / NXCD; wgid = (xcd < r ? xcd * (q + 1) : r * (q + 1) + (xcd - r) * q) + off; }
        const int nig = WGM * nN, gid = wgid / nig, fm = gid * WGM, gsz = (nM - fm) < WGM ? (nM - fm) : WGM;
        u.pm = fm + ((wgid % nig) % gsz); u.pn = (wgid % nig) / gsz; u.sel = 0; return true;
    }
};
template <int NSEL> struct MultiOrder {
    StaticOrder S;
    __host__ __device__ void init(int M_, int N_, int G_, int c_) { S.init(M_, N_, G_, c_); }
    __host__ __device__ bool next(int i, Unit& u) const { const bool ok = S.next(i / NSEL, u); u.sel = i % NSEL; return ok; }
};

template <class Epi, class Sched>
__device__ __forceinline__ void gemm_phase(LAS unsigned char* lds, const Gemm g, const Sched& S, const Epi& E) {
    int tid = threadIdx.x; LAUNDER(tid);
    const int wid = __builtin_amdgcn_readfirstlane(tid >> 6), lane = tid & 63, wr = wid >> 2, wc = wid & 3, fr = lane & 15, fq = lane >> 4;
    const int K = g.K, nt = K / BK;
    unsigned voffA[2], voffB[2];
#pragma unroll
    for (int i = 0; i < 2; ++i) { int R, C; stage_rc(tid * 16 + i * 8192, R, C); const int Rb = Epi::PERM ? ((R & ~31) + perm32(R & 31)) : R;
        voffA[i] = (unsigned)(R * K + C) * 2u; voffB[i] = (unsigned)(Rb * K + C) * 2u; }
    const size_t kstep = (size_t)(BK * 2);
    const size_t hstep = (size_t)HALF * K * 2;
    const size_t tstep = 2 * hstep;
    const unsigned ldsw = (unsigned)wid * 1024u;
    const int aoff = lds_byte(wr * 64 + fr, fq * 8), boff = lds_byte(wc * 32 + fr, fq * 8);
#define PG8_SA(b, h) (((b) * 2 + (h)) * HTB)
#define PG8_SB(b, h) ((4 + (b) * 2 + (h)) * HTB)
#define PG8_STAGE(bufoff, gbase, voff) do { _Pragma("unroll") for (int _i = 0; _i < 2; ++_i) \
        GLDS16((const char*)(gbase) + (voff)[_i], lds + (bufoff) + ldsw + _i * 8192); } while (0)
#define PG8_LDA(dst, b, h) do { _Pragma("unroll") for (int m = 0; m < 4; ++m) _Pragma("unroll") for (int k = 0; k < 2; ++k) dst[m][k] = *(const LAS h16x8*)(lds + PG8_SA(b, h) + aoff + m * 2048 + k * 1024); } while (0)
#define PG8_LDB(dst, b, h) do { _Pragma("unroll") for (int n = 0; n < 2; ++n) _Pragma("unroll") for (int k = 0; k < 2; ++k) dst[n][k] = *(const LAS h16x8*)(lds + PG8_SB(b, h) + boff + n * 2048 + k * 1024); } while (0)
#define PG8_MMA(ai, bj, At, Bt) do { SETPRIO(1); _Pragma("unroll") for (int m = 0; m < 4; ++m) _Pragma("unroll") for (int n = 0; n < 2; ++n) _Pragma("unroll") for (int k = 0; k < 2; ++k) \
        acc[ai][bj][m][n] = MFMA16(Bt[n][k], At[m][k], acc[ai][bj][m][n]); SETPRIO(0); } while (0)
    Unit cur, nxt; int ui = 0;
    if (!S.next(0, cur)) return;
    f32x4 acc[2][2][4][2];
#if defined(HOST_SIM) && defined(SIM_FAST_GEMM)
    for (;; ++ui) {
        if (!S.next(ui, cur)) break;
        const h16* Ap = (const h16*)g.a(cur.sel); const h16* Bp = (const h16*)g.b(cur.sel);
        for (int ai = 0; ai < 2; ++ai) for (int bj = 0; bj < 2; ++bj) for (int m = 0; m < 4; ++m) for (int n = 0; n < 2; ++n) for (int j = 0; j < 4; ++j) {
            const int row = cur.pm * 256 + ai * 128 + wr * 64 + m * 16 + fr;
            const int col = cur.pn * 256 + bj * 128 + wc * 32 + (Epi::PERM ? 8 * fq + 4 * n + j : 16 * n + 4 * fq + j);
            float sacc = 0.f; for (int k = 0; k < K; ++k) sacc += (float)Ap[(size_t)row * K + k] * (float)Bp[(size_t)col * K + k];
            acc[ai][bj][m][n][j] = sacc; }
        E(acc, cur, wr, wc, fr, fq);
    }
    (void)nxt; (void)voffA; (void)voffB; (void)aoff; (void)boff; (void)ldsw; (void)kstep; (void)tstep; (void)nt;
    return;
#endif
#pragma unroll
    for (int a = 0; a < 2; ++a)
#pragma unroll
        for (int b = 0; b < 2; ++b)
#pragma unroll
            for (int m = 0; m < 4; ++m)
#pragma unroll
                for (int n = 0; n < 2; ++n) acc[a][b][m][n] = (f32x4){0.f, 0.f, 0.f, 0.f};
    h16x8 At[4][2], B0[2][2], B1[2][2];
    const char* cA = g.a(cur.sel) + (size_t)cur.pm * tstep; const char* cB = g.b(cur.sel) + (size_t)cur.pn * tstep;
    PG8_STAGE(PG8_SB(0, 0), cB, voffB); PG8_STAGE(PG8_SA(0, 0), cA, voffA); PG8_STAGE(PG8_SB(0, 1), cB + hstep, voffB); PG8_STAGE(PG8_SA(0, 1), cA + hstep, voffA);
    if (wr == 1) SBAR;
    WAIT_V(4); SBAR;
    PG8_STAGE(PG8_SB(1, 0), cB + kstep, voffB); PG8_STAGE(PG8_SA(1, 0), cA + kstep, voffA); PG8_STAGE(PG8_SB(1, 1), cB + hstep + kstep, voffB);
    WAIT_V(6); SBAR;
    for (;;) {
        const bool has_next = S.next(ui + 1, nxt);
        const char* nA = has_next ? g.a(nxt.sel) + (size_t)nxt.pm * tstep : cA; const char* nB = has_next ? g.b(nxt.sel) + (size_t)nxt.pn * tstep : cB;
        for (int t = 0; t < nt; t += 2) {
            const bool last = (t == nt - 2);
            const char* a1 = cA + (size_t)(t + 1) * kstep;
            const char* a2 = last ? nA : cA + (size_t)(t + 2) * kstep; const char* b2 = last ? nB : cB + (size_t)(t + 2) * kstep;
            const char* a3 = a2 + kstep; const char* b3 = b2 + kstep;
            PG8_LDB(B0, 0, 0); SCHED; PG8_LDA(At, 0, 0); PG8_STAGE(PG8_SA(1, 1), a1 + hstep, voffA);
            WAIT_L(8); SBAR; WAIT_L(0); PG8_MMA(0, 0, At, B0); SBAR; SCHED;
            PG8_LDB(B1, 0, 1); PG8_STAGE(PG8_SB(0, 0), b2, voffB);
            SBAR; WAIT_L(0); PG8_MMA(0, 1, At, B1); SBAR;
            PG8_LDA(At, 0, 1); PG8_STAGE(PG8_SA(0, 0), a2, voffA);
            SBAR; WAIT_L(0); PG8_MMA(1, 0, At, B0); SBAR; SCHED;
            PG8_STAGE(PG8_SB(0, 1), b2 + hstep, voffB);
            WAIT_V(6); SBAR; PG8_MMA(1, 1, At, B1); SBAR;
            PG8_LDB(B0, 1, 0); SCHED; PG8_LDA(At, 1, 0); PG8_STAGE(PG8_SA(0, 1), a2 + hstep, voffA);
            WAIT_L(8); SBAR; WAIT_L(0); PG8_MMA(0, 0, At, B0); SBAR; SCHED;
            PG8_LDB(B1, 1, 1); PG8_STAGE(PG8_SB(1, 0), b3, voffB);
            SBAR; WAIT_L(0); PG8_MMA(0, 1, At, B1); SBAR;
            PG8_LDA(At, 1, 1); PG8_STAGE(PG8_SA(1, 0), a3, voffA);
            SBAR; WAIT_L(0); PG8_MMA(1, 0, At, B0); SBAR; SCHED;
            PG8_STAGE(PG8_SB(1, 1), b3 + hstep, voffB);
            WAIT_V(6); SBAR; PG8_MMA(1, 1, At, B1); SBAR;
        }
        E(acc, cur, wr, wc, fr, fq);
        if (!has_next) break;
#pragma unroll
        for (int a = 0; a < 2; ++a)
#pragma unroll
            for (int b = 0; b < 2; ++b)
#pragma unroll
                for (int m = 0; m < 4; ++m)
#pragma unroll
                    for (int n = 0; n < 2; ++n) acc[a][b][m][n] = (f32x4){0.f, 0.f, 0.f, 0.f};
        cur = nxt; cA = nA; cB = nB; ++ui;
    }
    WAIT_V(0);
    if (wr == 0) SBAR;
    SBAR;
#undef PG8_SA
#undef PG8_SB
#undef PG8_STAGE
#undef PG8_LDA
#undef PG8_LDB
#undef PG8_MMA
}
}

__device__ __forceinline__ int mod_row(int row) { return row < MP ? 0 : 1 + (row - MP) / DSEQ; }

struct EpiIn {
    static constexpr bool PERM = true;
    h16* Z; float* LOGF; const float* LB;
    __device__ __forceinline__ void operator()(const f32x4 (&acc)[2][2][4][2], const pg8::Unit& u, int wr, int wc, int fr, int fq) const {
        const int colt = u.pn * 256;
        int kind;
        if (colt < 2 * W) kind = 0; else if (colt < 4 * W) kind = 1; else if (colt < 5 * W) kind = 2; else if (colt < C_AG) kind = 0; else if (colt < C_SU) kind = 2;
        else if (colt < C_SG) kind = 0; else if (colt < C_MG) kind = 2; else kind = 3;
        const int row0 = u.pm * 256 + wr * 64 + fr;
        if (kind == 1) {
            const int dir = colt >= 3 * W ? 1 : 0;
#pragma unroll
            for (int bj = 0; bj < 2; ++bj) {
                const int c0 = colt + bj * 128 + wc * 32 + 8 * fq;
                const float* lbp = LB + (size_t)dir * DEPTH * W + (c0 - (2 + dir) * W);
                const f32x4 l0 = *(const f32x4*)lbp, l1 = *(const f32x4*)(lbp + 4);
#pragma unroll
                for (int ai = 0; ai < 2; ++ai)
#pragma unroll
                    for (int m = 0; m < 4; ++m) {
                        const int row = row0 + ai * 128 + m * 16;
                        f32x4 o0, o1;
#pragma unroll
                        for (int j = 0; j < 4; ++j) { o0[j] = __logf(l0[j] + (1.0f - l0[j]) * sigm(acc[ai][bj][m][0][j])); o1[j] = __logf(l1[j] + (1.0f - l1[j]) * sigm(acc[ai][bj][m][1][j])); }
                        float* dst = LOGF + (size_t)row * (2 * W) + (c0 - 2 * W);
                        *(f32x4*)dst = o0; *(f32x4*)(dst + 4) = o1;
                    }
            }
            return;
        }
#pragma unroll
        for (int ai = 0; ai < 2; ++ai)
#pragma unroll
            for (int m = 0; m < 4; ++m) {
                const int row = row0 + ai * 128 + m * 16;
#pragma unroll
                for (int bj = 0; bj < 2; ++bj) {
                    const int c0 = colt + bj * 128 + wc * 32 + 8 * fq;
                    h16x8 o;
#pragma unroll
                    for (int j = 0; j < 4; ++j) {
                        float a = acc[ai][bj][m][0][j], b = acc[ai][bj][m][1][j];
                        if (kind == 2) { a = siluf(a); b = siluf(b); } else if (kind == 3) { a = sigm(a); b = sigm(b); }
                        o[j] = (h16)a; o[4 + j] = (h16)b;
                    }
                    *(h16x8*)(Z + (size_t)row * INC + c0) = o;
                }
            }
    }
};
struct EpiGlu {
    static constexpr bool PERM = true;
    const h16* YS; const h16* Z; h16* OS5;
    __device__ __forceinline__ void operator()(const f32x4 (&acc)[2][2][4][2], const pg8::Unit& u, int wr, int wc, int fr, int fq) const {
        const int colt = u.pn * 256, row0 = u.pm * 256 + wr * 64 + fr;
#pragma unroll
        for (int ai = 0; ai < 2; ++ai) {
            h16x8 ys[4][2], sg[4][2];
#pragma unroll
            for (int m = 0; m < 4; ++m)
#pragma unroll
                for (int bj = 0; bj < 2; ++bj) { const int row = row0 + ai * 128 + m * 16, c0 = colt + bj * 128 + wc * 32 + 8 * fq;
                    ys[m][bj] = *(const h16x8*)(YS + (size_t)row * W + c0); sg[m][bj] = *(const h16x8*)(Z + (size_t)row * INC + C_SG + c0); }
#pragma unroll
            for (int m = 0; m < 4; ++m)
#pragma unroll
                for (int bj = 0; bj < 2; ++bj) { const int row = row0 + ai * 128 + m * 16, c0 = colt + bj * 128 + wc * 32 + 8 * fq;
                    h16x8 o;
#pragma unroll
                    for (int j = 0; j < 4; ++j) { o[j] = (h16)((float)ys[m][bj][j] * sigm(acc[ai][bj][m][0][j]) * (float)sg[m][bj][j]); o[4 + j] = (h16)((float)ys[m][bj][4 + j] * sigm(acc[ai][bj][m][1][j]) * (float)sg[m][bj][4 + j]); }
                    *(h16x8*)(OS5 + (size_t)row * W + c0) = o; }
            CFENCE;
        }
    }
};
struct EpiBr {
    static constexpr bool PERM = true;
    const h16* Z; h16* MG;
    __device__ __forceinline__ void operator()(const f32x4 (&acc)[2][2][4][2], const pg8::Unit& u, int wr, int wc, int fr, int fq) const {
        const int colt = u.pn * 256, row0 = u.pm * 256 + wr * 64 + fr, b = u.sel;
#pragma unroll
        for (int ai = 0; ai < 2; ++ai) {
            h16x8 gt[4][2], pv[4][2];
#pragma unroll
            for (int m = 0; m < 4; ++m)
#pragma unroll
                for (int bj = 0; bj < 2; ++bj) { const int row = row0 + ai * 128 + m * 16, c0 = colt + bj * 128 + wc * 32 + 8 * fq;
                    gt[m][bj] = *(const h16x8*)(Z + (size_t)row * INC + C_MG + (size_t)b * D + c0);
                    pv[m][bj] = gt[m][bj]; if (b > 0) pv[m][bj] = *(const h16x8*)(MG + (size_t)row * D + c0); }
#pragma unroll
            for (int m = 0; m < 4; ++m)
#pragma unroll
                for (int bj = 0; bj < 2; ++bj) { const int row = row0 + ai * 128 + m * 16, c0 = colt + bj * 128 + wc * 32 + 8 * fq;
                    h16x8 a16;
#pragma unroll
                    for (int j = 0; j < 4; ++j) { a16[j] = (h16)acc[ai][bj][m][0][j]; a16[4 + j] = (h16)acc[ai][bj][m][1][j]; }
                    h16x8 o = gt[m][bj] * a16;
                    if (b > 0) o = o + pv[m][bj];
                    *(h16x8*)(MG + (size_t)row * D + c0) = o; }
            CFENCE;
        }
    }
};
struct EpiOut {
    static constexpr bool PERM = false;
    const float* XP; const float* XS; float* X; const float* MOD;
    __device__ __forceinline__ void operator()(const f32x4 (&acc)[2][2][4][2], const pg8::Unit& u, int wr, int wc, int fr, int fq) const {
        const int colt = u.pn * 256, row0 = u.pm * 256 + wr * 64 + fr;
        const float* gate = MOD + (size_t)mod_row(u.pm * 256) * 3 * D + 2 * D;
        f32x4 gv[2][2];
#pragma unroll
        for (int bj = 0; bj < 2; ++bj)
#pragma unroll
            for (int n = 0; n < 2; ++n) gv[bj][n] = *(const f32x4*)(gate + colt + bj * 128 + wc * 32 + 16 * n + 4 * fq);
#pragma unroll
        for (int ai = 0; ai < 2; ++ai)
#pragma unroll
            for (int mp = 0; mp < 2; ++mp) {
                f32x4 xi[2][2][2];
#pragma unroll
                for (int mm = 0; mm < 2; ++mm) { const int row = row0 + ai * 128 + (mp * 2 + mm) * 16; const float* xin = row < MP ? XP + (size_t)row * D : XS + (size_t)(row - MP) * D;
#pragma unroll
                    for (int bj = 0; bj < 2; ++bj)
#pragma unroll
                        for (int n = 0; n < 2; ++n) xi[mm][bj][n] = *(const f32x4*)(xin + colt + bj * 128 + wc * 32 + 16 * n + 4 * fq); }
#pragma unroll
                for (int mm = 0; mm < 2; ++mm) { const int m = mp * 2 + mm, row = row0 + ai * 128 + m * 16;
#pragma unroll
                    for (int bj = 0; bj < 2; ++bj)
#pragma unroll
                        for (int n = 0; n < 2; ++n) *(f32x4*)(X + (size_t)row * D + colt + bj * 128 + wc * 32 + 16 * n + 4 * fq) = xi[mm][bj][n] + gv[bj][n] * acc[ai][bj][m][n]; }
                CFENCE;
            }
    }
};

__device__ __forceinline__ void transpose_cvt(LAS float* tile, const float* src, h16* dst, int K, int N, int bid, int G) {
    const int nkt = K / 64, nnt = N / 64, tid = threadIdx.x;
    for (int t = bid; t < nkt * nnt; t += G) {
        const int kt = t / nnt, ntile = t % nnt;
#pragma unroll
        for (int i = 0; i < 8; ++i) { const int idx = tid + i * 512, k = idx >> 6, n = idx & 63; tile[k * 65 + n] = src[(size_t)(kt * 64 + k) * N + ntile * 64 + n]; }
        __syncthreads();
#pragma unroll
        for (int i = 0; i < 8; ++i) { const int idx = tid + i * 512, n = idx >> 6, k = idx & 63; dst[(size_t)(ntile * 64 + n) * K + kt * 64 + k] = (h16)tile[k * 65 + n]; }
        __syncthreads();
    }
}
__device__ __forceinline__ void phase_prologue(const Params& p, LAS unsigned char* lds) {
    const int tid = threadIdx.x, bid = blockIdx.x, G = gridDim.x;
    unsigned char* ws = p.ws;
    {
        const int nitems = DEPTH * (3 * D / 128);
        if (bid < nitems) {
            LAS float* sc = (LAS float*)lds;
            LAS float* red = sc + NMODR * D;
            for (int i = tid; i < NMODR * D; i += NTHREADS) { const int r = i / D, k = i % D; const float c = r == 0 ? p.in[I_CCTX][k] : p.in[I_C][(size_t)(r - 1) * D + k]; sc[i] = siluf(c); }
            __syncthreads();
            for (int it = bid; it < nitems; it += G) {
                const int l = it / (3 * D / 128), j = (it % (3 * D / 128)) * 128 + (tid & 127), kg = tid >> 7;
                float a[NMODR];
#pragma unroll
                for (int r = 0; r < NMODR; ++r) a[r] = 0.f;
                const float* wp = p.in[I_WMOD] + (size_t)l * D * 3 * D + j;
                for (int k = kg * (D / 4); k < (kg + 1) * (D / 4); k += 8) { float w8[8];
#pragma unroll
                    for (int kk = 0; kk < 8; ++kk) w8[kk] = wp[(size_t)(k + kk) * 3 * D];
#pragma unroll
                    for (int kk = 0; kk < 8; ++kk)
#pragma unroll
                        for (int r = 0; r < NMODR; ++r) a[r] += sc[r * D + k + kk] * w8[kk]; }
#pragma unroll
                for (int r = 0; r < NMODR; ++r) red[(kg * NMODR + r) * 128 + (tid & 127)] = a[r];
                __syncthreads();
                for (int i = tid; i < NMODR * 128; i += NTHREADS) { const int r = i / 128, jj = i % 128; const int jcol = (it % (3 * D / 128)) * 128 + jj;
                    const float s = red[(0 * NMODR + r) * 128 + jj] + red[(1 * NMODR + r) * 128 + jj] + red[(2 * NMODR + r) * 128 + jj] + red[(3 * NMODR + r) * 128 + jj];
                    ((float*)(ws + WS_MOD))[((size_t)l * NMODR + r) * 3 * D + jcol] = s + p.in[I_BMOD][(size_t)l * 3 * D + jcol]; }
                __syncthreads();
            }
        }
        __syncthreads();
    }
    for (int i = bid * NTHREADS + tid; i < 2 * W; i += G * NTHREADS) {
        const int dir = i / W, w = i % W; const float* lg = p.in[I_LBL] + (size_t)dir * DEPTH * W + w;
        float mx = -1e30f; for (int l = 0; l < DEPTH; ++l) mx = fmaxf(mx, lg[(size_t)l * W]);
        float den = 0.f; for (int l = 0; l < DEPTH; ++l) den += __expf(lg[(size_t)l * W] - mx);
        float cs = 0.f, first = 0.f;
        for (int l = 0; l < DEPTH; ++l) { cs += __expf(lg[(size_t)l * W] - mx) / den; if (l == 0) first = cs; ((float*)(ws + WS_LB))[((size_t)dir * DEPTH + l) * W + w] = cs - first; }
    }
    for (int i = bid * NTHREADS + tid; i < DEPTH * 2 * S5G * S5P; i += G * NTHREADS) {
        const int gidx = i / S5P;
        const float are = p.in[I_ARE][i], aim = p.in[I_AIM][i], dt = __expf(p.in[I_LDT][gidx]);
        const float mag = expf(are * dt), abr = mag * cosf(aim * dt), abi = mag * sinf(aim * dt);
        const float den = are * are + aim * aim, nre = abr - 1.0f;
        const float cre = (nre * are + abi * aim) / den, cim = (abi * are - nre * aim) / den;
        ((f32x2*)(ws + WS_ABAR))[i] = (f32x2){abr, abi};
        h16* bb = (h16*)(ws + WS_BBAR) + (size_t)i * 32;
        for (int c = 0; c < 16; ++c) { const float br = p.in[I_BRE][(size_t)i * 16 + c], bi = p.in[I_BIM][(size_t)i * 16 + c]; bb[c] = (h16)(cre * br - cim * bi); bb[16 + c] = (h16)(cre * bi + cim * br); }
    }
    for (int i = bid * NTHREADS + tid; i < DEPTH * 2 * S5G * 256; i += G * NTHREADS) {
        const int lane = i & 63, pt = (i >> 6) & 3, ldg = i >> 8, lr = lane & 15, q = lane >> 4;
        const int pi = ldg * S5P + lr + 16 * pt;
        const float are = p.in[I_ARE][pi], aim = p.in[I_AIM][pi], dt = __expf(p.in[I_LDT][ldg]);
        const float mag = expf(are * dt), abr = mag * cosf(aim * dt), abi = mag * sinf(aim * dt);
        const float den = are * are + aim * aim, nre = abr - 1.0f;
        const float cre = (nre * are + abi * aim) / den, cim = (abi * are - nre * aim) / den;
        float pr = abr, pim = abi;
        float a16r, a16i, a32r, a32i;
        for (int k = 0; k < 4; ++k) { const float nr = pr * pr - pim * pim, ni = 2.0f * pr * pim; pr = nr; pim = ni; }
        a16r = pr; a16i = pim; a32r = pr * pr - pim * pim; a32i = 2.0f * pr * pim;
        const float a48r = a32r * a16r - a32i * a16i, a48i = a32r * a16i + a32i * a16r, a64r = a32r * a32r - a32i * a32i, a64i = 2.0f * a32r * a32i;
        float* tb = (float*)(ws + WS_S5T) + (size_t)i * 12;
        tb[0] = abr; tb[1] = abi; tb[2] = a16r; tb[3] = a16i; tb[4] = a32r; tb[5] = a32i;
        tb[6] = q == 0 ? a16r : (q == 1 ? a32r : (q == 2 ? a48r : a64r)); tb[7] = q == 0 ? a16i : (q == 1 ? a32i : (q == 2 ? a48i : a64i));
        h16* hb = (h16*)(tb + 8);
        for (int j = 0; j < 4; ++j) { const float br = p.in[I_BRE][(size_t)pi * 16 + 4 * q + j], bi = p.in[I_BIM][(size_t)pi * 16 + 4 * q + j]; hb[j] = (h16)(cre * br - cim * bi); hb[4 + j] = (h16)(cre * bi + cim * br); }
    }
    for (int i = bid * NTHREADS + tid; i < DEPTH * S5G * 256; i += G * NTHREADS) {
        const int ks = i & 3, lane = (i >> 2) & 63, lg = i >> 8, lr = lane & 15, q = lane >> 4;
        h16* cb = (h16*)(ws + WS_S5C) + (size_t)i * 8;
        for (int j = 0; j < 8; ++j) { const int pp = 4 * ks + q + 16 * (j >> 1); const size_t ci = ((size_t)lg * 16 + lr) * S5P + pp; cb[j] = (j & 1) ? (h16)(-p.in[I_CIM][ci]) : (h16)p.in[I_CRE][ci]; }
    }
    for (int i = bid * NTHREADS + tid; i < (DSEQ / 64 + 64) * 32; i += G * NTHREADS) {
        const int pos = i / 32, j = i % 32; const float inv = exp2f(-(float)j * (13.287712379549449f / 32.0f));
        const float ang = (float)(pos < DSEQ / 64 ? pos : pos - DSEQ / 64) * inv;
        ((f32x2*)(ws + WS_ROPE))[i] = (f32x2){cosf(ang), sinf(ang)};
    }
    LAS float* tile = (LAS float*)lds;
    for (int l = 0; l < DEPTH; ++l) {
        transpose_cvt(tile, p.in[I_WIN] + (size_t)l * D * INC, (h16*)(ws + WS_WIN) + (size_t)l * INC * D, D, INC, bid, G);
        transpose_cvt(tile, p.in[I_WGLU] + (size_t)l * W * W, (h16*)(ws + WS_WGLU) + (size_t)l * W * W, W, W, bid, G);
        transpose_cvt(tile, p.in[I_WBRHG] + (size_t)l * W * D, (h16*)(ws + WS_WBR) + (size_t)(l * 3 + 0) * D * W, W, D, bid, G);
        transpose_cvt(tile, p.in[I_WBRAT] + (size_t)l * W * D, (h16*)(ws + WS_WBR) + (size_t)(l * 3 + 1) * D * W, W, D, bid, G);
        transpose_cvt(tile, p.in[I_WBRS5] + (size_t)l * W * D, (h16*)(ws + WS_WBR) + (size_t)(l * 3 + 2) * D * W, W, D, bid, G);
        transpose_cvt(tile, p.in[I_WOUT] + (size_t)l * D * D, (h16*)(ws + WS_WOUT) + (size_t)l * D * D, D, D, bid, G);
    }
}

__device__ __forceinline__ void phase_norm(const Params& p, int l) {
    int tid_ = threadIdx.x; LAUNDER(tid_);
    const int lane = tid_ & 63, gw = blockIdx.x * NWAVES + (tid_ >> 6), nw = gridDim.x * NWAVES;
    const float* nwt = p.in[I_NORMW] + (size_t)l * D;
    const float* MOD = (const float*)(p.ws + WS_MOD) + (size_t)l * NMODR * 3 * D;
    h16* H = (h16*)(p.ws + WS_H);
    for (int row = gw; row < M; row += nw) {
        const float* x = l == 0 ? (row < MP ? p.in[I_XP] + (size_t)row * D : p.in[I_XS] + (size_t)(row - MP) * D) : (const float*)(p.ws + WS_X) + (size_t)row * D;
        f32x4 v[D / 256]; float ss = 0.f;
#pragma unroll
        for (int i = 0; i < D / 256; ++i) { v[i] = *(const f32x4*)(x + i * 256 + lane * 4); ss += v[i][0] * v[i][0] + v[i][1] * v[i][1] + v[i][2] * v[i][2] + v[i][3] * v[i][3]; }
        ss = wave_sum(ss, lane);
        const float rstd = rsqrtf(ss / (float)D + EPS);
        const float* md = MOD + (size_t)mod_row(row) * 3 * D;
#pragma unroll
        for (int i = 0; i < D / 256; ++i) { const int c = i * 256 + lane * 4; const f32x4 wv = *(const f32x4*)(nwt + c), sh = *(const f32x4*)(md + c), scl = *(const f32x4*)(md + D + c);
            h16x4 o;
#pragma unroll
            for (int j = 0; j < 4; ++j) o[j] = (h16)(v[i][j] * rstd * wv[j] * (1.0f + scl[j]) + sh[j]);
            *(h16x4*)(H + (size_t)row * D + c) = o; }
    }
}
__device__ __forceinline__ void phase_final(const Params& p) {
    int tid_ = threadIdx.x; LAUNDER(tid_);
    const int lane = tid_ & 63, gw = blockIdx.x * NWAVES + (tid_ >> 6), nw = gridDim.x * NWAVES;
    const float* fw = p.in[I_FNORM];
    for (int row = gw; row < M; row += nw) {
        const float* x = (const float*)(p.ws + WS_X) + (size_t)row * D;
        f32x4 v[D / 256]; float ss = 0.f;
#pragma unroll
        for (int i = 0; i < D / 256; ++i) { v[i] = *(const f32x4*)(x + i * 256 + lane * 4); ss += v[i][0] * v[i][0] + v[i][1] * v[i][1] + v[i][2] * v[i][2] + v[i][3] * v[i][3]; }
        ss = wave_sum(ss, lane);
        const float rstd = rsqrtf(ss / (float)D + EPS);
#pragma unroll
        for (int i = 0; i < D / 256; ++i) { const int c = i * 256 + lane * 4; const f32x4 wv = *(const f32x4*)(fw + c);
            *(f32x4*)(p.out + O_Y + (size_t)row * D + c) = v[i] * rstd * wv; }
    }
}

constexpr int PV_LS = 264;
__device__ __forceinline__ void prep_vt_store(LAS h16* VL, h16* VTrow0, int NKs, int pos0, int tid) {
#pragma unroll
    for (int i = 0; i < KVW * 8 / NTHREADS; ++i) { const int id = tid + NTHREADS * i, dk = id >> 3, tc = id & 7; h16x8 o;
#pragma unroll
        for (int j = 0; j < 8; ++j) o[j] = VL[(tc * 8 + j) * PV_LS + dk];
        *(h16x8*)(VTrow0 + (size_t)dk * NKs + pos0 + tc * 8) = o; }
}
__device__ __forceinline__ void prep_tile(const Params& p, int l, int tile, LAS unsigned char* lds) {
    int tid = threadIdx.x; LAUNDER(tid);
    const int w = tid >> 6, lane = tid & 63;
    LAS h16* VL = (LAS h16*)lds;
    constexpr int NT_REAL = M / 64;
    if (tile >= NT_REAL) {
        const int ct = tile - NT_REAL, b = ct / (PAST / 64), pos0 = (ct % (PAST / 64)) * 64;
        const float* ck = p.in[I_CK] + (((size_t)b * DEPTH + l) * PAST + pos0) * KVW; const float* cv = p.in[I_CV] + (((size_t)b * DEPTH + l) * PAST + pos0) * KVW;
        h16* kd = (h16*)(p.ws + WS_KBS) + ((size_t)b * KVLEN + pos0) * KVW;
#pragma unroll
        for (int i = 0; i < 64 * KVW / 8 / NTHREADS; ++i) { const int id = tid + NTHREADS * i, row = id / (KVW / 8), c = id % (KVW / 8);
            const f32x4 k0 = *(const f32x4*)(ck + (size_t)row * KVW + c * 8), k1 = *(const f32x4*)(ck + (size_t)row * KVW + c * 8 + 4);
            const f32x4 v0 = *(const f32x4*)(cv + (size_t)row * KVW + c * 8), v1 = *(const f32x4*)(cv + (size_t)row * KVW + c * 8 + 4);
            h16x8 ko, vo;
#pragma unroll
            for (int j = 0; j < 4; ++j) { ko[j] = (h16)k0[j]; ko[4 + j] = (h16)k1[j]; vo[j] = (h16)v0[j]; vo[4 + j] = (h16)v1[j]; }
            *(h16x8*)(kd + (size_t)row * KVW + c * 8) = ko; *(LAS h16x8*)(VL + row * PV_LS + c * 8) = vo; }
        __syncthreads();
        prep_vt_store(VL, (h16*)(p.ws + WS_VBS) + (size_t)b * KVW * KVLEN, KVLEN, pos0, tid);
        __syncthreads();
        return;
    }
    const int r0 = tile * 64; const bool smp = r0 >= MP;
    const int b = smp ? (r0 - MP) / DSEQ : r0 / SEQ, t0 = smp ? (r0 - MP) % DSEQ : r0 % SEQ;
    const h16* Z = (const h16*)(p.ws + WS_Z);
#pragma unroll
    for (int i = 0; i < 64 * KVW / 8 / NTHREADS; ++i) { const int id = tid + NTHREADS * i, row = id / (KVW / 8), c = id % (KVW / 8);
        const h16x8 v = *(const h16x8*)(Z + (size_t)(r0 + row) * INC + C_AV + c * 8);
        *(LAS h16x8*)(VL + row * PV_LS + c * 8) = v;
        if (!smp) { float* cvo = p.out + O_CV + (((size_t)b * DEPTH + l) * SEQ + t0 + row) * KVW + c * 8; f32x4 a, bq;
#pragma unroll
            for (int j = 0; j < 4; ++j) { a[j] = (float)v[j]; bq[j] = (float)v[4 + j]; }
            *(f32x4*)cvo = a; *(f32x4*)(cvo + 4) = bq; } }
    __syncthreads();
    if (smp) prep_vt_store(VL, (h16*)(p.ws + WS_VBS) + (size_t)b * KVW * KVLEN, KVLEN, PAST + t0, tid);
    else prep_vt_store(VL, (h16*)(p.ws + WS_VBC) + (size_t)b * KVW * SEQ, SEQ, t0, tid);
    constexpr int NH = AQH + AKVH;
    const float wq0 = p.in[I_QNORM][(size_t)l * 128 + lane], wq1 = p.in[I_QNORM][(size_t)l * 128 + lane + 64], wk0 = p.in[I_KNORM][(size_t)l * 128 + lane], wk1 = p.in[I_KNORM][(size_t)l * 128 + lane + 64];
    const f32x2* ROPE = (const f32x2*)(p.ws + WS_ROPE);
    constexpr int PQN = 16;
    for (int it0 = w; it0 < 64 * NH; it0 += PQN * NWAVES) {
        float x0[PQN], x1[PQN]; f32x2 cr[PQN], cc[PQN];
#pragma unroll
        for (int k = 0; k < PQN; ++k) { const int it = it0 + k * NWAVES; x0[k] = 0.f; x1[k] = 0.f; if (it >= 64 * NH) continue; const int row = it / NH, hh = it % NH; const bool isq = hh < AQH;
            const h16* src = Z + (size_t)(r0 + row) * INC + (isq ? C_AQ + hh * 128 : C_AK + (hh - AQH) * 128);
            x0[k] = (float)src[lane]; x1[k] = (float)src[lane + 64];
            if (smp) { const int t = t0 + row; cr[k] = ROPE[(t / 64) * 32 + (lane & 31)]; cc[k] = ROPE[(DSEQ / 64 + (t % 64)) * 32 + (lane & 31)]; } }
#pragma unroll
        for (int k = 0; k < PQN; ++k) { const int it = it0 + k * NWAVES; if (it >= 64 * NH) continue; const int row = it / NH, hh = it % NH; const bool isq = hh < AQH; const int t = t0 + row;
            const float ss = wave_sum(x0[k] * x0[k] + x1[k] * x1[k], lane);
            const float rstd = rsqrtf(ss * (1.0f / 128.0f) + EPS);
            float a0 = x0[k] * rstd * (isq ? wq0 : wk0), a1 = x1[k] * rstd * (isq ? wq1 : wk1);
            if (!isq && !smp) { float* cko = p.out + O_CK + (((size_t)b * DEPTH + l) * SEQ + t) * KVW + (hh - AQH) * 128; cko[lane] = a0; cko[lane + 64] = a1; }
            if (smp) { const float p0 = shfl_xor_l(a0, 32, lane), p1 = shfl_xor_l(a1, 32, lane);
                a0 = lane < 32 ? a0 * cr[k][0] - p0 * cr[k][1] : a0 * cr[k][0] + p0 * cr[k][1];
                a1 = lane < 32 ? a1 * cc[k][0] - p1 * cc[k][1] : a1 * cc[k][0] + p1 * cc[k][1]; }
            if (isq) { h16* dst = (h16*)(p.ws + WS_AQ2) + (size_t)(r0 + row) * W + hh * 128; const float sc = 0.08838834764831845f; dst[lane] = (h16)(a0 * sc); dst[lane + 64] = (h16)(a1 * sc); }
            else { h16* dst = (smp ? (h16*)(p.ws + WS_KBS) + ((size_t)b * KVLEN + PAST + t) * KVW : (h16*)(p.ws + WS_KBC) + ((size_t)b * SEQ + t) * KVW) + (hh - AQH) * 128; dst[lane] = (h16)a0; dst[lane + 64] = (h16)a1; } }
    }
    __syncthreads();
}
constexpr int S5_STS = 136, S5_WAVE_LDS = 64 * S5_STS * 2;
static_assert(NWAVES * S5_WAVE_LDS <= MISC_OFF, "S5 LDS");
struct cpx { float r, i; };
__device__ __forceinline__ cpx cmulf(cpx a, cpx b) { return cpx{a.r * b.r - a.i * b.i, a.r * b.i + a.i * b.r}; }
#ifdef HOST_SIM
__device__ __forceinline__ cpx cfma(cpx a, cpx b, cpx c) { return cpx{a.r * b.r - a.i * b.i + c.r, a.r * b.i + a.i * b.r + c.i}; }
#else
__device__ __forceinline__ cpx cfma(cpx a, cpx b, cpx c) {
    float t0, t1, r, i;
    asm("v_fma_f32 %0, -%1, %2, %3" : "=v"(t0) : "v"(a.i), "v"(b.i), "v"(c.r));
    asm("v_fma_f32 %0, %1, %2, %3" : "=v"(r) : "v"(a.r), "v"(b.r), "v"(t0));
    asm("v_fma_f32 %0, %1, %2, %3" : "=v"(t1) : "v"(a.r), "v"(b.i), "v"(c.i));
    asm("v_fma_f32 %0, %1, %2, %3" : "=v"(i) : "v"(a.i), "v"(b.r), "v"(t1));
    return cpx{r, i};
}
#endif
__device__ __forceinline__ cpx cshfl_up(cpx v, int d, int lane) { return cpx{shfl_up_l(v.r, d, lane), shfl_up_l(v.i, d, lane)}; }
__device__ __forceinline__ void c_s5(const Params& p, int l, int item, int lane, LAS unsigned char* ldsw) {
    const int dir = item & 1, g = (item >> 1) % S5G, sq = (item >> 1) / S5G;
    const bool smp = sq < DBATCH; const int b = smp ? sq : sq - DBATCH;
    const int T = smp ? DSEQ : SEQ, row0 = smp ? MP + b * DSEQ : b * SEQ;
    const h16* Z = (const h16*)(p.ws + WS_Z);
    h16* Y = (h16*)(p.ws + (dir ? WS_YB : WS_YF));
    LAS h16* ST = (LAS h16*)ldsw;
    const int lr = lane & 15, q = lane >> 4;
    cpx sp0 = cpx{0.f, 0.f}, sp1 = sp0, sp2 = sp0, sp3 = sp0;
    h16x8 cfr[4];
    if (smp) { const size_t si0 = (((size_t)b * DEPTH + l) * 2 + dir) * S5G * S5P + (size_t)g * S5P + lr;
        sp0 = cpx{p.in[I_SR][si0], p.in[I_SI][si0]}; sp1 = cpx{p.in[I_SR][si0 + 16], p.in[I_SI][si0 + 16]}; sp2 = cpx{p.in[I_SR][si0 + 32], p.in[I_SI][si0 + 32]}; sp3 = cpx{p.in[I_SR][si0 + 48], p.in[I_SI][si0 + 48]}; }
    { const h16x8* cb = (const h16x8*)(p.ws + WS_S5C) + (((size_t)l * S5G + g) * 64 + lane) * 4;
#pragma unroll
      for (int ks = 0; ks < 4; ++ks) cfr[ks] = cb[ks]; }
    const f32x4* tab = (const f32x4*)(p.ws + WS_S5T) + ((((size_t)l * 2 + dir) * S5G + g) * 256 + lane) * 3;
    f32x4 tn0 = tab[0], tn1 = tab[1], tn2 = tab[2];
    float one_ = 1.0f; LAUNDER(one_);
    const int NB = T / 64;
    const int tb0 = 16 * (lr >> 2) + (lr & 3);
    h16x4 uf[4], un[4];
#define S5_ULOAD(U, bk) do { _Pragma("unroll") for (int k = 0; k < 4; ++k) { const int tt = (bk) * 64 + tb0 + 4 * k; const int row = row0 + (dir ? T - 1 - tt : tt); \
        U[k] = *(const h16x4*)(Z + (size_t)row * INC + C_SU + g * 16 + 4 * q); } } while (0)
    S5_ULOAD(un, 0);
#pragma unroll 1
    for (int blk = 0; blk < NB; ++blk) {
#pragma unroll
        for (int k = 0; k < 4; ++k) uf[k] = un[k];
        { const int nb = blk + 1 < NB ? blk + 1 : blk; S5_ULOAD(un, nb); }
#pragma unroll 1
        for (int pt = 0; pt < 4; ++pt) {
            const f32x4 tc0 = tn0, tc1 = tn1, tc2 = tn2;
            { const f32x4* tp = tab + (size_t)((pt + 1) & 3) * 192; tn0 = tp[0]; tn1 = tp[1]; tn2 = tp[2]; }
            const cpx a1 = cpx{tc0[0], tc0[1]}, a16 = cpx{tc0[2], tc0[3]}, a32 = cpx{tc1[0], tc1[1]}, apq = cpx{tc1[2], tc1[3]};
            const h16x8 bfr = __builtin_bit_cast(h16x8, tc2);
            const h16x4 bre = {bfr[0], bfr[1], bfr[2], bfr[3]}, bim = {bfr[4], bfr[5], bfr[6], bfr[7]};
            const cpx a16m = cpx{q >= 1 ? a16.r : 0.f, q >= 1 ? a16.i : 0.f}, a32m = cpx{q >= 2 ? a32.r : 0.f, q >= 2 ? a32.i : 0.f};
            const cpx sp = cpx{pt == 0 ? sp0.r : (pt == 1 ? sp1.r : (pt == 2 ? sp2.r : sp3.r)), pt == 0 ? sp0.i : (pt == 1 ? sp1.i : (pt == 2 ? sp2.i : sp3.i))};
            f32x4 zr[4], zi[4];
#pragma unroll
            for (int k = 0; k < 4; ++k) { zr[k] = (f32x4){0.f, 0.f, 0.f, 0.f}; zi[k] = (f32x4){0.f, 0.f, 0.f, 0.f}; zr[k] = MFMA16K16(uf[k], bre, zr[k]); zi[k] = MFMA16K16(uf[k], bim, zi[k]); }
#pragma unroll
            for (int k = 0; k < 4; ++k) { zr[k] = zr[k] * one_; zi[k] = zi[k] * one_; }
            cpx e = cpx{zr[0][0], zi[0][0]};
#pragma unroll
            for (int j = 1; j < 16; ++j) e = cfma(a1, e, cpx{zr[j >> 2][j & 3], zi[j >> 2][j & 3]});
            { const cpx er = cshfl_up(e, 16, lane); e = cfma(a16m, er, e); }
            { const cpx er = cshfl_up(e, 32, lane); e = cfma(a32m, er, e); }
            const cpx E = cfma(apq, sp, e);
            const cpx Eup = cshfl_up(E, 16, lane);
            cpx zc = cpx{q == 0 ? sp.r : Eup.r, q == 0 ? sp.i : Eup.i};
            const cpx spn = cpx{shfl_l(E.r, lr + 48), shfl_l(E.i, lr + 48)};
            if (pt == 0) sp0 = spn; else if (pt == 1) sp1 = spn; else if (pt == 2) sp2 = spn; else sp3 = spn;
#pragma unroll
            for (int j = 0; j < 16; ++j) { zc = cfma(a1, zc, cpx{zr[j >> 2][j & 3], zi[j >> 2][j & 3]});
                *(LAS unsigned*)(ST + (16 * q + j) * S5_STS + 8 * lr + 2 * pt) = cvtpk_h(zc.r, zc.i); }
        }
        WAVE_LDS_SYNC();
#pragma unroll
        for (int m = 0; m < 4; ++m) {
            f32x4 acc = (f32x4){0.f, 0.f, 0.f, 0.f};
#pragma unroll
            for (int ks = 0; ks < 4; ++ks) { const h16x8 afr = *(const LAS h16x8*)(ST + (16 * m + lr) * S5_STS + 32 * ks + 8 * q); acc = MFMA16(afr, cfr[ks], acc); }
#pragma unroll
            for (int i = 0; i < 4; ++i) { const int tt = blk * 64 + 16 * m + 4 * q + i; const int row = row0 + (dir ? T - 1 - tt : tt); Y[(size_t)row * W + g * 16 + lr] = (h16)acc[i]; }
        }
        WAVE_LDS_SYNC();
    }
#undef S5_ULOAD
    if (!smp && q == 0) {
#pragma unroll
        for (int pt = 0; pt < 4; ++pt) { const size_t so = (((size_t)b * DEPTH + l) * 2 + dir) * S5G * S5P + (size_t)g * S5P + lr + 16 * pt; const cpx sv = pt == 0 ? sp0 : (pt == 1 ? sp1 : (pt == 2 ? sp2 : sp3)); p.out[O_SR + so] = sv.r; p.out[O_SI + so] = sv.i; }
    }
}
typedef __bf16 bf16;
typedef bf16 bf16x8 __attribute__((ext_vector_type(8)));
typedef bf16 bf16x4 __attribute__((ext_vector_type(4)));
#ifdef HOST_SIM
#define MFMA16B(a, b, c) sim::mfma16<0>(&(a), &(b), c)
#else
#define MFMA16B(a, b, c) __builtin_amdgcn_mfma_f32_16x16x32_bf16(a, b, c, 0, 0, 0)
#endif
constexpr int HS_QK = 136, HS_T = 40;
constexpr int HG_QH = 0, HG_KH = HG_QH + 32 * HS_QK * 2, HG_KHT = HG_KH + 32 * HS_QK * 2, HG_VT = HG_KHT + 128 * HS_T * 2, HG_P = HG_VT + 2 * 128 * HS_T * 2,
              HG_SST = HG_P + 2 * 32 * HS_T * 2, HG_END = HG_SST + 128 * HS_QK * 2;
static_assert(HG_END <= STAGE_BYTES, "hgrn LDS");
__device__ __forceinline__ void hgrn_item(const Params& p, int l, int sq, int h, int dir, LAS unsigned char* lds) {
    int tid = threadIdx.x; LAUNDER(tid);
    const int w = tid >> 6, lane = tid & 63, lr = lane & 15, lq = lane >> 4;
    const bool smp = sq < DBATCH; const int b = smp ? sq : sq - DBATCH;
    const int T = smp ? DSEQ : SEQ, row0 = smp ? MP + b * DSEQ : b * SEQ, NC = T / 32;
    const h16* Z = (const h16*)(p.ws + WS_Z); const float* LOGF = (const float*)(p.ws + WS_LOGF);
    h16* O = (h16*)(p.ws + (dir ? WS_OB : WS_OF));
    LAS bf16* QH = (LAS bf16*)(lds + HG_QH); LAS bf16* KH = (LAS bf16*)(lds + HG_KH); LAS bf16* KHT = (LAS bf16*)(lds + HG_KHT);
    LAS bf16* VT = (LAS bf16*)(lds + HG_VT); LAS bf16* PP = (LAS bf16*)(lds + HG_P); LAS bf16* SST = (LAS bf16*)(lds + HG_SST);
    const int dcol = 16 * w + lr;
    f32x4 S[8];
    if (smp) { const float* s0 = p.in[I_SH] + ((((size_t)b * DEPTH + l) * 2 + dir) * HGH + h) * 128 * 128;
#pragma unroll
        for (int vt = 0; vt < 8; ++vt)
#pragma unroll
            for (int i = 0; i < 4; ++i) S[vt][i] = s0[(size_t)(16 * w + 4 * lq + i) * 128 + 16 * vt + lr]; }
    else {
#pragma unroll
        for (int vt = 0; vt < 8; ++vt) S[vt] = (f32x4){0.f, 0.f, 0.f, 0.f}; }
    float lf[8]; h16 qv[8], vv[8];
    const unsigned voffz = (unsigned)(((dir ? 31 - 8 * lq : 8 * lq) * INC + h * 128 + dcol) * 2);
    const unsigned voffl = (unsigned)(((dir ? 31 - 8 * lq : 8 * lq) * 2 * W + dir * W + h * 128 + dcol) * 4);
    const unsigned voffo = (unsigned)(((dir ? 31 - 4 * lq : 4 * lq) * W + h * 128 + 16 * w + lr) * 2);
    const long sgn = dir ? -1 : 1;
#define HG_LOAD(c) do { const int rlo = dir ? row0 + T - 32 * (c) - 32 : row0 + 32 * (c); const char* zb = (const char*)Z + (size_t)rlo * INC * 2; const char* lb = (const char*)LOGF + (size_t)rlo * 2 * W * 4; \
        _Pragma("unroll") for (int i = 0; i < 8; ++i) { const char* zi_ = zb + sgn * i * (long)(INC * 2); const char* li_ = lb + sgn * i * (long)(2 * W * 4); \
            lf[i] = *(const float*)(li_ + voffl); qv[i] = *(const h16*)(zi_ + C_HQ * 2 + voffz); vv[i] = *(const h16*)(zi_ + C_HI * 2 + voffz); } } while (0)
    HG_LOAD(0);
    for (int c = 0; c < NC; ++c) {
        const int buf = c & 1;
        float bc[8]; float run = 0.f;
#pragma unroll
        for (int i = 0; i < 8; ++i) { run += lf[i]; bc[i] = run; }
        const float t0 = shfl_l(run, lr), t1 = shfl_l(run, lr + 16), t2 = shfl_l(run, lr + 32), t3 = shfl_l(run, lr + 48);
        const float pre = (lq > 0 ? t0 : 0.f) + (lq > 1 ? t1 : 0.f) + (lq > 2 ? t2 : 0.f), bl = (t0 + t1) + (t2 + t3);
        bf16x8 kht, vtv;
#pragma unroll
        for (int i = 0; i < 8; ++i) { const float bi = pre + bc[i]; const float kk = (1.0f - __expf(lf[i])) * __expf(bl - bi), qq = (float)qv[i] * __expf(bi - bl);
            const int t = 8 * lq + i; QH[t * HS_QK + dcol] = (bf16)qq; KH[t * HS_QK + dcol] = (bf16)kk; kht[i] = (bf16)kk; vtv[i] = (bf16)(float)vv[i]; }
        *(LAS bf16x8*)(KHT + dcol * HS_T + 8 * lq) = kht;
        *(LAS bf16x8*)(VT + buf * 128 * HS_T + dcol * HS_T + 8 * lq) = vtv;
        const float ebl = __expf(bl);
#pragma unroll
        for (int i = 0; i < 4; ++i) { const float e = shfl_l(ebl, 4 * lq + i);
#pragma unroll
            for (int vt = 0; vt < 8; ++vt) S[vt][i] *= e; }
#pragma unroll
        for (int vt = 0; vt < 8; ++vt) { bf16x4 sv; sv[0] = (bf16)S[vt][0]; sv[1] = (bf16)S[vt][1]; sv[2] = (bf16)S[vt][2]; sv[3] = (bf16)S[vt][3];
            *(LAS bf16x4*)(SST + (16 * vt + lr) * HS_QK + 16 * w + 4 * lq) = sv; }
        if (c + 1 < NC) HG_LOAD(c + 1);
        __syncthreads();
        f32x4 oi[2] = {(f32x4){0.f, 0.f, 0.f, 0.f}, (f32x4){0.f, 0.f, 0.f, 0.f}};
#pragma unroll
        for (int ks = 0; ks < 4; ++ks) { const bf16x8 bfr = *(const LAS bf16x8*)(SST + (16 * w + lr) * HS_QK + 32 * ks + 8 * lq);
#pragma unroll
            for (int ti = 0; ti < 2; ++ti) { const bf16x8 afr = *(const LAS bf16x8*)(QH + (16 * ti + lr) * HS_QK + 32 * ks + 8 * lq); oi[ti] = MFMA16B(afr, bfr, oi[ti]); } }
        if (w < 3) { const int ti = (w + 1) >> 1, si = w >> 1;
            f32x4 sc = (f32x4){0.f, 0.f, 0.f, 0.f};
#pragma unroll
            for (int ks = 0; ks < 4; ++ks) { const bf16x8 afr = *(const LAS bf16x8*)(QH + (16 * ti + lr) * HS_QK + 32 * ks + 8 * lq), bfr = *(const LAS bf16x8*)(KH + (16 * si + lr) * HS_QK + 32 * ks + 8 * lq);
                sc = MFMA16B(afr, bfr, sc); }
#pragma unroll
            for (int i = 0; i < 4; ++i) { const int t = 16 * ti + 4 * lq + i, s_ = 16 * si + lr; PP[buf * 32 * HS_T + t * HS_T + s_] = (bf16)(s_ <= t ? sc[i] : 0.f); }
        } else if (w == 3) {
#pragma unroll
            for (int i = 0; i < 4; ++i) PP[buf * 32 * HS_T + (4 * lq + i) * HS_T + 16 + lr] = (bf16)0.f;
        }
        { const bf16x8 afr = *(const LAS bf16x8*)(KHT + (16 * w + lr) * HS_T + 8 * lq);
#pragma unroll
          for (int vt = 0; vt < 8; ++vt) { const bf16x8 bfr = *(const LAS bf16x8*)(VT + buf * 128 * HS_T + (16 * vt + lr) * HS_T + 8 * lq); S[vt] = MFMA16B(afr, bfr, S[vt]); } }
        __syncthreads();
        { const bf16x8 bfr = *(const LAS bf16x8*)(VT + buf * 128 * HS_T + (16 * w + lr) * HS_T + 8 * lq);
#pragma unroll
          for (int ti = 0; ti < 2; ++ti) { const bf16x8 afr = *(const LAS bf16x8*)(PP + buf * 32 * HS_T + (16 * ti + lr) * HS_T + 8 * lq); oi[ti] = MFMA16B(afr, bfr, oi[ti]); } }
        { const int rlo = dir ? row0 + T - 32 * c - 32 : row0 + 32 * c; char* ob = (char*)O + (size_t)rlo * W * 2;
#pragma unroll
          for (int ti = 0; ti < 2; ++ti)
#pragma unroll
            for (int i = 0; i < 4; ++i) *(h16*)(ob + sgn * (16 * ti + i) * (long)(W * 2) + voffo) = (h16)oi[ti][i]; }
    }
#undef HG_LOAD
    if (!smp) { float* so = p.out + O_SH + ((((size_t)b * DEPTH + l) * 2 + dir) * HGH + h) * 128 * 128;
#pragma unroll
        for (int vt = 0; vt < 8; ++vt)
#pragma unroll
            for (int i = 0; i < 4; ++i) so[(size_t)(16 * w + 4 * lq + i) * 128 + 16 * vt + lr] = S[vt][i]; }
    __syncthreads();
}
template <int PARTS> __device__ __forceinline__ void phase_scans(const Params& p, int l, LAS unsigned char* lds) {
    int tid_ = threadIdx.x; LAUNDER(tid_);
    const int lane = tid_ & 63, gw = blockIdx.x * NWAVES + (tid_ >> 6), nw = gridDim.x * NWAVES;
    if (PARTS & 1) {
        constexpr int NL = DBATCH * HGH * 2, NS = BATCH * HGH * 2;
        const int G = gridDim.x, bid = blockIdx.x;
        for (int it = bid; it < NL; it += G) hgrn_item(p, l, it / (HGH * 2), (it >> 1) % HGH, it & 1, lds);
        if (NL < G) { if (bid >= NL) for (int it = bid - NL; it < NS; it += G - NL) hgrn_item(p, l, DBATCH + it / (HGH * 2), (it >> 1) % HGH, it & 1, lds); }
        else { for (int it = bid; it < NS; it += G) hgrn_item(p, l, DBATCH + it / (HGH * 2), (it >> 1) % HGH, it & 1, lds); }
    }
    constexpr int N_S5S = DBATCH * S5G * 2, N_S5C = BATCH * S5G * 2;
    LAS unsigned char* ldsw = lds + (tid_ >> 6) * S5_WAVE_LDS;
    if (PARTS & 2) {
    for (int it = gw; it < N_S5S; it += nw) c_s5(p, l, it, lane, ldsw);
    if (N_S5S < nw) { if (gw >= N_S5S) for (int it = gw - N_S5S; it < N_S5C; it += nw - N_S5S) c_s5(p, l, N_S5S + it, lane, ldsw); }
    else { for (int it = gw; it < N_S5C; it += nw) c_s5(p, l, N_S5S + it, lane, ldsw); }
    }
    if (PARTS & 4) { __syncthreads(); for (int t = blockIdx.x; t < M / 64 + DBATCH * PAST / 64; t += gridDim.x) prep_tile(p, l, t, lds); }
}

__device__ __forceinline__ int crow(int r, int hi) { return (r & 3) + 8 * (r >> 2) + 4 * hi; }
constexpr int AT_K = 0, AT_V = 32768, AT_OS = 136, AT_WS = 8 * 32 * AT_OS * 2;
__device__ __forceinline__ void attn_unit(const h16* Qb, const h16* Kb, const h16* VTb, int NK, const h16* Gb, h16* Ob, LAS unsigned char* lds, unsigned char* PS_WS) {
    int tid = threadIdx.x; LAUNDER(tid);
    const int wid = tid >> 6, lane = tid & 63, r32 = lane & 31, hi = lane >> 5;
    LAS float* wsf = (LAS float*)(lds + AT_WS) + wid * 64; LAS float* al_l = wsf; LAS float* li_l = wsf + 32;
    constexpr float C = 1.4426950408889634f;
    float m_reg = -1e30f, l_reg = 0.f;
    f32x16 o[4];
#pragma unroll
    for (int d = 0; d < 4; ++d)
#pragma unroll
        for (int r = 0; r < 16; ++r) o[d][r] = 0.f;
    h16x8 qr[8];
    { const h16* Qw = Qb + (size_t)(wid * 32 + r32) * W + hi * 8;
#pragma unroll
      for (int d0 = 0; d0 < 8; ++d0) qr[d0] = *(const h16x8*)(Qw + d0 * 16); }
    const int kr_ = tid >> 4, kc_ = tid & 15, vr_ = tid >> 3, vc_ = tid & 7;
    const int kst0 = kr_ * 256 + ((kc_ * 16) ^ ((kr_ & 15) << 4)), kst1 = (kr_ + 32) * 256 + ((kc_ * 16) ^ (((kr_ + 32) & 15) << 4));
    const int vst0 = vr_ * 128 + ((vc_ * 16) ^ (((vr_ >> 1) & 7) << 4)), vst1 = (vr_ + 64) * 128 + ((vc_ * 16) ^ ((((vr_ + 64) >> 1) & 7) << 4));
    const h16* kg0 = Kb + (size_t)kr_ * KVW + kc_ * 8; const h16* kg1 = Kb + (size_t)(kr_ + 32) * KVW + kc_ * 8;
    const h16* vg0 = VTb + (size_t)vr_ * NK + vc_ * 8; const h16* vg1 = VTb + (size_t)(vr_ + 64) * NK + vc_ * 8;
    const int NT = NK / 64;
    h16x8 kaA = *(const h16x8*)kg0, kbA = *(const h16x8*)kg1, vaA = *(const h16x8*)vg0, vbA = *(const h16x8*)vg1;
    *(LAS h16x8*)(lds + AT_K + kst0) = kaA; *(LAS h16x8*)(lds + AT_K + kst1) = kbA; *(LAS h16x8*)(lds + AT_V + vst0) = vaA; *(LAS h16x8*)(lds + AT_V + vst1) = vbA;
    h16x8 kaB, kbB, vaB, vbB;
#define AT_GLOAD(S, t) do { ka##S = *(const h16x8*)(kg0 + (size_t)(t) * 64 * KVW); kb##S = *(const h16x8*)(kg1 + (size_t)(t) * 64 * KVW); va##S = *(const h16x8*)(vg0 + (t) * 64); vb##S = *(const h16x8*)(vg1 + (t) * 64); } while (0)
#define AT_LWRITE(S, nb) do { *(LAS h16x8*)(lds + AT_K + (nb) + kst0) = ka##S; *(LAS h16x8*)(lds + AT_K + (nb) + kst1) = kb##S; *(LAS h16x8*)(lds + AT_V + (nb) + vst0) = va##S; *(LAS h16x8*)(lds + AT_V + (nb) + vst1) = vb##S; } while (0)
    AT_GLOAD(A, 1); AT_GLOAD(B, (2 < NT ? 2 : 1));
    __syncthreads();
    PSPIN_T0(1)
#define AT_TILE(j, S) do { \
        const int buf = (j) & 1; \
        const LAS unsigned char* Kl = lds + AT_K + buf * 16384; const LAS unsigned char* Vl = lds + AT_V + buf * 16384; \
        f32x16 p0, p1; \
        _Pragma("unroll") for (int r = 0; r < 16; ++r) { p0[r] = 0.f; p1[r] = 0.f; } \
        _Pragma("unroll") for (int d0 = 0; d0 < 8; ++d0) { const int cb = (d0 * 16 + hi * 8) * 2; \
            const h16x8 b0 = *(const LAS h16x8*)(Kl + r32 * 256 + (cb ^ ((r32 & 15) << 4))); \
            const h16x8 b1 = *(const LAS h16x8*)(Kl + (32 + r32) * 256 + (cb ^ ((r32 & 15) << 4))); \
            p0 = MFMA32(b0, qr[d0], p0); p1 = MFMA32(b1, qr[d0], p1); } \
        float pmax = p0[0]; \
        _Pragma("unroll") for (int r = 1; r < 16; ++r) pmax = fmaxf(pmax, p0[r]); \
        _Pragma("unroll") for (int r = 0; r < 16; ++r) pmax = fmaxf(pmax, p1[r]); \
        { unsigned ra, rb; permlane32_swap_u(__builtin_bit_cast(unsigned, pmax), __builtin_bit_cast(unsigned, pmax), ra, rb); pmax = fmaxf(__builtin_bit_cast(float, ra), __builtin_bit_cast(float, rb)); } \
        const bool keep = WAVE_ALL(pmax - m_reg <= 8.0f);             \
        const float mn = keep ? m_reg : fmaxf(m_reg, pmax), alpha = keep ? 1.0f : EXP2F((m_reg - mn) * C), mnC = -mn * C; m_reg = mn; \
        float ps = 0.f; \
        _Pragma("unroll") for (int r = 0; r < 16; ++r) { p0[r] = EXP2F(fmaf(p0[r], C, mnC)); p1[r] = EXP2F(fmaf(p1[r], C, mnC)); ps += p0[r] + p1[r]; } \
        { unsigned ra, rb; permlane32_swap_u(__builtin_bit_cast(unsigned, ps), __builtin_bit_cast(unsigned, ps), ra, rb); ps = __builtin_bit_cast(float, ra) + __builtin_bit_cast(float, rb); } \
        l_reg = l_reg * alpha + ps; \
        if (!keep) { if (hi == 0) al_l[r32] = alpha; \
        WAVE_LDS_SYNC(); \
        _Pragma("unroll") for (int r = 0; r < 16; ++r) { const float a = al_l[crow(r, hi)]; \
            _Pragma("unroll") for (int d = 0; d < 4; ++d) o[d][r] *= a; } \
        WAVE_LDS_SYNC(); } \
        h16x8 pa[4]; \
        PK4(p0, 0, pa[0]); PK4(p0, 8, pa[1]); PK4(p1, 0, pa[2]); PK4(p1, 8, pa[3]); \
        _Pragma("unroll") for (int d0 = 0; d0 < 4; ++d0) { const int vrow = d0 * 32 + r32; \
            _Pragma("unroll") for (int ks = 0; ks < 4; ++ks) { const int cb = (ks * 16 + hi * 8) * 2; \
                const h16x8 vf = *(const LAS h16x8*)(Vl + vrow * 128 + (cb ^ (((vrow >> 1) & 7) << 4))); \
                o[d0] = MFMA32(pa[ks], vf, o[d0]); } } \
        if ((j) + 1 < NT) AT_LWRITE(S, (buf ^ 1) * 16384); \
        if ((j) + 3 < NT) AT_GLOAD(S, (j) + 3); \
        __syncthreads(); \
    } while (0)
#define PK4(P, BASE, OUT) do { const unsigned a0 = cvtpk_h(P[BASE + 0], P[BASE + 1]), a1 = cvtpk_h(P[BASE + 2], P[BASE + 3]), b0_ = cvtpk_h(P[BASE + 4], P[BASE + 5]), b1_ = cvtpk_h(P[BASE + 6], P[BASE + 7]); \
        unsigned r00, r01, r10, r11; permlane32_swap_u(a0, b0_, r00, r01); permlane32_swap_u(a1, b1_, r10, r11); u32x4 w_ = {r00, r10, r01, r11}; OUT = __builtin_bit_cast(h16x8, w_); } while (0)
    for (int j = 0; j < NT; j += 2) { AT_TILE(j, A); AT_TILE(j + 1, B); }
#undef PK4
#undef AT_TILE
#undef AT_GLOAD
#undef AT_LWRITE
    PSPIN_T1(1, PS_WS)
    if (hi == 0) li_l[r32] = l_reg;
    WAVE_LDS_SYNC();
    LAS h16* OT = (LAS h16*)(lds + wid * (32 * AT_OS * 2));
#pragma unroll
    for (int r = 0; r < 16; ++r) { const float rl = RCPF(li_l[crow(r, hi)]);
#pragma unroll
        for (int d0 = 0; d0 < 4; ++d0) OT[crow(r, hi) * AT_OS + d0 * 32 + r32] = (h16)(o[d0][r] * rl); }
    WAVE_LDS_SYNC();
#pragma unroll
    for (int k = 0; k < 8; ++k) { const int ch = lane + 64 * k, row = ch >> 4, c = ch & 15; const int orow = wid * 32 + row;
        const h16x8 v = *(const LAS h16x8*)(OT + row * AT_OS + c * 8), g = *(const h16x8*)(Gb + (size_t)orow * INC + c * 8);
        h16x8 ov;
#pragma unroll
        for (int j = 0; j < 8; ++j) ov[j] = (h16)((float)v[j] * (float)g[j]);
        *(h16x8*)(Ob + (size_t)orow * W + c * 8) = ov; }
    __syncthreads();
}
constexpr int HGP_N = 8;
__device__ __forceinline__ void d_hgpost4(const Params& p, int l, int item0, int stride, int nitems, int lane) {
    const h16* OF = (const h16*)(p.ws + WS_OF); const h16* OB = (const h16*)(p.ws + WS_OB);
    const float* wn = p.in[I_ONORM] + (size_t)l * 128; const float w0 = wn[lane], w1 = wn[lane + 64];
    float a0[HGP_N], a1[HGP_N]; h16 g0[HGP_N], g1[HGP_N];
#pragma unroll
    for (int k = 0; k < HGP_N; ++k) { const int item = item0 + k * stride; if (item < nitems) { const int row = item / HGH, h = item % HGH; const size_t o0 = (size_t)row * W + h * 128;
        a0[k] = (float)OF[o0 + lane] + (float)OB[o0 + lane]; a1[k] = (float)OF[o0 + lane + 64] + (float)OB[o0 + lane + 64];
        const h16* gz = (const h16*)(p.ws + WS_Z) + (size_t)row * INC + C_HGG + h * 128; g0[k] = gz[lane]; g1[k] = gz[lane + 64]; } else { a0[k] = 0.f; a1[k] = 0.f; g0[k] = (h16)0.f; g1[k] = (h16)0.f; } }
#pragma unroll
    for (int k = 0; k < HGP_N; ++k) { const int item = item0 + k * stride; const float ss = wave_sum(a0[k] * a0[k] + a1[k] * a1[k], lane);
        if (item < nitems) { const int row = item / HGH, h = item % HGH; const float rstd = rsqrtf(ss * (1.0f / 128.0f) + EPS);
            h16* dst = (h16*)(p.ws + WS_OHG) + (size_t)row * W + h * 128; dst[lane] = (h16)(a0[k] * rstd * w0 * (float)g0[k]); dst[lane + 64] = (h16)(a1[k] * rstd * w1 * (float)g1[k]); } }
}
template <int PARTS> __device__ __forceinline__ void phase_attn(const Params& p, int l, LAS unsigned char* lds) {
    int tid_ = threadIdx.x; LAUNDER(tid_);
    const int lane = tid_ & 63, gw = blockIdx.x * NWAVES + (tid_ >> 6), nw = gridDim.x * NWAVES;
    constexpr int NU_S = DBATCH * AQH * (DSEQ / 256), NU_C = BATCH * AQH * (SEQ / 256);
    if (PARTS & 1)
    for (int u = blockIdx.x; u < NU_S + NU_C; u += gridDim.x) {
        const bool smp = u < NU_S; const int uu = smp ? u : u - NU_S;
        const int T = smp ? DSEQ : SEQ, NK = smp ? KVLEN : SEQ;
        const int qb = uu % (T / 256), qh = (uu / (T / 256)) % AQH, b = uu / ((T / 256) * AQH), kh = qh / 4;
        const int row0 = (smp ? MP + b * DSEQ : b * SEQ) + qb * 256;
        const h16* Kb = (smp ? (const h16*)(p.ws + WS_KBS) : (const h16*)(p.ws + WS_KBC)) + (size_t)b * NK * KVW + kh * 128;
        const h16* VTb = (smp ? (const h16*)(p.ws + WS_VBS) : (const h16*)(p.ws + WS_VBC)) + (size_t)(b * AKVH + kh) * 128 * NK;
        attn_unit((const h16*)(p.ws + WS_AQ2) + (size_t)row0 * W + qh * 128, Kb, VTb, NK, (const h16*)(p.ws + WS_Z) + (size_t)row0 * INC + C_AG + qh * 128,
                  (h16*)(p.ws + WS_OAT) + (size_t)row0 * W + qh * 128, lds, p.ws);
    }
    constexpr int N_HP = M * HGH;
    if (PARTS & 2)
    for (int it = gw; it < N_HP; it += HGP_N * nw) d_hgpost4(p, l, it, nw, N_HP, lane);
    if (!(PARTS & 4)) return;
    const h16* YF = (const h16*)(p.ws + WS_YF); const h16* YB = (const h16*)(p.ws + WS_YB); const h16* Z = (const h16*)(p.ws + WS_Z);
    const float* dd = p.in[I_S5D] + (size_t)l * W; h16* YS = (h16*)(p.ws + WS_YS);
    const size_t nth = (size_t)gridDim.x * NTHREADS;
    constexpr int SPN = 8;
    for (size_t i0 = ((size_t)blockIdx.x * NTHREADS + tid_) * 4; i0 < (size_t)M * W; i0 += nth * 4 * SPN) {
        h16x4 a[SPN], b[SPN]; h16x4 u[SPN]; f32x4 dv[SPN];
#pragma unroll
        for (int k = 0; k < SPN; ++k) { const size_t i = i0 + k * nth * 4; if (i < (size_t)M * W) { const size_t row = i / W; const int c = (int)(i % W);
            a[k] = *(const h16x4*)(YF + i); b[k] = *(const h16x4*)(YB + i); dv[k] = *(const f32x4*)(dd + c); u[k] = *(const h16x4*)(Z + row * INC + C_SU + c); } }
#pragma unroll
        for (int k = 0; k < SPN; ++k) { const size_t i = i0 + k * nth * 4; if (i < (size_t)M * W) { h16x4 o;
#pragma unroll
            for (int j = 0; j < 4; ++j) o[j] = (h16)geluf((float)a[k][j] + (float)b[k][j] + dv[k][j] * (float)u[k][j]);
            *(h16x4*)(YS + i) = o; } }
    }
}

constexpr int NPL = 7, PH_FINAL = 1 + DEPTH * NPL, N_PHASES = PH_FINAL + 1;

__global__ void __launch_bounds__(NTHREADS, 2) fwd_kernel(Params p) {
#ifdef HOST_SIM
    unsigned char* lds = sim::cur->blk->lds;
#else
    extern __shared__ __attribute__((aligned(16))) unsigned char lds_raw[];
    LAS unsigned char* lds = (LAS unsigned char*)lds_raw;
#endif
    const int lo = p.ph_lo, hi = p.ph_hi;
#ifndef HOST_SIM
    if (threadIdx.x < 4) ((LAS unsigned*)(lds + MISC_OFF))[threadIdx.x] = 0u;
    __syncthreads();
    XcdBarrier bar; bar.bar = (unsigned*)(p.ws + WS_BAR); bar.x = 0; bar.st = nullptr;
    if (hi - lo > 1) bar = xcd_barrier_post((unsigned*)(p.ws + WS_BAR), (volatile LAS unsigned*)(lds + MISC_OFF));
#else
    XcdBarrier bar{0};
#endif
#define IN(k) (lo <= (k) && (k) < hi)
#define SEAM(k) do { if (IN(k) && IN((k) + 1)) xcd_barrier(bar); } while (0)

    unsigned char* ws = p.ws;
    const int G = gridDim.x, bid = blockIdx.x;
    if (IN(0)) { phase_prologue(p, lds); if (PROBE_REP == 0) { xcd_barrier(bar); phase_prologue(p, lds); } } SEAM(0);
    for (int l = 0; l < DEPTH; ++l) {
        const int pb = 1 + l * NPL;
        if (IN(pb + 0)) { phase_norm(p, l); } SEAM(pb + 0);
        if (IN(pb + 1)) {
            pg8::Gemm g{(const h16*)(ws + WS_H), (const h16*)(ws + WS_WIN) + (size_t)l * INC * D, 0, 0, M, INC, D};
            pg8::StaticOrder S; S.init(M, INC, G, bid);
            EpiIn E{(h16*)(ws + WS_Z), (float*)(ws + WS_LOGF), (const float*)(ws + WS_LB) + (size_t)l * W};
            pg8::gemm_phase<EpiIn, pg8::StaticOrder>(lds, g, S, E);
            if (PROBE_REP == 1) { xcd_barrier(bar); pg8::gemm_phase<EpiIn, pg8::StaticOrder>(lds, g, S, E); }
        } SEAM(pb + 1);
        if (IN(pb + 2)) { phase_scans<7>(p, l, lds); if (PROBE_REP == 2) { xcd_barrier(bar); phase_scans<7>(p, l, lds); } if (PROBE_REP == 21) { xcd_barrier(bar); phase_scans<1>(p, l, lds); } if (PROBE_REP == 22) { xcd_barrier(bar); phase_scans<2>(p, l, lds); } if (PROBE_REP == 23) { xcd_barrier(bar); phase_scans<4>(p, l, lds); } } SEAM(pb + 2);
        if (IN(pb + 3)) { phase_attn<7>(p, l, lds); if (PROBE_REP == 3) { xcd_barrier(bar); phase_attn<7>(p, l, lds); } if (PROBE_REP == 31) { xcd_barrier(bar); phase_attn<1>(p, l, lds); } if (PROBE_REP == 32) { xcd_barrier(bar); phase_attn<2>(p, l, lds); } if (PROBE_REP == 33) { xcd_barrier(bar); phase_attn<4>(p, l, lds); } } SEAM(pb + 3);
        if (IN(pb + 4)) {
            pg8::Gemm g{(const h16*)(ws + WS_YS), (const h16*)(ws + WS_WGLU) + (size_t)l * W * W, 0, 0, M, W, W};
            pg8::StaticOrder S; S.init(M, W, G, bid);
            EpiGlu E{(const h16*)(ws + WS_YS), (const h16*)(ws + WS_Z), (h16*)(ws + WS_OS5)};
            pg8::gemm_phase<EpiGlu, pg8::StaticOrder>(lds, g, S, E);
        } SEAM(pb + 4);
        if (IN(pb + 5)) {
            const h16* wbr = (const h16*)(ws + WS_WBR) + (size_t)l * 3 * D * W;
            pg8::Gemm g{(const h16*)(ws + WS_OHG), wbr, (size_t)M * W, (size_t)D * W, M, D, W};
            pg8::MultiOrder<3> S; S.init(M, D, G, bid);
            EpiBr E{(const h16*)(ws + WS_Z), (h16*)(ws + WS_MG)};
            pg8::gemm_phase<EpiBr, pg8::MultiOrder<3>>(lds, g, S, E);
            if (PROBE_REP == 5) { xcd_barrier(bar); pg8::gemm_phase<EpiBr, pg8::MultiOrder<3>>(lds, g, S, E); }
        } SEAM(pb + 5);
        if (IN(pb + 6)) {
            pg8::Gemm g{(const h16*)(ws + WS_MG), (const h16*)(ws + WS_WOUT) + (size_t)l * D * D, 0, 0, M, D, D};
            pg8::StaticOrder S; S.init(M, D, G, bid);
            const float* X = (const float*)(ws + WS_X);
            EpiOut E{l == 0 ? p.in[I_XP] : X, l == 0 ? p.in[I_XS] : X + (size_t)MP * D, (float*)(ws + WS_X), (const float*)(ws + WS_MOD) + (size_t)l * NMODR * 3 * D};
            pg8::gemm_phase<EpiOut, pg8::StaticOrder>(lds, g, S, E);
        } SEAM(pb + 6);
    }
    if (IN(PH_FINAL)) { phase_final(p); }
#if !defined(HOST_SIM) && PROBE_SPIN
    if (blockIdx.x == 0 && threadIdx.x == 0) { const unsigned T = __hip_atomic_load((unsigned*)p.ws + 64, __ATOMIC_RELAXED, __HIP_MEMORY_SCOPE_AGENT); const unsigned long long t0 = __builtin_amdgcn_s_memrealtime(); while (__builtin_amdgcn_s_memrealtime() - t0 < (unsigned long long)T) __builtin_amdgcn_s_sleep(8); }
#endif
#undef IN
#undef SEAM
}

#ifndef HOST_SIM
extern "C" void kernel_launch(void* const* d_in, const int* in_sizes, int n_in, void* d_out, int out_size, void* d_ws, size_t ws_size, hipStream_t stream) {
    static int grid = 0;
    if (grid == 0) {
        if (n_in != N_IN || (size_t)out_size != O_END || ws_size < WS_END) { grid = -1; return; }
        int dev = 0, cus = 0;
        if (hipGetDevice(&dev) != hipSuccess || hipDeviceGetAttribute(&cus, hipDeviceAttributeMultiprocessorCount, dev) != hipSuccess) { grid = -1; return; }
        if (hipFuncSetAttribute((const void*)fwd_kernel, hipFuncAttributeMaxDynamicSharedMemorySize, LDS_BYTES) != hipSuccess) { grid = -1; return; }
        int per_cu = 0; (void)hipOccupancyMaxActiveBlocksPerMultiprocessor(&per_cu, (const void*)fwd_kernel, NTHREADS, LDS_BYTES); (void)hipGetLastError();
        grid = cus;
    }
    if (grid < 0) return;
    (void)hipMemsetAsync((char*)d_ws + WS_BAR, 0, 16384, stream);
    Params p{};
    for (int i = 0; i < N_IN; ++i) p.in[i] = (const float*)d_in[i];
    p.out = (float*)d_out; p.ws = (unsigned char*)d_ws;
#if N_LAUNCH_MODE == 1
    p.ph_lo = 0; p.ph_hi = N_PHASES;
    hipLaunchKernelGGL(fwd_kernel, dim3(grid), dim3(NTHREADS), LDS_BYTES, stream, p);
#else
    for (int k = 0; k < N_PHASES; ++k) { p.ph_lo = k; p.ph_hi = k + 1; hipLaunchKernelGGL(fwd_kernel, dim3(grid), dim3(NTHREADS), LDS_BYTES, stream, p); }
#endif
}
#endif
```

```cpp
#ifndef HOST_SIM
#include <hip/hip_runtime.h>
#endif

#ifndef CFG_D
#define CFG_D 2048
#define CFG_BATCH 32
#define CFG_SEQ 256
#define CFG_DEPTH 4
#define CFG_DBATCH 8
#define CFG_DSEQ 1024
#define CFG_PAST 256
#endif
#ifndef PROBE_REP
#define PROBE_REP -1
#endif
#ifndef PROBE_SPIN
#define PROBE_SPIN 0
#endif
#ifndef PROBE_BLK
#define PROBE_BLK 0
#endif
#ifndef N_LAUNCH_MODE
#define N_LAUNCH_MODE 1
#endif

constexpr int D = CFG_D, BATCH = CFG_BATCH, SEQ = CFG_SEQ, DEPTH = CFG_DEPTH, DBATCH = CFG_DBATCH, DSEQ = CFG_DSEQ, PAST = CFG_PAST;
constexpr int W = D / 2;
constexpr int HGH = W / 128;
constexpr int AQH = W / 128, AKVH = AQH / 4, KVW = AKVH * 128;
constexpr int S5G = W / 16, S5P = 64;
constexpr int C_HQ = 0, C_HI = W, C_FF = 2 * W, C_FB = 3 * W, C_HGG = 4 * W, C_AQ = 5 * W, C_AK = 6 * W, C_AV = 6 * W + KVW, C_AG = 6 * W + 2 * KVW,
              C_SU = 7 * W + 2 * KVW, C_SG = 8 * W + 2 * KVW, C_MG = 9 * W + 2 * KVW, INC = C_MG + 3 * D;
constexpr int MP = BATCH * SEQ, MS = DBATCH * DSEQ, M = MP + MS;
constexpr int KVLEN = PAST + DSEQ;
constexpr int NMODR = 1 + DBATCH;
constexpr float EPS = 1e-6f;
constexpr int ZLD = INC;
static_assert(INC % 256 == 0 && MP % 256 == 0 && MS % 256 == 0 && W % 256 == 0, "tile shapes");

typedef _Float16 h16;
typedef h16 h16x8 __attribute__((ext_vector_type(8)));
typedef h16 h16x4 __attribute__((ext_vector_type(4)));
typedef h16 h16x2 __attribute__((ext_vector_type(2)));
typedef float f32x4 __attribute__((ext_vector_type(4)));
typedef __bf16 bf16;
typedef bf16 bf16x8 __attribute__((ext_vector_type(8)));
typedef bf16 bf16x4 __attribute__((ext_vector_type(4)));
typedef float f32x2 __attribute__((ext_vector_type(2)));
typedef float f32x16 __attribute__((ext_vector_type(16)));
typedef unsigned u32x4 __attribute__((ext_vector_type(4)));

constexpr size_t al256(size_t x) { return (x + 255) & ~(size_t)255; }
constexpr size_t WS_BAR = 0;
constexpr size_t WS_MOD = 16384;
constexpr size_t WS_LB = al256(WS_MOD + (size_t)DEPTH * NMODR * 3 * D * 4);
constexpr size_t WS_ABAR = al256(WS_LB + (size_t)2 * DEPTH * W * 4);
constexpr size_t WS_BBAR = al256(WS_ABAR + (size_t)DEPTH * 2 * S5G * S5P * 8);
constexpr size_t WS_S5T = al256(WS_BBAR + (size_t)DEPTH * 2 * S5G * S5P * 32 * 4);
constexpr size_t WS_S5C = al256(WS_S5T + (size_t)DEPTH * 2 * S5G * 256 * 48);
constexpr int NBLK = M / 16, NBLK_P = (NBLK + 255) / 256 * 256;
constexpr size_t WS_S5BY = al256(WS_S5C + (size_t)DEPTH * S5G * 256 * 16);
constexpr size_t WS_S5BG = al256(WS_S5BY + (size_t)DEPTH * S5G * 256 * 512 * 2);
constexpr size_t WS_A3 = al256(WS_S5BG + (size_t)DEPTH * S5G * 256 * 256 * 2);
constexpr size_t WS_PB = al256(WS_A3 + (size_t)S5G * NBLK_P * 512 * 2);
constexpr size_t WS_ROPE = al256(WS_PB + (size_t)S5G * NBLK_P * 256 * 4);
constexpr size_t WS_WIN = al256(WS_ROPE + (size_t)(DSEQ / 64 + 64) * 32 * 8);
constexpr size_t WS_WGLU = al256(WS_WIN + (size_t)DEPTH * INC * D * 2);
constexpr size_t WS_WBR = al256(WS_WGLU + (size_t)DEPTH * W * W * 2);
constexpr size_t WS_WOUT = al256(WS_WBR + (size_t)DEPTH * 3 * D * W * 2);
constexpr size_t WS_X = al256(WS_WOUT + (size_t)DEPTH * D * D * 2);
constexpr size_t WS_H = al256(WS_X + (size_t)M * D * 4);
constexpr size_t WS_Z = al256(WS_H + (size_t)M * D * 2);
constexpr size_t WS_LOGF = al256(WS_Z + (size_t)M * INC * 2);
constexpr size_t WS_AQ2 = al256(WS_LOGF + (size_t)M * 2 * W * 4);
constexpr size_t WS_KBC = al256(WS_AQ2 + (size_t)M * W * 2);
constexpr size_t WS_VBC = al256(WS_KBC + (size_t)MP * KVW * 2);
constexpr size_t WS_KBS = al256(WS_VBC + (size_t)MP * KVW * 2);
constexpr size_t WS_VBS = al256(WS_KBS + (size_t)DBATCH * KVLEN * KVW * 2);
constexpr size_t WS_OF = al256(WS_VBS + (size_t)DBATCH * KVLEN * KVW * 2);
constexpr size_t WS_OB = al256(WS_OF + (size_t)M * W * 4);
constexpr size_t WS_YF = al256(WS_OB + (size_t)M * W * 4);
constexpr size_t WS_YB = al256(WS_YF + (size_t)M * W * 4);
constexpr size_t WS_OHG = al256(WS_YB + (size_t)M * W * 4);
constexpr size_t WS_OAT = al256(WS_OHG + (size_t)M * W * 2);
constexpr size_t WS_OS5 = al256(WS_OAT + (size_t)M * W * 2);
constexpr size_t WS_YS = al256(WS_OS5 + (size_t)M * W * 2);
constexpr size_t WS_MG = al256(WS_YS + (size_t)M * W * 2);
static_assert(WS_OAT - WS_OHG == (size_t)M * W * 2 && WS_OS5 - WS_OAT == (size_t)M * W * 2, "branch operands must be equally spaced");
constexpr size_t WS_END = al256(WS_MG + (size_t)M * D * 2);

constexpr size_t O_Y = 0;
constexpr size_t O_CK = (size_t)M * D;
constexpr size_t O_CV = O_CK + (size_t)BATCH * DEPTH * SEQ * KVW;
constexpr size_t O_SH = O_CV + (size_t)BATCH * DEPTH * SEQ * KVW;
constexpr size_t O_SR = O_SH + (size_t)BATCH * DEPTH * 2 * HGH * 128 * 128;
constexpr size_t O_SI = O_SR + (size_t)BATCH * DEPTH * 2 * S5G * S5P;
constexpr size_t O_END = O_SI + (size_t)BATCH * DEPTH * 2 * S5G * S5P;

enum { I_XP = 0, I_XS, I_CK, I_CV, I_SH, I_SR, I_SI, I_C, I_CCTX, I_NORMW, I_WMOD, I_BMOD, I_WIN, I_LBL, I_ONORM, I_QNORM, I_KNORM,
       I_ARE, I_AIM, I_LDT, I_BRE, I_BIM, I_CRE, I_CIM, I_S5D, I_WGLU, I_WBRHG, I_WBRAT, I_WBRS5, I_WOUT, I_FNORM, N_IN };

struct Params { const float* in[N_IN]; float* out; unsigned char* ws; int ph_lo, ph_hi; };

constexpr int NTHREADS = 512, NWAVES = 8;
constexpr int STAGE_BYTES = 131072, LDS_BYTES = 147456, MISC_OFF = LDS_BYTES - 64;

#ifdef HOST_SIM
#define LAS
static inline void sim_glds16(const void* g, void* l) { memcpy((char*)l + sim::cur->lane * 16, g, 16); }
#define GLDS16(g, l) sim_glds16((const void*)(g), (void*)(l))
#define WAIT_V(n) ((void)0)
#define WAIT_L(n) ((void)0)
#define SBAR sim::block_sync()
#define SCHED ((void)0)
#define SETPRIO(x) ((void)0)
#define CFENCE ((void)0)
#define LAUNDER(x) ((void)0)
#define NT_STORE(v, p) (*(p) = (v))
#define PIN4(a, b, c, d) ((void)0)
#define MFMA16(a, b, c) sim::mfma16<1>(&(a), &(b), c)
#define MFMA16K16(a, b, c) sim::mfma16k16_f16(&(a), &(b), c)
static inline float readlane_f(float v, int l) { return sim::shfl<float>(v, l); }
#else
#define LAS __attribute__((address_space(3)))
#define GLDS16(g, l) __builtin_amdgcn_global_load_lds((const unsigned*)(g), (LAS unsigned*)(l), 16, 0, 0)
#define WAIT_V(n) asm volatile("s_waitcnt vmcnt(" #n ")" ::: "memory")
#define WAIT_L(n) asm volatile("s_waitcnt lgkmcnt(" #n ")" ::: "memory")
#define SBAR __builtin_amdgcn_s_barrier()
#define SCHED __builtin_amdgcn_sched_barrier(0)
#define SETPRIO(x) __builtin_amdgcn_s_setprio(x)
#define CFENCE asm volatile("" ::: "memory")
#define LAUNDER(x) asm volatile("" : "+v"(x))
#define NT_STORE(v, p) __builtin_nontemporal_store(v, p)
#define PIN4(a, b, c, d) asm volatile("" : "+v"(a), "+v"(b), "+v"(c), "+v"(d) :: "memory")
#define MFMA16(a, b, c) __builtin_amdgcn_mfma_f32_16x16x32_f16(a, b, c, 0, 0, 0)
#define MFMA16K16(a, b, c) __builtin_amdgcn_mfma_f32_16x16x16f16(a, b, c, 0, 0, 0)
__device__ __forceinline__ float readlane_f(float v, int l) { return __builtin_bit_cast(float, __builtin_amdgcn_readlane(__builtin_bit_cast(int, v), l)); }
#endif

#ifdef HOST_SIM
#define MFMA32(a, b, c) sim::mfma32<1>(&(a), &(b), c)
#define WAVE_LDS_SYNC() sim::wave_sync()
#define WAVE_ALL(p) sim_wave_all(p)
#define EXP2F(x) exp2f(x)
#define RCPF(x) (1.0f / (x))
#define LOG2F(x) log2f(x)
static inline void permlane32_swap_u(unsigned a, unsigned b, unsigned& ra, unsigned& rb) { sim_permlane32_swap(a, b, ra, rb); }
#else
#define MFMA32(a, b, c) __builtin_amdgcn_mfma_f32_32x32x16_f16(a, b, c, 0, 0, 0)
#define WAVE_LDS_SYNC() asm volatile("s_waitcnt lgkmcnt(0)" ::: "memory")
#define WAVE_ALL(p) (__all(p) != 0)
#define EXP2F(x) __builtin_amdgcn_exp2f(x)
#define RCPF(x) __builtin_amdgcn_rcpf(x)
#define LOG2F(x) __builtin_amdgcn_logf(x)
__device__ __forceinline__ void permlane32_swap_u(unsigned a, unsigned b, unsigned& ra, unsigned& rb) { auto r = __builtin_amdgcn_permlane32_swap(a, b, false, false); ra = r[0]; rb = r[1]; }
#endif
#if !defined(HOST_SIM) && PROBE_SPIN
#define PSPIN_T0(id) unsigned long long _pt0 = 0; if (PROBE_SPIN == (id) && blockIdx.x == PROBE_BLK && threadIdx.x == 0) _pt0 = __builtin_amdgcn_s_memrealtime();
#define PSPIN_T1(id, wsp) if (PROBE_SPIN == (id) && blockIdx.x == PROBE_BLK && threadIdx.x == 0) { const unsigned long long _d = __builtin_amdgcn_s_memrealtime() - _pt0; atomicAdd((unsigned*)(wsp) + 64, (unsigned)_d); }
#define PSPINL_T0(id, ldsp) if (PROBE_SPIN == (id) && blockIdx.x == PROBE_BLK && threadIdx.x == 0) { const unsigned long long _t = __builtin_amdgcn_s_memrealtime(); ((LAS unsigned*)((ldsp) + MISC_OFF + 16))[0] = (unsigned)_t; ((LAS unsigned*)((ldsp) + MISC_OFF + 16))[1] = (unsigned)(_t >> 32); }
#define PSPINL_T1(id, ldsp, wsp) if (PROBE_SPIN == (id) && blockIdx.x == PROBE_BLK && threadIdx.x == 0) { const unsigned long long _t0 = ((unsigned long long)((LAS unsigned*)((ldsp) + MISC_OFF + 16))[1] << 32) | ((LAS unsigned*)((ldsp) + MISC_OFF + 16))[0]; atomicAdd((unsigned*)(wsp) + 64, (unsigned)(__builtin_amdgcn_s_memrealtime() - _t0)); }
#else
#define PSPIN_T0(id)
#define PSPIN_T1(id, wsp)
#define PSPINL_T0(id, ldsp)
#define PSPINL_T1(id, ldsp, wsp)
#endif
__device__ __forceinline__ unsigned cvtpk_h(float lo, float hi) { h16x2 v; v[0] = (h16)lo; v[1] = (h16)hi; return __builtin_bit_cast(unsigned, v); }
__device__ __forceinline__ float sigm(float x) { return RCPF(1.0f + __expf(-x)); }
__device__ __forceinline__ float siluf(float x) { return x * sigm(x); }
__device__ __forceinline__ float geluf(float x) { const float u2 = x * (1.5957691216057308f + 0.07135481627f * x * x); return x * RCPF(1.0f + __expf(-u2)); }
#ifdef HOST_SIM
static inline float shfl_xor_l(float v, int m, int lane) { (void)lane; return __shfl_xor(v, m); }
static inline float shfl_l(float v, int src) { return __shfl(v, src); }
static inline float shfl_up_l(float v, int d, int lane) { (void)lane; return __shfl_up(v, d); }
#else
__device__ __forceinline__ float shfl_xor_l(float v, int m, int lane) { return __builtin_bit_cast(float, __builtin_amdgcn_ds_bpermute((lane ^ m) << 2, __builtin_bit_cast(int, v))); }
__device__ __forceinline__ float shfl_l(float v, int src) { return __builtin_bit_cast(float, __builtin_amdgcn_ds_bpermute(src << 2, __builtin_bit_cast(int, v))); }
__device__ __forceinline__ float shfl_up_l(float v, int d, int lane) { const float r = __builtin_bit_cast(float, __builtin_amdgcn_ds_bpermute((lane - d) << 2, __builtin_bit_cast(int, v))); return lane >= d ? r : v; }
#endif
__device__ __forceinline__ float wave_sum(float v, int lane) { v += shfl_xor_l(v, 32, lane); v += shfl_xor_l(v, 16, lane); v += shfl_xor_l(v, 8, lane); v += shfl_xor_l(v, 4, lane); v += shfl_xor_l(v, 2, lane); v += shfl_xor_l(v, 1, lane); return v; }

#ifndef HOST_SIM
#define XB_TMO      128
#define XB_XCNT(j)  (256  + 64 * (j))
#define XB_XSUB(j)  (1280 + 64 * (j))
#define XB_XGEN(j)  (2304 + 64 * (j))
#define XB_TOP      3328
#define XB_TOPGEN   3392
#define XCD_BAR_WORDS 3456
#define XB_SPIN_CAP (1u << 24)
__device__ __forceinline__ unsigned xb_ld(unsigned* p)              { return __hip_atomic_load(p, __ATOMIC_RELAXED, __HIP_MEMORY_SCOPE_AGENT); }
__device__ __forceinline__ unsigned xb_add(unsigned* p, unsigned v) { return __hip_atomic_fetch_add(p, v, __ATOMIC_RELAXED, __HIP_MEMORY_SCOPE_AGENT); }
__device__ __forceinline__ unsigned xb_xcc_id() { return (unsigned)__builtin_amdgcn_s_getreg((3 << 11) | 20) & 0xFu; }
#define XB_SPIN(cond, bar) do { unsigned _sp = 0; while (cond) { __builtin_amdgcn_s_sleep(1); \
    if ((++_sp & 255u) == 0u) { if (xb_ld(&(bar)[XB_TMO])) break; if (_sp > XB_SPIN_CAP) { atomicAdd(&(bar)[XB_TMO], 1u); break; } } } } while (0)
struct XcdBarrier { unsigned* bar; unsigned x; volatile LAS unsigned* st; };
__device__ __forceinline__ XcdBarrier xcd_barrier_post(unsigned* bar, volatile LAS unsigned* st) {
    XcdBarrier b; b.bar = bar; b.x = xb_xcc_id(); b.st = st;
    if (threadIdx.x == 0) (void)xb_add(&bar[XB_XCNT(b.x)], 1u);
    return b;
}
__device__ __forceinline__ void xcd_barrier_complete(unsigned* bar, unsigned x, unsigned& nloc, unsigned& nx) {
    const unsigned G = gridDim.x * gridDim.y * gridDim.z;
    unsigned sum, cnt, mine, sp = 0u;
    for (;;) {
        sum = 0u; cnt = 0u; mine = 0u;
#pragma unroll
        for (unsigned j = 0; j < 16; ++j) { const unsigned c = xb_ld(&bar[XB_XCNT(j)]); sum += c; cnt += (c > 0u) ? 1u : 0u; mine = (j == x) ? c : mine; }
        if (sum == G) break;
        __builtin_amdgcn_s_sleep(1);
        if ((++sp & 255u) == 0u) { if (xb_ld(&bar[XB_TMO])) break; if (sp > XB_SPIN_CAP) { atomicAdd(&bar[XB_TMO], 1u); break; } }
    }
    nloc = mine > 0u ? mine : 1u; nx = cnt > 0u ? cnt : 1u;
}
__device__ __forceinline__ void xcd_barrier(const XcdBarrier& b) {
    asm volatile("s_waitcnt vmcnt(0)" ::: "memory");
    __syncthreads();
    if (threadIdx.x == 0) {
        unsigned* bar = b.bar;
        __builtin_amdgcn_s_waitcnt(0);
        unsigned nloc = b.st[0], nx = b.st[1];
        if (nloc == 0u) { xcd_barrier_complete(bar, b.x, nloc, nx); b.st[0] = nloc; b.st[1] = nx; }
        const unsigned old = xb_add(&bar[XB_XSUB(b.x)], 1u);
        const unsigned gen = old / nloc;
        if (old + 1u == (gen + 1u) * nloc) {
            __builtin_amdgcn_fence(__ATOMIC_RELEASE, "agent");
            asm volatile("s_waitcnt vmcnt(0)" ::: "memory");
            const unsigned og = xb_add(&bar[XB_TOP], 1u);
            const unsigned tg = og / nx;
            if (og + 1u == (tg + 1u) * nx) xb_add(&bar[XB_TOPGEN], 1u);
            else XB_SPIN(xb_ld(&bar[XB_TOPGEN]) == tg, bar);
            __builtin_amdgcn_fence(__ATOMIC_ACQUIRE, "agent");
            xb_add(&bar[XB_XGEN(b.x)], 1u);
            asm volatile("s_waitcnt vmcnt(0)" ::: "memory");
        } else {
            XB_SPIN(xb_ld(&bar[XB_XGEN(b.x)]) == gen, bar);
            __builtin_amdgcn_fence(__ATOMIC_ACQUIRE, "agent");
            asm volatile("s_waitcnt vmcnt(0)" ::: "memory");
        }
    }
    __syncthreads();
}
#else
#define XCD_BAR_WORDS 3456
struct XcdBarrier { int dummy; };
static inline void xcd_barrier(const XcdBarrier&) { sim::grid_sync(); }
#endif

#ifdef HOST_SIM
#define PF_LOAD(g, l) ((void)(g))
#define LANE_ID(x) ((x) = sim::cur->lane)
#else
#define LANE_ID(x) asm volatile("v_mbcnt_lo_u32_b32 %0, -1, 0\n\tv_mbcnt_hi_u32_b32 %0, -1, %0" : "=v"(x))
#define PF_LOAD(g, l) __builtin_amdgcn_global_load_lds((const unsigned*)(g), (LAS unsigned*)(l), 4, 0, 0)
#endif
namespace pg8 {
constexpr int BM = 256, BK = 64, HALF = 128, HTB = HALF * BK * 2, NXCD = 8, WGM = 8;
__host__ __device__ __forceinline__ int lds_byte(int r, int c) { const int st = (r >> 4) * 2 + (c >> 5), rr = r & 15, cc = c & 31, ob = rr * 64 + cc * 2; return st * 1024 + (ob ^ (((ob >> 9) & 1) << 5)); }
__host__ __device__ __forceinline__ void stage_rc(int b, int& R, int& C) { const int st = b / 1024, sb = b % 1024, swz = sb ^ (((sb >> 9) & 1) << 5); R = (st >> 1) * 16 + swz / 64; C = (st & 1) * 32 + (swz % 64) / 2; }
__host__ __device__ __forceinline__ int perm32(int rho) { const int n = rho >> 4, i = rho & 15; return 8 * (i >> 2) + 4 * n + (i & 3); }
struct Unit { int pm, pn, sel; };
struct Gemm { const h16* A; const h16* Bt; size_t sa, sb; int M, N, K, lda, ldb;
    __device__ __forceinline__ const char* a(int s) const { return (const char*)(A + (size_t)s * sa); }
    __device__ __forceinline__ const char* b(int s) const { return (const char*)(Bt + (size_t)s * sb); } };
struct StaticOrder {
    int nM, nN, nwg, G, c;
    __host__ __device__ void init(int M_, int N_, int G_, int c_) { nM = M_ / BM; nN = N_ / BM; nwg = nM * nN; G = G_; c = c_; }
    __host__ __device__ bool next(int i, Unit& u) const {
        const long L = (long)i * G + c; if (L >= nwg) return false;
        int wgid = (int)L; { const int q = nwg / NXCD, r = nwg % NXCD, xcd = wgid % NXCD, off = wgid / NXCD; wgid = (xcd < r ? xcd * (q + 1) : r * (q + 1) + (xcd - r) * q) + off; }
        const int nig = WGM * nN, gid = wgid / nig, fm = gid * WGM, gsz = (nM - fm) < WGM ? (nM - fm) : WGM;
        u.pm = fm + ((wgid % nig) % gsz); u.pn = (wgid % nig) / gsz; u.sel = 0; return true;
    }
};
struct WholeRounds { StaticOrder S; int rounds;
    __host__ __device__ void init(int M_, int N_, int G_, int c_) { S.init(M_, N_, G_, c_); rounds = S.nwg / G_; if (rounds == 0) rounds = 1; }
    __host__ __device__ bool next(int i, Unit& u) const { return i < rounds && S.next(i, u); } };
struct LeftoverUnit { StaticOrder S; int round; bool mine;
    __host__ __device__ void init(int M_, int N_, int G_, int bid) { const int nwg = (M_ / BM) * (N_ / BM), R = nwg / G_ > 0 ? nwg / G_ : 1, left = nwg - R * G_; mine = left > 0 && bid >= G_ - left; S.init(M_, N_, G_, mine ? bid - (G_ - left) : 0); round = R; }
    __host__ __device__ bool next(int i, Unit& u) const { return mine && i == 0 && S.next(round, u); } };
template <int NSEL> struct MultiOrder {
    StaticOrder S;
    __host__ __device__ void init(int M_, int N_, int G_, int c_) { S.init(M_, N_, G_, c_); }
    __host__ __device__ bool next(int i, Unit& u) const { const bool ok = S.next(i / NSEL, u); u.sel = i % NSEL; return ok; }
};

struct GroupOrder {
    int G, c;
    __host__ __device__ void init(int G_, int c_) { G = G_; c = c_; }
    __host__ __device__ bool next(int i, Unit& u) const { const int L = i * G + c; if (L >= S5G * (NBLK_P / 256)) return false; u.sel = L / (NBLK_P / 256); u.pm = L % (NBLK_P / 256); u.pn = 0; return true; }
};
template <class Epi, class Sched>
__device__ __forceinline__ void gemm_phase(LAS unsigned char* lds, const Gemm g, const Sched& S, const Epi& E) {
    int tid = threadIdx.x; LAUNDER(tid);
    const int wid = __builtin_amdgcn_readfirstlane(tid >> 6), lane = tid & 63, wr = wid >> 2, wc = wid & 3, fr = lane & 15, fq = lane >> 4;
    const int K = g.K, nt = K / BK;
    unsigned voffA[2], voffB[2];
#pragma unroll
    for (int i = 0; i < 2; ++i) { int R, C; stage_rc(tid * 16 + i * 8192, R, C); const int Rb = Epi::PERM ? ((R & ~31) + perm32(R & 31)) : R;
        voffA[i] = (unsigned)(R * g.lda + C) * 2u; voffB[i] = (unsigned)(Rb * g.ldb + C) * 2u; }
    const size_t kstep = (size_t)(BK * 2);
    const size_t hstepA = (size_t)HALF * g.lda * 2, hstepB = (size_t)HALF * g.ldb * 2;
    const size_t tstepA = 2 * hstepA, tstepB = 2 * hstepB;
    const unsigned ldsw = (unsigned)wid * 1024u;
    const int aoff = lds_byte(wr * 64 + fr, fq * 8), boff = lds_byte(wc * 32 + fr, fq * 8);
#define PG8_SA(b, h) (((b) * 2 + (h)) * HTB)
#define PG8_SB(b, h) ((4 + (b) * 2 + (h)) * HTB)
#define PG8_STAGE(bufoff, gbase, voff) do { _Pragma("unroll") for (int _i = 0; _i < 2; ++_i) \
        GLDS16((const char*)(gbase) + (voff)[_i], lds + (bufoff) + ldsw + _i * 8192); } while (0)
#define PG8_LDA(dst, b, h) do { _Pragma("unroll") for (int m = 0; m < 4; ++m) _Pragma("unroll") for (int k = 0; k < 2; ++k) dst[m][k] = *(const LAS h16x8*)(lds + PG8_SA(b, h) + aoff + m * 2048 + k * 1024); } while (0)
#define PG8_LDB(dst, b, h) do { _Pragma("unroll") for (int n = 0; n < 2; ++n) _Pragma("unroll") for (int k = 0; k < 2; ++k) dst[n][k] = *(const LAS h16x8*)(lds + PG8_SB(b, h) + boff + n * 2048 + k * 1024); } while (0)
#define PG8_MMA(ai, bj, At, Bt) do { SETPRIO(1); _Pragma("unroll") for (int m = 0; m < 4; ++m) _Pragma("unroll") for (int n = 0; n < 2; ++n) _Pragma("unroll") for (int k = 0; k < 2; ++k) \
        acc[ai][bj][m][n] = MFMA16(Bt[n][k], At[m][k], acc[ai][bj][m][n]); SETPRIO(0); } while (0)
    Unit cur, nxt; int ui = 0;
    if (!S.next(0, cur)) return;
    f32x4 acc[2][2][4][2];
#if defined(HOST_SIM) && defined(SIM_FAST_GEMM)
    for (;; ++ui) {
        if (!S.next(ui, cur)) break;
        const h16* Ap = (const h16*)g.a(cur.sel); const h16* Bp = (const h16*)g.b(cur.sel);
        for (int ai = 0; ai < 2; ++ai) for (int bj = 0; bj < 2; ++bj) for (int m = 0; m < 4; ++m) for (int n = 0; n < 2; ++n) for (int j = 0; j < 4; ++j) {
            const int row = cur.pm * 256 + ai * 128 + wr * 64 + m * 16 + fr;
            const int col = cur.pn * 256 + bj * 128 + wc * 32 + (Epi::PERM ? 8 * fq + 4 * n + j : 16 * n + 4 * fq + j);
            float sacc = 0.f; for (int k = 0; k < K; ++k) sacc += (float)Ap[(size_t)row * g.lda + k] * (float)Bp[(size_t)col * g.ldb + k];
            acc[ai][bj][m][n][j] = (Epi::CHAIN && cur.sel > 0 ? acc[ai][bj][m][n][j] : 0.f) + sacc; }
        if constexpr (Epi::CHAIN) (void)E.chain(acc, cur, wr, wc, fr, fq); else E(acc, cur, wr, wc, fr, fq);
    }
    (void)nxt; (void)voffA; (void)voffB; (void)aoff; (void)boff; (void)ldsw; (void)kstep; (void)tstepA; (void)tstepB; (void)nt;
    return;
#endif
#pragma unroll
    for (int a = 0; a < 2; ++a)
#pragma unroll
        for (int b = 0; b < 2; ++b)
#pragma unroll
            for (int m = 0; m < 4; ++m)
#pragma unroll
                for (int n = 0; n < 2; ++n) acc[a][b][m][n] = (f32x4){0.f, 0.f, 0.f, 0.f};
    h16x8 At[4][2], B0[2][2], B1[2][2];
    const char* cA = g.a(cur.sel) + (size_t)cur.pm * tstepA; const char* cB = g.b(cur.sel) + (size_t)cur.pn * tstepB;
    PG8_STAGE(PG8_SB(0, 0), cB, voffB); PG8_STAGE(PG8_SA(0, 0), cA, voffA); PG8_STAGE(PG8_SB(0, 1), cB + hstepB, voffB); PG8_STAGE(PG8_SA(0, 1), cA + hstepA, voffA);
    if (wr == 1) SBAR;
    WAIT_V(4); SBAR;
    PG8_STAGE(PG8_SB(1, 0), cB + kstep, voffB); PG8_STAGE(PG8_SA(1, 0), cA + kstep, voffA); PG8_STAGE(PG8_SB(1, 1), cB + hstepB + kstep, voffB);
    WAIT_V(6); SBAR;
    for (;;) {
        const bool has_next = S.next(ui + 1, nxt);
        const char* nA = has_next ? g.a(nxt.sel) + (size_t)nxt.pm * tstepA : cA; const char* nB = has_next ? g.b(nxt.sel) + (size_t)nxt.pn * tstepB : cB;
        for (int t = 0; t < nt; t += 2) {
            if constexpr (Epi::PFI > 0) { const int it = (nt - 2 - t) >> 1;
                if (it < Epi::PFI && E.pf_on(it, wid)) { unsigned ln = 0; LANE_ID(ln); PF_LOAD(E.pf_base(cur, it) + E.pf_voff(it, (wid & 3) * 64 + (int)ln, wid >> 2), lds + STAGE_BYTES + wid * 256); } }
            const bool last = (t == nt - 2);
            const char* a1 = cA + (size_t)(t + 1) * kstep;
            const char* a2 = last ? nA : cA + (size_t)(t + 2) * kstep; const char* b2 = last ? nB : cB + (size_t)(t + 2) * kstep;
            const char* a3 = a2 + kstep; const char* b3 = b2 + kstep;
            PG8_LDB(B0, 0, 0); SCHED; PG8_LDA(At, 0, 0); PG8_STAGE(PG8_SA(1, 1), a1 + hstepA, voffA);
            WAIT_L(8); SBAR; WAIT_L(0); PG8_MMA(0, 0, At, B0); SBAR; SCHED;
            PG8_LDB(B1, 0, 1); PG8_STAGE(PG8_SB(0, 0), b2, voffB);
            SBAR; WAIT_L(0); PG8_MMA(0, 1, At, B1); SBAR;
            PG8_LDA(At, 0, 1); PG8_STAGE(PG8_SA(0, 0), a2, voffA);
            SBAR; WAIT_L(0); PG8_MMA(1, 0, At, B0); SBAR; SCHED;
            PG8_STAGE(PG8_SB(0, 1), b2 + hstepB, voffB);
            WAIT_V(6); SBAR; PG8_MMA(1, 1, At, B1); SBAR;
            PG8_LDB(B0, 1, 0); SCHED; PG8_LDA(At, 1, 0); PG8_STAGE(PG8_SA(0, 1), a2 + hstepA, voffA);
            WAIT_L(8); SBAR; WAIT_L(0); PG8_MMA(0, 0, At, B0); SBAR; SCHED;
            PG8_LDB(B1, 1, 1); PG8_STAGE(PG8_SB(1, 0), b3, voffB);
            SBAR; WAIT_L(0); PG8_MMA(0, 1, At, B1); SBAR;
            PG8_LDA(At, 1, 1); PG8_STAGE(PG8_SA(1, 0), a3, voffA);
            SBAR; WAIT_L(0); PG8_MMA(1, 0, At, B0); SBAR; SCHED;
            PG8_STAGE(PG8_SB(1, 1), b3 + hstepB, voffB);
            WAIT_V(6); SBAR; PG8_MMA(1, 1, At, B1); SBAR;
        }
        bool zero_acc = true;
        if constexpr (Epi::CHAIN) zero_acc = E.chain(acc, cur, wr, wc, fr, fq); else E(acc, cur, wr, wc, fr, fq);
        if (!has_next) break;
        if (zero_acc) {
#pragma unroll
        for (int a = 0; a < 2; ++a)
#pragma unroll
            for (int b = 0; b < 2; ++b)
#pragma unroll
                for (int m = 0; m < 4; ++m)
#pragma unroll
                    for (int n = 0; n < 2; ++n) acc[a][b][m][n] = (f32x4){0.f, 0.f, 0.f, 0.f};
        }
        cur = nxt; cA = nA; cB = nB; ++ui;
    }
    WAIT_V(0);
    if (wr == 0) SBAR;
    SBAR;
#undef PG8_SA
#undef PG8_SB
#undef PG8_STAGE
#undef PG8_LDA
#undef PG8_LDB
#undef PG8_MMA
}
}

__device__ __forceinline__ int mod_row(int row) { return row < MP ? 0 : 1 + (row - MP) / DSEQ; }

static_assert(D == 2 * W, "mixed-tile column grouping");
__host__ __device__ __forceinline__ int mix_tile(int colt) {
    if (colt >= C_MG) return (colt - C_MG) >> 8;
    if (colt >= C_SG) return 3 * D / 256 + W / 256 + ((colt - C_SG) >> 8);
    if (colt >= C_HGG && colt < C_AQ) return 3 * D / 256 + ((colt - C_HGG) >> 8);
    return -1;
}
__host__ __device__ __forceinline__ int win_src_col(int nd) {
    const int T = mix_tile(nd & ~255); if (T < 0) return nd;
    const int n = nd & 255, slot = ((n >> 7) << 1) | ((n >> 2) & 1), cb = 64 * T + ((n >> 5) & 3) * 16 + ((n >> 3) & 3) * 4 + (n & 3);
    return slot < 3 ? C_MG + slot * D + cb : (cb < W ? C_HGG + cb : C_SG + cb - W);
}
struct EpiIn {
    static constexpr bool PERM = true, CHAIN = false; static constexpr int PFI = 0;
    h16* Z; float* LOGF; const float* LB; h16* A3;
    __device__ __forceinline__ void operator()(const f32x4 (&acc)[2][2][4][2], const pg8::Unit& u, int wr, int wc, int fr, int fq) const {
        const int colt = u.pn * 256;
        int kind;
        if (colt < 2 * W) kind = 0; else if (colt < 4 * W) kind = 1; else if (colt < 5 * W) kind = 2; else if (colt < C_AG) kind = 0; else if (colt < C_SU) kind = 2;
        else if (colt < C_SG) kind = 0; else if (colt < C_MG) kind = 2; else kind = 3;
        const int row0 = u.pm * 256 + wr * 64 + fr;
        const int T = mix_tile(colt);
        if (T >= 0) {
            const int cb = 64 * T + wc * 16 + fq * 4, cs = cb < W ? C_HGG + cb : C_SG + cb - W;
            constexpr float EMAX = 16777216.f, HMAX = 65504.f;
#pragma unroll
            for (int ai = 0; ai < 2; ++ai)
#pragma unroll
                for (int m = 0; m < 4; ++m) {
                    h16* zr = Z + (size_t)(row0 + ai * 128 + m * 16) * INC;
                    h16x4 r0, r1, r2, sv;
#pragma unroll
                    for (int j = 0; j < 4; ++j) {
                        const float a0 = 1.0f + fminf(__expf(-acc[ai][0][m][0][j]), EMAX), a1 = 1.0f + fminf(__expf(-acc[ai][0][m][1][j]), EMAX), a2 = 1.0f + fminf(__expf(-acc[ai][1][m][0][j]), EMAX);
                        const float i0 = RCPF(a0), i1 = RCPF(a1), i2 = RCPF(a2);
                        r0[j] = (h16)fminf(a1 * i0, HMAX); r1[j] = (h16)fminf(a2 * i1, HMAX); r2[j] = (h16)i2; sv[j] = (h16)siluf(acc[ai][1][m][1][j]);
                    }
                    *(h16x4*)(zr + C_MG + cb) = r0; *(h16x4*)(zr + C_MG + D + cb) = r1; *(h16x4*)(zr + C_MG + 2 * D + cb) = r2; *(h16x4*)(zr + cs) = sv;
                }
            return;
        }
        if (kind == 1) {
            const int dir = colt >= 3 * W ? 1 : 0;
#pragma unroll
            for (int bj = 0; bj < 2; ++bj) {
                const int c0 = colt + bj * 128 + wc * 32 + 8 * fq;
                const float* lbp = LB + (size_t)dir * DEPTH * W + (c0 - (2 + dir) * W);
                const f32x4 l0 = *(const f32x4*)lbp, l1 = *(const f32x4*)(lbp + 4);
#pragma unroll
                for (int ai = 0; ai < 2; ++ai)
#pragma unroll
                    for (int m = 0; m < 4; ++m) {
                        const int row = row0 + ai * 128 + m * 16;
                        f32x4 o0, o1;
#pragma unroll
                        for (int j = 0; j < 4; ++j) { o0[j] = l0[j] + (1.0f - l0[j]) * sigm(acc[ai][bj][m][0][j]); o1[j] = l1[j] + (1.0f - l1[j]) * sigm(acc[ai][bj][m][1][j]); }
                        float* dst = LOGF + (size_t)row * (2 * W) + (c0 - 2 * W);
                        *(f32x4*)dst = o0; *(f32x4*)(dst + 4) = o1;
                    }
            }
            return;
        }
#pragma unroll
        for (int ai = 0; ai < 2; ++ai)
#pragma unroll
            for (int m = 0; m < 4; ++m) {
                const int row = row0 + ai * 128 + m * 16;
#pragma unroll
                for (int bj = 0; bj < 2; ++bj) {
                    const int c0 = colt + bj * 128 + wc * 32 + 8 * fq;
                    h16x8 o;
#pragma unroll
                    for (int j = 0; j < 4; ++j) {
                        float a = acc[ai][bj][m][0][j], b = acc[ai][bj][m][1][j];
                        if (kind == 2) { a = siluf(a); b = siluf(b); } else if (kind == 3) { a = sigm(a); b = sigm(b); }
                        o[j] = (h16)a; o[4 + j] = (h16)b;
                    }
                    if (colt >= C_HI && colt < C_FF) { bf16x8 ob;
#pragma unroll
                        for (int j = 0; j < 4; ++j) { ob[j] = (bf16)acc[ai][bj][m][0][j]; ob[4 + j] = (bf16)acc[ai][bj][m][1][j]; }
                        *(bf16x8*)((bf16*)Z + (size_t)row * INC + c0) = ob; }
                    else if (colt >= C_SU && colt < C_SG) { const int cg = c0 - C_SU; *(h16x8*)(A3 + ((size_t)(cg >> 4) * NBLK_P + (row >> 4)) * 512 + (row & 15) * 16 + (cg & 15)) = o; }
                    else *(h16x8*)(Z + (size_t)row * INC + c0) = o;
                }
            }
    }
};
struct EpiS5P {
    static constexpr bool PERM = false, CHAIN = false; static constexpr int PFI = 0;
    float* PB;
    __device__ __forceinline__ void operator()(const f32x4 (&acc)[2][2][4][2], const pg8::Unit& u, int wr, int wc, int fr, int fq) const {
        const int row0 = u.pm * 256 + wr * 64 + fr;
#pragma unroll
        for (int ai = 0; ai < 2; ++ai)
#pragma unroll
            for (int m = 0; m < 4; ++m) { const int row = row0 + ai * 128 + m * 16; if (row >= NBLK) continue;
#pragma unroll
                for (int bj = 0; bj < 2; ++bj)
#pragma unroll
                    for (int n = 0; n < 2; ++n) *(f32x4*)(PB + ((size_t)u.sel * NBLK_P + row) * 256 + bj * 128 + wc * 32 + 16 * n + 4 * fq) = acc[ai][bj][m][n]; }
    }
};
struct EpiS5Y {
    static constexpr bool PERM = true, CHAIN = false; static constexpr int PFI = 0;
    h16* YS;
    __device__ __forceinline__ void operator()(const f32x4 (&acc)[2][2][4][2], const pg8::Unit& u, int wr, int wc, int fr, int fq) const {
        const int row0 = u.pm * 256 + wr * 64 + fr, g = u.sel;
#pragma unroll
        for (int ai = 0; ai < 2; ++ai)
#pragma unroll
            for (int m = 0; m < 4; ++m)
#pragma unroll
                for (int bj = 0; bj < 2; ++bj) { const int blk = row0 + ai * 128 + m * 16, n0 = bj * 128 + wc * 32 + 8 * fq; if (blk >= NBLK) continue;
                    h16x8 o;
#pragma unroll
                    for (int j = 0; j < 4; ++j) { o[j] = (h16)geluf(acc[ai][bj][m][0][j]); o[4 + j] = (h16)geluf(acc[ai][bj][m][1][j]); }
                    *(h16x8*)(YS + ((size_t)blk * 16 + (n0 >> 4)) * W + g * 16 + (n0 & 15)) = o; }
    }
};
struct EpiGlu {
    static constexpr bool PERM = true, CHAIN = false; static constexpr int PFI = 4;
    __device__ __forceinline__ bool pf_on(int, int) const { return true; }
    __device__ __forceinline__ const char* pf_base(const pg8::Unit& u, int it) const { return (it >> 1) ? (const char*)(Z + (size_t)u.pm * 256 * INC + C_SG + u.pn * 256) : (const char*)(YS + (size_t)u.pm * 256 * W + u.pn * 256); }
    __device__ __forceinline__ unsigned pf_voff(int it, int l256, int hi) const { const int L = (it & 1) * 512 + hi * 256 + l256; return (unsigned)((L >> 2) * ((it >> 1) ? INC : W) + (L & 3) * 64) * 2u; }
    const h16* YS; const h16* Z; h16* OS5;
    __device__ __forceinline__ void operator()(const f32x4 (&acc)[2][2][4][2], const pg8::Unit& u, int wr, int wc, int fr, int fq) const {
        const int colt = u.pn * 256, row0 = u.pm * 256 + wr * 64 + fr;
#pragma unroll
        for (int ai = 0; ai < 2; ++ai) {
            h16x8 ys[4][2], sg[4][2];
#pragma unroll
            for (int m = 0; m < 4; ++m)
#pragma unroll
                for (int bj = 0; bj < 2; ++bj) { const int row = row0 + ai * 128 + m * 16, c0 = colt + bj * 128 + wc * 32 + 8 * fq;
                    ys[m][bj] = *(const h16x8*)(YS + (size_t)row * W + c0); sg[m][bj] = *(const h16x8*)(Z + (size_t)row * INC + C_SG + c0); }
#pragma unroll
            for (int m = 0; m < 4; ++m)
#pragma unroll
                for (int bj = 0; bj < 2; ++bj) { const int row = row0 + ai * 128 + m * 16, c0 = colt + bj * 128 + wc * 32 + 8 * fq;
                    h16x8 o;
#pragma unroll
                    for (int j = 0; j < 4; ++j) { o[j] = (h16)((float)ys[m][bj][j] * sigm(acc[ai][bj][m][0][j]) * (float)sg[m][bj][j]); o[4 + j] = (h16)((float)ys[m][bj][4 + j] * sigm(acc[ai][bj][m][1][j]) * (float)sg[m][bj][4 + j]); }
                    *(h16x8*)(OS5 + (size_t)row * W + c0) = o; }
            CFENCE;
        }
    }
};
struct EpiBr {
    static constexpr bool PERM = true, CHAIN = true; static constexpr int PFI = 4;
    __device__ __forceinline__ bool pf_on(int it, int wid) const { return (wid >> 2) == (it & 1); }
    __device__ __forceinline__ const char* pf_base(const pg8::Unit& u, int) const { return (const char*)(Z + (size_t)u.pm * 256 * INC + C_MG + (size_t)u.sel * D + u.pn * 256); }
    __device__ __forceinline__ unsigned pf_voff(int it, int l256, int) const { const int L = it * 256 + l256; return (unsigned)((L >> 2) * INC + (L & 3) * 64) * 2u; }
    const h16* Z; h16* MG;
    __device__ __forceinline__ bool chain(f32x4 (&acc)[2][2][4][2], const pg8::Unit& u, int wr, int wc, int fr, int fq) const {
        const int colt = u.pn * 256, row0 = u.pm * 256 + wr * 64 + fr, b = u.sel;
        h16x8 gn[2][4][2];
#pragma unroll
        for (int ai = 0; ai < 2; ++ai)
#pragma unroll
            for (int m = 0; m < 4; ++m)
#pragma unroll
                for (int bj = 0; bj < 2; ++bj) { const int row = row0 + ai * 128 + m * 16, c0 = colt + bj * 128 + wc * 32 + 8 * fq;
                    gn[ai][m][bj] = *(const h16x8*)(Z + (size_t)row * INC + C_MG + (size_t)b * D + c0); }
#pragma unroll
        for (int ai = 0; ai < 2; ++ai) {
#pragma unroll
            for (int m = 0; m < 4; ++m)
#pragma unroll
                for (int bj = 0; bj < 2; ++bj) {
#pragma unroll
                    for (int j = 0; j < 4; ++j) { acc[ai][bj][m][0][j] *= (float)gn[ai][m][bj][j]; acc[ai][bj][m][1][j] *= (float)gn[ai][m][bj][4 + j]; }
                    if (b == 2) { const int row = row0 + ai * 128 + m * 16, c0 = colt + bj * 128 + wc * 32 + 8 * fq; h16x8 o;
#pragma unroll
                        for (int j = 0; j < 4; ++j) { o[j] = (h16)acc[ai][bj][m][0][j]; o[4 + j] = (h16)acc[ai][bj][m][1][j]; }
                        *(h16x8*)(MG + (size_t)row * D + c0) = o; } }
            CFENCE;
        }
        return b == 2;
    }
};
struct EpiOut {
    static constexpr bool PERM = true, CHAIN = false; static constexpr int PFI = 4;
    __device__ __forceinline__ bool pf_on(int it, int wid) const { return !first && (wid >> 2) == (it & 1); }
    __device__ __forceinline__ const char* pf_base(const pg8::Unit& u, int) const { return (const char*)(X + (size_t)u.pm * 256 * D + u.pn * 256); }
    __device__ __forceinline__ unsigned pf_voff(int it, int l256, int) const { const int L = it * 256 + l256; return (unsigned)((L >> 2) * D + (L & 3) * 64) * 2u; }
    const float* XP; const float* XS; h16* X; const float* MOD; bool first;
    __device__ __forceinline__ void operator()(const f32x4 (&acc)[2][2][4][2], const pg8::Unit& u, int wr, int wc, int fr, int fq) const {
        const int colt = u.pn * 256, row0 = u.pm * 256 + wr * 64 + fr;
        const float* gate = MOD + (size_t)mod_row(u.pm * 256) * 3 * D + 2 * D;
        f32x4 gv[2][2];
#pragma unroll
        for (int bj = 0; bj < 2; ++bj)
#pragma unroll
            for (int n = 0; n < 2; ++n) gv[bj][n] = *(const f32x4*)(gate + colt + bj * 128 + wc * 32 + 8 * fq + 4 * n);
#pragma unroll
        for (int ai = 0; ai < 2; ++ai) {
            h16x8 xh[4][2];
            if (first) {
#pragma unroll
                for (int m = 0; m < 4; ++m) { const int row = row0 + ai * 128 + m * 16; const float* xin = row < MP ? XP + (size_t)row * D : XS + (size_t)(row - MP) * D;
#pragma unroll
                    for (int bj = 0; bj < 2; ++bj) { const f32x4 a = *(const f32x4*)(xin + colt + bj * 128 + wc * 32 + 8 * fq), b = *(const f32x4*)(xin + colt + bj * 128 + wc * 32 + 8 * fq + 4);
#pragma unroll
                        for (int j = 0; j < 4; ++j) { xh[m][bj][j] = (h16)a[j]; xh[m][bj][4 + j] = (h16)b[j]; } } }
            } else {
#pragma unroll
                for (int m = 0; m < 4; ++m)
#pragma unroll
                    for (int bj = 0; bj < 2; ++bj) xh[m][bj] = *(const h16x8*)(X + (size_t)(row0 + ai * 128 + m * 16) * D + colt + bj * 128 + wc * 32 + 8 * fq);
            }
#pragma unroll
            for (int m = 0; m < 4; ++m) { const int row = row0 + ai * 128 + m * 16;
#pragma unroll
                for (int bj = 0; bj < 2; ++bj) { h16x8 o;
#pragma unroll
                    for (int j = 0; j < 4; ++j) { o[j] = (h16)((float)xh[m][bj][j] + gv[bj][0][j] * acc[ai][bj][m][0][j]); o[4 + j] = (h16)((float)xh[m][bj][4 + j] + gv[bj][1][j] * acc[ai][bj][m][1][j]); }
                    *(h16x8*)(X + (size_t)row * D + colt + bj * 128 + wc * 32 + 8 * fq) = o; } }
            CFENCE;
        }
    }
};

template <bool WMAP = false>
__device__ __forceinline__ void transpose_cvt(LAS float* tile, const float* src, h16* dst, int K, int N, int bid, int G) {
    constexpr int LD = 129;
    const int nkt = K / 64, nnt = N / 128, tid = threadIdx.x;
    for (int t = bid; t < nkt * nnt; t += G) {
        const int kt = t / nnt, ntile = t % nnt;
        float v[16];
#pragma unroll
        for (int i = 0; i < 16; ++i) { const int idx = tid + i * 512, k = idx >> 7, n = idx & 127; v[i] = src[(size_t)(kt * 64 + k) * N + (WMAP ? win_src_col(ntile * 128 + n) : ntile * 128 + n)]; }
#pragma unroll
        for (int i = 0; i < 16; ++i) { const int idx = tid + i * 512, k = idx >> 7, n = idx & 127; tile[k * LD + n] = v[i]; }
        __syncthreads();
#pragma unroll
        for (int i = 0; i < 2; ++i) { const int id = tid + i * 512, n = id & 127, kc = id >> 7; h16x8 o;
#pragma unroll
            for (int j = 0; j < 8; ++j) o[j] = (h16)tile[(kc * 8 + j) * LD + n];
            *(h16x8*)(dst + (size_t)(ntile * 128 + n) * K + kt * 64 + kc * 8) = o; }
        __syncthreads();
    }
}
__device__ __forceinline__ void s5_build(const Params& p, int item, LAS unsigned char* lds) {
    const int tid = threadIdx.x, l = item / S5G, g = item % S5G;
    LAS f32x2* POW = (LAS f32x2*)lds;
    LAS f32x2* BBL = POW + 2 * 17 * 64;
    LAS f32x2* CCL = BBL + 2 * 64 * 16;
    LAS float* KT = (LAS float*)(CCL + 16 * 64);
    if (tid < 128) { const int dir = tid >> 6, pp = tid & 63; const size_t i = (((size_t)l * 2 + dir) * S5G + g) * S5P + pp;
        const float are = p.in[I_ARE][i], aim = p.in[I_AIM][i], dt = __expf(p.in[I_LDT][((size_t)l * 2 + dir) * S5G + g]);
        const float mag = expf(are * dt), abr = mag * cosf(aim * dt), abi = mag * sinf(aim * dt);
        const float den = are * are + aim * aim, nre = abr - 1.0f; const float cre = (nre * are + abi * aim) / den, cim = (abi * are - nre * aim) / den;
        float pr = 1.0f, pi_ = 0.0f;
        for (int k = 0; k <= 16; ++k) { POW[(dir * 17 + k) * 64 + pp] = (f32x2){pr, pi_}; const float nr = pr * abr - pi_ * abi, ni = pr * abi + pi_ * abr; pr = nr; pi_ = ni; }
        for (int c = 0; c < 16; ++c) { const float br = p.in[I_BRE][i * 16 + c], bi = p.in[I_BIM][i * 16 + c]; BBL[(dir * 64 + pp) * 16 + c] = (f32x2){cre * br - cim * bi, cre * bi + cim * br}; } }
    for (int i = tid; i < 16 * 64; i += NTHREADS) { const size_t ci = ((size_t)l * S5G + g) * 16 * S5P + i; CCL[i] = (f32x2){p.in[I_CRE][ci], p.in[I_CIM][ci]}; }
    __syncthreads();
    {
        const int dir = tid >> 8, lag = (tid >> 4) & 15, c = tid & 15; float acc[16];
#pragma unroll
        for (int cp = 0; cp < 16; ++cp) acc[cp] = 0.f;
        for (int pp = 0; pp < 64; ++pp) { const f32x2 cc = CCL[c * 64 + pp], aw = POW[(dir * 17 + lag) * 64 + pp];
            const float mr = cc[0] * aw[0] - cc[1] * aw[1], mi = cc[0] * aw[1] + cc[1] * aw[0];
            const LAS f32x4* bb4 = (const LAS f32x4*)(BBL + (dir * 64 + pp) * 16);
#pragma unroll
            for (int k = 0; k < 8; ++k) { const f32x4 b2 = bb4[k]; acc[2 * k] += mr * b2[0] - mi * b2[1]; acc[2 * k + 1] += mr * b2[2] - mi * b2[3]; } }
#pragma unroll
        for (int cp = 0; cp < 16; ++cp) KT[(dir * 16 + lag) * 256 + c * 16 + cp] = acc[cp];
    }
    __syncthreads();
    h16* BY = (h16*)(p.ws + WS_S5BY) + ((size_t)l * S5G + g) * 256 * 512; h16* BG = (h16*)(p.ws + WS_S5BG) + ((size_t)l * S5G + g) * 256 * 256;
    for (int ch = tid; ch < 256 * 64; ch += NTHREADS) { const int n = ch >> 6, k0 = (ch & 63) * 8, j = n >> 4, c = n & 15; h16x8 o;
#pragma unroll
        for (int q = 0; q < 8; ++q) { const int k = k0 + q; float v;
            if (k < 256) { const int jp = k >> 4, cp = k & 15; v = (jp <= j ? KT[(0 * 16 + (j - jp)) * 256 + c * 16 + cp] : 0.f) + (jp >= j ? KT[(1 * 16 + (jp - j)) * 256 + c * 16 + cp] : 0.f);
                if (jp == j && cp == c) v += p.in[I_S5D][(size_t)l * W + g * 16 + c]; }
            else { const int kk = k - 256, dir = kk >> 7, im = (kk >> 6) & 1, pp = kk & 63; const f32x2 cc = CCL[c * 64 + pp], aw = POW[(dir * 17 + (dir ? 16 - j : j + 1)) * 64 + pp];
                v = im ? -(cc[0] * aw[1] + cc[1] * aw[0]) : (cc[0] * aw[0] - cc[1] * aw[1]); }
            o[q] = (h16)v; }
        *(h16x8*)(BY + (size_t)n * 512 + k0) = o; }
    for (int ch = tid; ch < 256 * 32; ch += NTHREADS) { const int n = ch >> 5, k0 = (ch & 31) * 8, dir = n >> 7, im = (n >> 6) & 1, pp = n & 63; h16x8 o;
#pragma unroll
        for (int q = 0; q < 8; ++q) { const int k = k0 + q, jp = k >> 4, cp = k & 15; const f32x2 aw = POW[(dir * 17 + (dir ? jp : 15 - jp)) * 64 + pp], bb = BBL[(dir * 64 + pp) * 16 + cp];
            o[q] = (h16)(im ? (aw[0] * bb[1] + aw[1] * bb[0]) : (aw[0] * bb[0] - aw[1] * bb[1])); }
        *(h16x8*)(BG + (size_t)n * 256 + k0) = o; }
    __syncthreads();
}
__device__ __forceinline__ void phase_prologue(const Params& p, LAS unsigned char* lds) {
    const int tid = threadIdx.x, bid = blockIdx.x, G = gridDim.x;
    unsigned char* ws = p.ws;
    {
        const int nitems = DEPTH * (3 * D / 128);
        if (bid < nitems) {
            LAS float* sc = (LAS float*)lds;
            LAS float* red = sc + NMODR * D;
            for (int i = tid; i < NMODR * D; i += NTHREADS) { const int r = i / D, k = i % D; const float c = r == 0 ? p.in[I_CCTX][k] : p.in[I_C][(size_t)(r - 1) * D + k]; sc[i] = siluf(c); }
            __syncthreads();
            for (int it = bid; it < nitems; it += G) {
                const int l = it / (3 * D / 128), j = (it % (3 * D / 128)) * 128 + (tid & 127), kg = tid >> 7;
                float a[NMODR];
#pragma unroll
                for (int r = 0; r < NMODR; ++r) a[r] = 0.f;
                const float* wp = p.in[I_WMOD] + (size_t)l * D * 3 * D + j;
                for (int k = kg * (D / 4); k < (kg + 1) * (D / 4); k += 32) { float w8[32];
#pragma unroll
                    for (int kk = 0; kk < 32; ++kk) w8[kk] = wp[(size_t)(k + kk) * 3 * D];
#pragma unroll
                    for (int kk = 0; kk < 32; ++kk)
#pragma unroll
                        for (int r = 0; r < NMODR; ++r) a[r] += sc[r * D + k + kk] * w8[kk]; }
#pragma unroll
                for (int r = 0; r < NMODR; ++r) red[(kg * NMODR + r) * 128 + (tid & 127)] = a[r];
                __syncthreads();
                for (int i = tid; i < NMODR * 128; i += NTHREADS) { const int r = i / 128, jj = i % 128; const int jcol = (it % (3 * D / 128)) * 128 + jj;
                    const float s = red[(0 * NMODR + r) * 128 + jj] + red[(1 * NMODR + r) * 128 + jj] + red[(2 * NMODR + r) * 128 + jj] + red[(3 * NMODR + r) * 128 + jj];
                    ((float*)(ws + WS_MOD))[((size_t)l * NMODR + r) * 3 * D + jcol] = s + p.in[I_BMOD][(size_t)l * 3 * D + jcol]; }
                __syncthreads();
            }
        }
        __syncthreads();
    }
    for (int i = bid * NTHREADS + tid; i < 2 * W; i += G * NTHREADS) {
        const int dir = i / W, w = i % W; const float* lg = p.in[I_LBL] + (size_t)dir * DEPTH * W + w;
        float mx = -1e30f; for (int l = 0; l < DEPTH; ++l) mx = fmaxf(mx, lg[(size_t)l * W]);
        float den = 0.f; for (int l = 0; l < DEPTH; ++l) den += __expf(lg[(size_t)l * W] - mx);
        float cs = 0.f, first = 0.f;
        for (int l = 0; l < DEPTH; ++l) { cs += __expf(lg[(size_t)l * W] - mx) / den; if (l == 0) first = cs; ((float*)(ws + WS_LB))[((size_t)dir * DEPTH + l) * W + w] = cs - first; }
    }
    for (int i = bid * NTHREADS + tid; i < DEPTH * 2 * S5G * S5P; i += G * NTHREADS) {
        const int gidx = i / S5P;
        const float are = p.in[I_ARE][i], aim = p.in[I_AIM][i], dt = __expf(p.in[I_LDT][gidx]);
        const float mag = expf(are * dt), abr = mag * cosf(aim * dt), abi = mag * sinf(aim * dt);
        const float den = are * are + aim * aim, nre = abr - 1.0f;
        const float cre = (nre * are + abi * aim) / den, cim = (abi * are - nre * aim) / den;
        ((f32x2*)(ws + WS_ABAR))[i] = (f32x2){abr, abi};
        h16* bb = (h16*)(ws + WS_BBAR) + (size_t)i * 32;
        for (int c = 0; c < 16; ++c) { const float br = p.in[I_BRE][(size_t)i * 16 + c], bi = p.in[I_BIM][(size_t)i * 16 + c]; bb[c] = (h16)(cre * br - cim * bi); bb[16 + c] = (h16)(cre * bi + cim * br); }
    }
    __syncthreads();
    for (int it = bid; it < DEPTH * S5G; it += G) s5_build(p, it, lds);
    for (int i = bid * NTHREADS + tid; i < (DSEQ / 64 + 64) * 32; i += G * NTHREADS) {
        const int pos = i / 32, j = i % 32; const float inv = exp2f(-(float)j * (13.287712379549449f / 32.0f));
        const float ang = (float)(pos < DSEQ / 64 ? pos : pos - DSEQ / 64) * inv;
        ((f32x2*)(ws + WS_ROPE))[i] = (f32x2){cosf(ang), sinf(ang)};
    }
    LAS float* tile = (LAS float*)lds;
    for (int l = 0; l < DEPTH; ++l) {
        transpose_cvt<true>(tile, p.in[I_WIN] + (size_t)l * D * INC, (h16*)(ws + WS_WIN) + (size_t)l * INC * D, D, INC, bid, G);
        transpose_cvt(tile, p.in[I_WGLU] + (size_t)l * W * W, (h16*)(ws + WS_WGLU) + (size_t)l * W * W, W, W, bid, G);
        transpose_cvt(tile, p.in[I_WBRHG] + (size_t)l * W * D, (h16*)(ws + WS_WBR) + (size_t)(l * 3 + 0) * D * W, W, D, bid, G);
        transpose_cvt(tile, p.in[I_WBRAT] + (size_t)l * W * D, (h16*)(ws + WS_WBR) + (size_t)(l * 3 + 1) * D * W, W, D, bid, G);
        transpose_cvt(tile, p.in[I_WBRS5] + (size_t)l * W * D, (h16*)(ws + WS_WBR) + (size_t)(l * 3 + 2) * D * W, W, D, bid, G);
        transpose_cvt(tile, p.in[I_WOUT] + (size_t)l * D * D, (h16*)(ws + WS_WOUT) + (size_t)l * D * D, D, D, bid, G);
    }
}

__device__ __forceinline__ void phase_norm(const Params& p, int l) {
    int tid_ = threadIdx.x; LAUNDER(tid_);
    const int lane = tid_ & 63, gw = blockIdx.x * NWAVES + (tid_ >> 6), nw = gridDim.x * NWAVES;
    const float* nwt = p.in[I_NORMW] + (size_t)l * D;
    const float* MOD = (const float*)(p.ws + WS_MOD) + (size_t)l * NMODR * 3 * D;
    h16* H = (h16*)(p.ws + WS_H);
    if (l > 0) {
        const h16* X = (const h16*)(p.ws + WS_X);
        for (int row = gw; row < M; row += nw) {
            h16x8 v[D / 512]; float ss = 0.f;
#pragma unroll
            for (int i = 0; i < D / 512; ++i) { v[i] = *(const h16x8*)(X + (size_t)row * D + i * 512 + lane * 8);
#pragma unroll
                for (int j = 0; j < 8; ++j) ss += (float)v[i][j] * (float)v[i][j]; }
            ss = wave_sum(ss, lane);
            const float rstd = rsqrtf(ss / (float)D + EPS);
            const float* md = MOD + (size_t)mod_row(row) * 3 * D;
#pragma unroll
            for (int i = 0; i < D / 512; ++i) { const int c = i * 512 + lane * 8; h16x8 o;
#pragma unroll
                for (int n = 0; n < 2; ++n) { const f32x4 wv = *(const f32x4*)(nwt + c + 4 * n), sh = *(const f32x4*)(md + c + 4 * n), scl = *(const f32x4*)(md + D + c + 4 * n);
#pragma unroll
                    for (int j = 0; j < 4; ++j) o[4 * n + j] = (h16)((float)v[i][4 * n + j] * rstd * wv[j] * (1.0f + scl[j]) + sh[j]); }
                *(h16x8*)(H + (size_t)row * D + c) = o; }
        }
        return;
    }
    for (int row = gw; row < M; row += nw) {
        const float* x = row < MP ? p.in[I_XP] + (size_t)row * D : p.in[I_XS] + (size_t)(row - MP) * D;
        f32x4 v[D / 256]; float ss = 0.f;
#pragma unroll
        for (int i = 0; i < D / 256; ++i) { v[i] = *(const f32x4*)(x + i * 256 + lane * 4); ss += v[i][0] * v[i][0] + v[i][1] * v[i][1] + v[i][2] * v[i][2] + v[i][3] * v[i][3]; }
        ss = wave_sum(ss, lane);
        const float rstd = rsqrtf(ss / (float)D + EPS);
        const float* md = MOD + (size_t)mod_row(row) * 3 * D;
#pragma unroll
        for (int i = 0; i < D / 256; ++i) { const int c = i * 256 + lane * 4; const f32x4 wv = *(const f32x4*)(nwt + c), sh = *(const f32x4*)(md + c), scl = *(const f32x4*)(md + D + c);
            h16x4 o;
#pragma unroll
            for (int j = 0; j < 4; ++j) o[j] = (h16)(v[i][j] * rstd * wv[j] * (1.0f + scl[j]) + sh[j]);
            *(h16x4*)(H + (size_t)row * D + c) = o; }
    }
}
__device__ __forceinline__ void phase_final(const Params& p) {
    int tid_ = threadIdx.x; LAUNDER(tid_);
    const int lane = tid_ & 63, gw = blockIdx.x * NWAVES + (tid_ >> 6), nw = gridDim.x * NWAVES;
    const float* fw = p.in[I_FNORM];
    const h16* X = (const h16*)(p.ws + WS_X);
    for (int row = gw; row < M; row += nw) {
        h16x8 v[D / 512]; float ss = 0.f;
#pragma unroll
        for (int i = 0; i < D / 512; ++i) { v[i] = *(const h16x8*)(X + (size_t)row * D + i * 512 + lane * 8);
#pragma unroll
            for (int j = 0; j < 8; ++j) ss += (float)v[i][j] * (float)v[i][j]; }
        ss = wave_sum(ss, lane);
        const float rstd = rsqrtf(ss / (float)D + EPS);
#pragma unroll
        for (int i = 0; i < D / 512; ++i) { const int c = i * 512 + lane * 8;
#pragma unroll
            for (int n = 0; n < 2; ++n) { const f32x4 wv = *(const f32x4*)(fw + c + 4 * n); f32x4 o;
#pragma unroll
                for (int j = 0; j < 4; ++j) o[j] = (float)v[i][4 * n + j] * rstd * wv[j];
                *(f32x4*)(p.out + O_Y + (size_t)row * D + c + 4 * n) = o; } }
    }
}

constexpr int PV_LS = 264;
__device__ __forceinline__ void prep_vt_store(LAS h16* VL, h16* VTrow0, int NKs, int pos0, int tid) {
#pragma unroll
    for (int i = 0; i < KVW * 8 / NTHREADS; ++i) { const int id = tid + NTHREADS * i, dk = id >> 3, tc = id & 7; h16x8 o;
#pragma unroll
        for (int j = 0; j < 8; ++j) o[j] = VL[(tc * 8 + j) * PV_LS + dk];
        *(h16x8*)(VTrow0 + (size_t)dk * NKs + pos0 + tc * 8) = o; }
}
__device__ __forceinline__ void prep_tile(const Params& p, int l, int tile, LAS unsigned char* lds) {
    int tid = threadIdx.x; LAUNDER(tid);
    const int w = tid >> 6, lane = tid & 63;
    LAS h16* VL = (LAS h16*)lds;
    constexpr int NT_REAL = M / 64;
    if (tile >= NT_REAL) {
        const int ct = tile - NT_REAL, b = ct / (PAST / 64), pos0 = (ct % (PAST / 64)) * 64;
        const float* ck = p.in[I_CK] + (((size_t)b * DEPTH + l) * PAST + pos0) * KVW; const float* cv = p.in[I_CV] + (((size_t)b * DEPTH + l) * PAST + pos0) * KVW;
        h16* kd = (h16*)(p.ws + WS_KBS) + ((size_t)b * KVLEN + pos0) * KVW;
#pragma unroll
        for (int i = 0; i < 64 * KVW / 8 / NTHREADS; ++i) { const int id = tid + NTHREADS * i, row = id / (KVW / 8), c = id % (KVW / 8);
            const f32x4 k0 = *(const f32x4*)(ck + (size_t)row * KVW + c * 8), k1 = *(const f32x4*)(ck + (size_t)row * KVW + c * 8 + 4);
            const f32x4 v0 = *(const f32x4*)(cv + (size_t)row * KVW + c * 8), v1 = *(const f32x4*)(cv + (size_t)row * KVW + c * 8 + 4);
            h16x8 ko, vo;
#pragma unroll
            for (int j = 0; j < 4; ++j) { ko[j] = (h16)k0[j]; ko[4 + j] = (h16)k1[j]; vo[j] = (h16)v0[j]; vo[4 + j] = (h16)v1[j]; }
            *(h16x8*)(kd + (size_t)row * KVW + c * 8) = ko; *(LAS h16x8*)(VL + row * PV_LS + c * 8) = vo; }
        __syncthreads();
        prep_vt_store(VL, (h16*)(p.ws + WS_VBS) + (size_t)b * KVW * KVLEN, KVLEN, pos0, tid);
        __syncthreads();
        return;
    }
    const int r0 = tile * 64; const bool smp = r0 >= MP;
    const int b = smp ? (r0 - MP) / DSEQ : r0 / SEQ, t0 = smp ? (r0 - MP) % DSEQ : r0 % SEQ;
    const h16* Z = (const h16*)(p.ws + WS_Z);
#pragma unroll
    for (int i = 0; i < 64 * KVW / 8 / NTHREADS; ++i) { const int id = tid + NTHREADS * i, row = id / (KVW / 8), c = id % (KVW / 8);
        const h16x8 v = *(const h16x8*)(Z + (size_t)(r0 + row) * INC + C_AV + c * 8);
        *(LAS h16x8*)(VL + row * PV_LS + c * 8) = v;
        if (!smp) { float* cvo = p.out + O_CV + (((size_t)b * DEPTH + l) * SEQ + t0 + row) * KVW + c * 8; f32x4 a, bq;
#pragma unroll
            for (int j = 0; j < 4; ++j) { a[j] = (float)v[j]; bq[j] = (float)v[4 + j]; }
            *(f32x4*)cvo = a; *(f32x4*)(cvo + 4) = bq; } }
    __syncthreads();
    if (smp) prep_vt_store(VL, (h16*)(p.ws + WS_VBS) + (size_t)b * KVW * KVLEN, KVLEN, PAST + t0, tid);
    else prep_vt_store(VL, (h16*)(p.ws + WS_VBC) + (size_t)b * KVW * SEQ, SEQ, t0, tid);
    constexpr int NH = AQH + AKVH, NGRP = 64 * NH / 4, PQN = 4;
    const int c8 = (lane & 15) * 8, sub = lane >> 4;
    const f32x4 wq0 = *(const f32x4*)(p.in[I_QNORM] + (size_t)l * 128 + c8), wq1 = *(const f32x4*)(p.in[I_QNORM] + (size_t)l * 128 + c8 + 4);
    const f32x4 wk0 = *(const f32x4*)(p.in[I_KNORM] + (size_t)l * 128 + c8), wk1 = *(const f32x4*)(p.in[I_KNORM] + (size_t)l * 128 + c8 + 4);
    const int cp8 = c8 ^ 32;
    const f32x4 wqp0 = *(const f32x4*)(p.in[I_QNORM] + (size_t)l * 128 + cp8), wqp1 = *(const f32x4*)(p.in[I_QNORM] + (size_t)l * 128 + cp8 + 4);
    const f32x4 wkp0 = *(const f32x4*)(p.in[I_KNORM] + (size_t)l * 128 + cp8), wkp1 = *(const f32x4*)(p.in[I_KNORM] + (size_t)l * 128 + cp8 + 4);
    const f32x2* ROPE = (const f32x2*)(p.ws + WS_ROPE);
    for (int g0 = w; g0 < NGRP; g0 += PQN * NWAVES) {
        h16x8 xr[PQN]; f32x4 rt[PQN][4];
#pragma unroll
        for (int k = 0; k < PQN; ++k) { const int grp = g0 + k * NWAVES; if (grp >= NGRP) continue; const int it = grp * 4 + sub; const int row = it / NH, hh = it % NH; const bool isq = hh < AQH;
            xr[k] = *(const h16x8*)(Z + (size_t)(r0 + row) * INC + (isq ? C_AQ + hh * 128 : C_AK + (hh - AQH) * 128) + c8);
            if (smp) { const int t = t0 + row; const int pos = c8 < 64 ? t / 64 : DSEQ / 64 + (t % 64); const f32x4* rp = (const f32x4*)(ROPE + pos * 32 + (c8 & 31));
#pragma unroll
                for (int q = 0; q < 4; ++q) rt[k][q] = rp[q]; } }
#pragma unroll
        for (int k = 0; k < PQN; ++k) { const int grp = g0 + k * NWAVES; if (grp >= NGRP) continue; const int it = grp * 4 + sub; const int row = it / NH, hh = it % NH; const bool isq = hh < AQH; const int t = t0 + row;
            float x[8]; float ss = 0.f;
#pragma unroll
            for (int j = 0; j < 8; ++j) { x[j] = (float)xr[k][j]; ss += x[j] * x[j]; }
            ss += shfl_xor_l(ss, 8, lane); ss += shfl_xor_l(ss, 4, lane); ss += shfl_xor_l(ss, 2, lane); ss += shfl_xor_l(ss, 1, lane);
            const float rstd = rsqrtf(ss * (1.0f / 128.0f) + EPS);
            float a[8];
#pragma unroll
            for (int j = 0; j < 4; ++j) { a[j] = x[j] * rstd * (isq ? wq0[j] : wk0[j]); a[4 + j] = x[4 + j] * rstd * (isq ? wq1[j] : wk1[j]); }
            if (!isq && !smp) { float* cko = p.out + O_CK + (((size_t)b * DEPTH + l) * SEQ + t) * KVW + (hh - AQH) * 128 + c8; *(f32x4*)cko = (f32x4){a[0], a[1], a[2], a[3]}; *(f32x4*)(cko + 4) = (f32x4){a[4], a[5], a[6], a[7]}; }
            if (smp) { const h16x2 x01 = {xr[k][0], xr[k][1]}, x23 = {xr[k][2], xr[k][3]}, x45 = {xr[k][4], xr[k][5]}, x67 = {xr[k][6], xr[k][7]};
                const float pf0 = shfl_xor_l(__builtin_bit_cast(float, x01), 4, lane), pf1 = shfl_xor_l(__builtin_bit_cast(float, x23), 4, lane), pf2 = shfl_xor_l(__builtin_bit_cast(float, x45), 4, lane), pf3 = shfl_xor_l(__builtin_bit_cast(float, x67), 4, lane);
                const u32x4 pw = {__builtin_bit_cast(unsigned, pf0), __builtin_bit_cast(unsigned, pf1), __builtin_bit_cast(unsigned, pf2), __builtin_bit_cast(unsigned, pf3)};
                const h16x8 pr = __builtin_bit_cast(h16x8, pw); const bool lo = (lane & 4) == 0;
#pragma unroll
                for (int j = 0; j < 8; ++j) { const float pn = (float)pr[j] * rstd * (isq ? (j < 4 ? wqp0[j] : wqp1[j - 4]) : (j < 4 ? wkp0[j] : wkp1[j - 4]));
                    const float cs = rt[k][j >> 1][(j & 1) * 2], sn = rt[k][j >> 1][(j & 1) * 2 + 1]; a[j] = lo ? a[j] * cs - pn * sn : a[j] * cs + pn * sn; } }
            h16x8 o;
            if (isq) { const float sc = 0.08838834764831845f;
#pragma unroll
                for (int j = 0; j < 8; ++j) o[j] = (h16)(a[j] * sc);
                *(h16x8*)((h16*)(p.ws + WS_AQ2) + (size_t)(r0 + row) * W + hh * 128 + c8) = o; }
            else {
#pragma unroll
                for (int j = 0; j < 8; ++j) o[j] = (h16)a[j];
                *(h16x8*)((smp ? (h16*)(p.ws + WS_KBS) + ((size_t)b * KVLEN + PAST + t) * KVW : (h16*)(p.ws + WS_KBC) + ((size_t)b * SEQ + t) * KVW) + (hh - AQH) * 128 + c8) = o; } }
    }
    __syncthreads();
}
#ifdef HOST_SIM
#define MFMA16B(a, b, c) sim::mfma16<0>(&(a), &(b), c)
#else
#define MFMA16B(a, b, c) __builtin_amdgcn_mfma_f32_16x16x32_bf16(a, b, c, 0, 0, 0)
#endif
constexpr int HS_QK = 136, HS_T = 40;
constexpr int HG_SET = 2 * 32 * HS_QK * 2 + 2 * 128 * HS_T * 2 + 32 * HS_T * 2;
constexpr int HG_QH = 0, HG_KH = HG_QH + 32 * HS_QK * 2, HG_KHT = HG_KH + 32 * HS_QK * 2, HG_VT = HG_KHT + 128 * HS_T * 2, HG_P = HG_VT + 128 * HS_T * 2,
              HG_SST = 2 * HG_SET, HG_END = HG_SST + 128 * HS_QK * 2;
static_assert(HG_END <= STAGE_BYTES && HG_SET % 16 == 0, "hgrn LDS");
__device__ __forceinline__ void hgrn_item(const Params& p, int l, int sq, int h, int dir, LAS unsigned char* lds) {
    int tid = threadIdx.x; LAUNDER(tid);
    const int w = tid >> 6, lane = tid & 63, lr = lane & 15, lq = lane >> 4;
    const bool smp = sq < DBATCH; const int b = smp ? sq : sq - DBATCH;
    const int T = smp ? DSEQ : SEQ, row0 = smp ? MP + b * DSEQ : b * SEQ, NC = T / 32;
    const h16* Z = (const h16*)(p.ws + WS_Z); const float* LOGF = (const float*)(p.ws + WS_LOGF);
    h16* O = (h16*)(p.ws + (dir ? WS_OB : WS_OF));
    LAS bf16* SST = (LAS bf16*)(lds + HG_SST);
    const int dcol = 16 * w + lr;
    f32x4 S[8];
    if (smp) { const float* s0 = p.in[I_SH] + ((((size_t)b * DEPTH + l) * 2 + dir) * HGH + h) * 128 * 128;
#pragma unroll
        for (int vt = 0; vt < 8; ++vt)
#pragma unroll
            for (int i = 0; i < 4; ++i) S[vt][i] = s0[(size_t)(16 * w + 4 * lq + i) * 128 + 16 * vt + lr]; }
    else {
#pragma unroll
        for (int vt = 0; vt < 8; ++vt) S[vt] = (f32x4){0.f, 0.f, 0.f, 0.f}; }
    const unsigned voffz = (unsigned)(((dir ? 31 - 8 * lq : 8 * lq) * INC + h * 128 + dcol) * 2);
    const unsigned voffl = (unsigned)(((dir ? 31 - 8 * lq : 8 * lq) * 2 * W + dir * W + h * 128 + dcol) * 4);
    const unsigned voffo = (unsigned)(((dir ? 31 - 4 * lq : 4 * lq) * W + h * 128 + 16 * w + lr) * 2);
    const long sgn = dir ? -1 : 1;
    float lfX[8]; h16 qvX[8]; bf16 vvX[8];
#define HG_LOAD(S_, c) do { const int cc_ = (c) < NC ? (c) : NC - 1; const int rlo = dir ? row0 + T - 32 * cc_ - 32 : row0 + 32 * cc_; const char* zb = (const char*)Z + (size_t)rlo * INC * 2; const char* lb = (const char*)LOGF + (size_t)rlo * 2 * W * 4; \
        _Pragma("unroll") for (int i = 0; i < 8; ++i) { const char* zi_ = zb + sgn * i * (long)(INC * 2); const char* li_ = lb + sgn * i * (long)(2 * W * 4); \
            lf##S_[i] = *(const float*)(li_ + voffl); qv##S_[i] = *(const h16*)(zi_ + C_HQ * 2 + voffz); vv##S_[i] = *(const bf16*)(zi_ + C_HI * 2 + voffz); } } while (0)
#define HG_IMAGES(S_, st, EBL) do { \
        LAS bf16* QH_ = (LAS bf16*)(lds + (st) * HG_SET + HG_QH); LAS bf16* KH_ = (LAS bf16*)(lds + (st) * HG_SET + HG_KH); LAS bf16* KHT_ = (LAS bf16*)(lds + (st) * HG_SET + HG_KHT); LAS bf16* VT_ = (LAS bf16*)(lds + (st) * HG_SET + HG_VT); \
        float pc[8]; float run = 1.f;                                     \
        _Pragma("unroll") for (int i = 0; i < 8; ++i) { run *= lf##S_[i]; pc[i] = run; } \
        const float t0 = shfl_l(run, lr), t1 = shfl_l(run, lr + 16), t2 = shfl_l(run, lr + 32), t3 = shfl_l(run, lr + 48); \
        const float pre = (lq > 0 ? t0 : 1.f) * (lq > 1 ? t1 : 1.f) * (lq > 2 ? t2 : 1.f), pl = (t0 * t1) * (t2 * t3);     \
        const float qs = pre * RCPF(pl);                                  \
        bf16x8 kht, vtv; \
        _Pragma("unroll") for (int i = 0; i < 8; ++i) { const float e = qs * pc[i]; const float kk = (1.0f - lf##S_[i]) * RCPF(e), qq = (float)qv##S_[i] * e; \
            const int t = 8 * lq + i; QH_[t * HS_QK + dcol] = (bf16)qq; KH_[t * HS_QK + dcol] = (bf16)kk; kht[i] = (bf16)kk; vtv[i] = vv##S_[i]; } \
        *(LAS bf16x8*)(KHT_ + dcol * HS_T + 8 * lq) = kht; \
        *(LAS bf16x8*)(VT_ + dcol * HS_T + 8 * lq) = vtv; \
        EBL = pl; } while (0)
#define HG_CHUNK(c, SN_) do { const int st = (c) & 1; PSPIN_T0(13) \
        LAS bf16* QH = (LAS bf16*)(lds + st * HG_SET + HG_QH); LAS bf16* KH = (LAS bf16*)(lds + st * HG_SET + HG_KH); LAS bf16* KHT = (LAS bf16*)(lds + st * HG_SET + HG_KHT); \
        LAS bf16* VT = (LAS bf16*)(lds + st * HG_SET + HG_VT); LAS bf16* PP = (LAS bf16*)(lds + st * HG_SET + HG_P); \
        _Pragma("unroll") for (int i = 0; i < 4; ++i) { const float e = shfl_l(ebl, 4 * lq + i); \
            _Pragma("unroll") for (int vt = 0; vt < 8; ++vt) S[vt][i] *= e; } \
        _Pragma("unroll") for (int vt = 0; vt < 8; ++vt) { bf16x4 sv; sv[0] = (bf16)S[vt][0]; sv[1] = (bf16)S[vt][1]; sv[2] = (bf16)S[vt][2]; sv[3] = (bf16)S[vt][3]; \
            *(LAS bf16x4*)(SST + (16 * vt + lr) * HS_QK + 16 * w + 4 * lq) = sv; } \
        __syncthreads(); PSPIN_T1(13, p.ws) { PSPIN_T0(14) \
        f32x4 oi[2] = {(f32x4){0.f, 0.f, 0.f, 0.f}, (f32x4){0.f, 0.f, 0.f, 0.f}}; \
        _Pragma("unroll") for (int ks = 0; ks < 4; ++ks) { const bf16x8 bfr = *(const LAS bf16x8*)(SST + (16 * w + lr) * HS_QK + 32 * ks + 8 * lq); \
            _Pragma("unroll") for (int ti = 0; ti < 2; ++ti) { const bf16x8 afr = *(const LAS bf16x8*)(QH + (16 * ti + lr) * HS_QK + 32 * ks + 8 * lq); oi[ti] = MFMA16B(afr, bfr, oi[ti]); } } \
        if (w < 3) { const int ti = (w + 1) >> 1, si = w >> 1; \
            f32x4 sc = (f32x4){0.f, 0.f, 0.f, 0.f}; \
            _Pragma("unroll") for (int ks = 0; ks < 4; ++ks) { const bf16x8 afr = *(const LAS bf16x8*)(QH + (16 * ti + lr) * HS_QK + 32 * ks + 8 * lq), bfr = *(const LAS bf16x8*)(KH + (16 * si + lr) * HS_QK + 32 * ks + 8 * lq); \
                sc = MFMA16B(afr, bfr, sc); } \
            _Pragma("unroll") for (int i = 0; i < 4; ++i) { const int t = 16 * ti + 4 * lq + i, s_ = 16 * si + lr; PP[t * HS_T + s_] = (bf16)(s_ <= t ? sc[i] : 0.f); } \
        } else if (w == 3) { \
            _Pragma("unroll") for (int i = 0; i < 4; ++i) PP[(4 * lq + i) * HS_T + 16 + lr] = (bf16)0.f; \
        } \
        { const bf16x8 afr = *(const LAS bf16x8*)(KHT + (16 * w + lr) * HS_T + 8 * lq); \
          _Pragma("unroll") for (int vt = 0; vt < 8; ++vt) { const bf16x8 bfr = *(const LAS bf16x8*)(VT + (16 * vt + lr) * HS_T + 8 * lq); S[vt] = MFMA16B(afr, bfr, S[vt]); } } \
        if ((c) + 1 < NC) { HG_IMAGES(SN_, st ^ 1, ebl); HG_LOAD(SN_, (c) + 2); }        \
        __syncthreads(); PSPIN_T1(14, p.ws) { PSPIN_T0(15) \
        { const bf16x8 bfr = *(const LAS bf16x8*)(VT + (16 * w + lr) * HS_T + 8 * lq); \
          _Pragma("unroll") for (int ti = 0; ti < 2; ++ti) { const bf16x8 afr = *(const LAS bf16x8*)(PP + (16 * ti + lr) * HS_T + 8 * lq); oi[ti] = MFMA16B(afr, bfr, oi[ti]); } } \
        { const int rlo = dir ? row0 + T - 32 * (c) - 32 : row0 + 32 * (c); char* ob = (char*)O + (size_t)rlo * W * 2; \
          _Pragma("unroll") for (int ti = 0; ti < 2; ++ti) \
            _Pragma("unroll") for (int i = 0; i < 4; ++i) *(h16*)(ob + sgn * (16 * ti + i) * (long)(W * 2) + voffo) = (h16)oi[ti][i]; } \
        PSPIN_T1(15, p.ws) } } \
    } while (0)
    float ebl;
    HG_LOAD(X, 0); HG_IMAGES(X, 0, ebl); HG_LOAD(X, 1);
    for (int c = 0; c < NC; ++c) { HG_CHUNK(c, X); }
#undef HG_LOAD
#undef HG_IMAGES
#undef HG_CHUNK
    if (!smp) { float* so = p.out + O_SH + ((((size_t)b * DEPTH + l) * 2 + dir) * HGH + h) * 128 * 128;
#pragma unroll
        for (int vt = 0; vt < 8; ++vt)
#pragma unroll
            for (int i = 0; i < 4; ++i) so[(size_t)(16 * w + 4 * lq + i) * 128 + 16 * vt + lr] = S[vt][i]; }
    __syncthreads();
}
template <int PARTS> __device__ __forceinline__ void phase_scans(const Params& p, int l, LAS unsigned char* lds) {
    int tid_ = threadIdx.x; LAUNDER(tid_);
    const int lane = tid_ & 63, gw = blockIdx.x * NWAVES + (tid_ >> 6), nw = gridDim.x * NWAVES;
    { PSPIN_T0(10)
    if (PARTS & 1) {
        const int G = gridDim.x, bid = blockIdx.x;
        constexpr int NL = DBATCH * HGH * 2, NS = BATCH * HGH * 2, NWG1 = (M / 256) * (INC / 256);
        const int R1 = NWG1 / G > 0 ? NWG1 / G : 1, left = NWG1 - R1 * G;
        {
            pg8::Gemm g{(const h16*)(p.ws + WS_H), (const h16*)(p.ws + WS_WIN) + (size_t)l * INC * D, 0, 0, M, INC, D, D, D};
            pg8::LeftoverUnit S; S.init(M, INC, G, bid);
            EpiIn E{(h16*)(p.ws + WS_Z), (float*)(p.ws + WS_LOGF), (const float*)(p.ws + WS_LB) + (size_t)l * W, (h16*)(p.ws + WS_A3)};
            pg8::gemm_phase<EpiIn, pg8::LeftoverUnit>(lds, g, S, E);
            __syncthreads();
        }
        for (int it = bid; it < NL; it += G) hgrn_item(p, l, it / (HGH * 2), (it >> 1) % HGH, it & 1, lds);
        if (NL < G && left == G - NL && NS >= G) {
            constexpr int PER = NS / (NL > 0 ? NL : 1);
            const int NS_A = (PER - 2) / 2 > 0 ? (PER - 2) / 2 : 0, NS_B = PER - NS_A;
            if (bid < NL) { for (int k = 0; k < NS_A; ++k) { const int it = bid * NS_A + k; hgrn_item(p, l, DBATCH + it / (HGH * 2), (it >> 1) % HGH, it & 1, lds); } }
            else { for (int k = 0; k < NS_B; ++k) { const int it = NL * NS_A + (bid - NL) * NS_B + k; if (it < NS) hgrn_item(p, l, DBATCH + it / (HGH * 2), (it >> 1) % HGH, it & 1, lds); } }
        }
        else if (NL < G) { if (bid >= NL) for (int it = bid - NL; it < NS; it += G - NL) hgrn_item(p, l, DBATCH + it / (HGH * 2), (it >> 1) % HGH, it & 1, lds); }
        else { for (int it = bid; it < NS; it += G) hgrn_item(p, l, DBATCH + it / (HGH * 2), (it >> 1) % HGH, it & 1, lds); }
    }
    PSPIN_T1(10, p.ws) }
    { PSPIN_T0(11)
    if (PARTS & 2) {
        __syncthreads();
        pg8::Gemm gm{(const h16*)(p.ws + WS_A3), (const h16*)(p.ws + WS_S5BG) + (size_t)l * S5G * 256 * 256, (size_t)NBLK_P * 512, (size_t)256 * 256, NBLK_P, 256, 256, 512, 256};
        pg8::GroupOrder S; S.init((int)gridDim.x, (int)blockIdx.x);
        EpiS5P E{(float*)(p.ws + WS_PB)};
        pg8::gemm_phase<EpiS5P, pg8::GroupOrder>(lds, gm, S, E);
    }
    PSPIN_T1(11, p.ws) }
    { PSPIN_T0(12)
    if (PARTS & 4) { __syncthreads(); for (int t = blockIdx.x; t < M / 64 + DBATCH * PAST / 64; t += gridDim.x) prep_tile(p, l, t, lds); }
    PSPIN_T1(12, p.ws) }
}

__device__ __forceinline__ int crow(int r, int hi) { return (r & 3) + 8 * (r >> 2) + 4 * hi; }
constexpr int AT_K = 0, AT_V = 32768, AT_OS = 136, AT_WS = 8 * 32 * AT_OS * 2;
__device__ __forceinline__ void attn_unit(const h16* Qb, const h16* Kb, const h16* VTb, int NK, const h16* Gb, h16* Ob, LAS unsigned char* lds, unsigned char* PS_WS) {
    int tid = threadIdx.x; LAUNDER(tid);
    const int wid = tid >> 6, lane = tid & 63, r32 = lane & 31, hi = lane >> 5;
    LAS float* wsf = (LAS float*)(lds + AT_WS) + wid * 64; LAS float* al_l = wsf; LAS float* li_l = wsf + 32;
    constexpr float C = 1.4426950408889634f;
    float m_reg = -1e30f, l_reg = 0.f;
    f32x16 o[4];
#pragma unroll
    for (int d = 0; d < 4; ++d)
#pragma unroll
        for (int r = 0; r < 16; ++r) o[d][r] = 0.f;
    h16x8 qr[8];
    { const h16* Qw = Qb + (size_t)(wid * 32 + r32) * W + hi * 8;
#pragma unroll
      for (int d0 = 0; d0 < 8; ++d0) qr[d0] = *(const h16x8*)(Qw + d0 * 16); }
    const int kr_ = tid >> 4, kc_ = tid & 15, vr_ = tid >> 3, vc_ = tid & 7;
    const int kst0 = kr_ * 256 + ((kc_ * 16) ^ ((kr_ & 15) << 4)), kst1 = (kr_ + 32) * 256 + ((kc_ * 16) ^ (((kr_ + 32) & 15) << 4));
    const int vst0 = vr_ * 128 + ((vc_ * 16) ^ (((vr_ >> 1) & 7) << 4)), vst1 = (vr_ + 64) * 128 + ((vc_ * 16) ^ ((((vr_ + 64) >> 1) & 7) << 4));
    const h16* kg0 = Kb + (size_t)kr_ * KVW + kc_ * 8; const h16* kg1 = Kb + (size_t)(kr_ + 32) * KVW + kc_ * 8;
    const h16* vg0 = VTb + (size_t)vr_ * NK + vc_ * 8; const h16* vg1 = VTb + (size_t)(vr_ + 64) * NK + vc_ * 8;
    const int NT = NK / 64;
    h16x8 kaA = *(const h16x8*)kg0, kbA = *(const h16x8*)kg1, vaA = *(const h16x8*)vg0, vbA = *(const h16x8*)vg1;
    *(LAS h16x8*)(lds + AT_K + kst0) = kaA; *(LAS h16x8*)(lds + AT_K + kst1) = kbA; *(LAS h16x8*)(lds + AT_V + vst0) = vaA; *(LAS h16x8*)(lds + AT_V + vst1) = vbA;
    h16x8 kaB, kbB, vaB, vbB;
#define AT_GLOAD(S, t) do { ka##S = *(const h16x8*)(kg0 + (size_t)(t) * 64 * KVW); kb##S = *(const h16x8*)(kg1 + (size_t)(t) * 64 * KVW); va##S = *(const h16x8*)(vg0 + (t) * 64); vb##S = *(const h16x8*)(vg1 + (t) * 64); } while (0)
#define AT_LWRITE(S, nb) do { *(LAS h16x8*)(lds + AT_K + (nb) + kst0) = ka##S; *(LAS h16x8*)(lds + AT_K + (nb) + kst1) = kb##S; *(LAS h16x8*)(lds + AT_V + (nb) + vst0) = va##S; *(LAS h16x8*)(lds + AT_V + (nb) + vst1) = vb##S; } while (0)
    AT_GLOAD(A, 1); AT_GLOAD(B, (2 < NT ? 2 : 1));
    __syncthreads();
    PSPIN_T0(1)
#define AT_TILE(j, S) do { \
        const int buf = (j) & 1; \
        const LAS unsigned char* Kl = lds + AT_K + buf * 16384; const LAS unsigned char* Vl = lds + AT_V + buf * 16384; \
        f32x16 p0, p1; \
        _Pragma("unroll") for (int r = 0; r < 16; ++r) { p0[r] = 0.f; p1[r] = 0.f; } \
        _Pragma("unroll") for (int d0 = 0; d0 < 8; ++d0) { const int cb = (d0 * 16 + hi * 8) * 2; \
            const h16x8 b0 = *(const LAS h16x8*)(Kl + r32 * 256 + (cb ^ ((r32 & 15) << 4))); \
            const h16x8 b1 = *(const LAS h16x8*)(Kl + (32 + r32) * 256 + (cb ^ ((r32 & 15) << 4))); \
            p0 = MFMA32(b0, qr[d0], p0); p1 = MFMA32(b1, qr[d0], p1); } \
        float pmax = p0[0]; \
        _Pragma("unroll") for (int r = 1; r < 16; ++r) pmax = fmaxf(pmax, p0[r]); \
        _Pragma("unroll") for (int r = 0; r < 16; ++r) pmax = fmaxf(pmax, p1[r]); \
        { unsigned ra, rb; permlane32_swap_u(__builtin_bit_cast(unsigned, pmax), __builtin_bit_cast(unsigned, pmax), ra, rb); pmax = fmaxf(__builtin_bit_cast(float, ra), __builtin_bit_cast(float, rb)); } \
        const bool keep = WAVE_ALL(pmax - m_reg <= 8.0f);             \
        const float mn = keep ? m_reg : fmaxf(m_reg, pmax), alpha = keep ? 1.0f : EXP2F((m_reg - mn) * C), mnC = -mn * C; m_reg = mn; \
        float ps = 0.f; \
        _Pragma("unroll") for (int r = 0; r < 16; ++r) { p0[r] = EXP2F(fmaf(p0[r], C, mnC)); p1[r] = EXP2F(fmaf(p1[r], C, mnC)); ps += p0[r] + p1[r]; } \
        { unsigned ra, rb; permlane32_swap_u(__builtin_bit_cast(unsigned, ps), __builtin_bit_cast(unsigned, ps), ra, rb); ps = __builtin_bit_cast(float, ra) + __builtin_bit_cast(float, rb); } \
        l_reg = l_reg * alpha + ps; \
        if (!keep) { if (hi == 0) al_l[r32] = alpha; \
        WAVE_LDS_SYNC(); \
        _Pragma("unroll") for (int r = 0; r < 16; ++r) { const float a = al_l[crow(r, hi)]; \
            _Pragma("unroll") for (int d = 0; d < 4; ++d) o[d][r] *= a; } \
        WAVE_LDS_SYNC(); } \
        h16x8 pa[4]; \
        PK4(p0, 0, pa[0]); PK4(p0, 8, pa[1]); PK4(p1, 0, pa[2]); PK4(p1, 8, pa[3]); \
        _Pragma("unroll") for (int d0 = 0; d0 < 4; ++d0) { const int vrow = d0 * 32 + r32; \
            _Pragma("unroll") for (int ks = 0; ks < 4; ++ks) { const int cb = (ks * 16 + hi * 8) * 2; \
                const h16x8 vf = *(const LAS h16x8*)(Vl + vrow * 128 + (cb ^ (((vrow >> 1) & 7) << 4))); \
                o[d0] = MFMA32(pa[ks], vf, o[d0]); } } \
        if ((j) + 1 < NT) AT_LWRITE(S, (buf ^ 1) * 16384); \
        if ((j) + 3 < NT) AT_GLOAD(S, (j) + 3); \
        __syncthreads(); \
    } while (0)
#define PK4(P, BASE, OUT) do { const unsigned a0 = cvtpk_h(P[BASE + 0], P[BASE + 1]), a1 = cvtpk_h(P[BASE + 2], P[BASE + 3]), b0_ = cvtpk_h(P[BASE + 4], P[BASE + 5]), b1_ = cvtpk_h(P[BASE + 6], P[BASE + 7]); \
        unsigned r00, r01, r10, r11; permlane32_swap_u(a0, b0_, r00, r01); permlane32_swap_u(a1, b1_, r10, r11); u32x4 w_ = {r00, r10, r01, r11}; OUT = __builtin_bit_cast(h16x8, w_); } while (0)
    for (int j = 0; j < NT; j += 2) { AT_TILE(j, A); AT_TILE(j + 1, B); }
#undef PK4
#undef AT_TILE
#undef AT_GLOAD
#undef AT_LWRITE
    PSPIN_T1(1, PS_WS)
    if (hi == 0) li_l[r32] = l_reg;
    WAVE_LDS_SYNC();
    LAS h16* OT = (LAS h16*)(lds + wid * (32 * AT_OS * 2));
#pragma unroll
    for (int r = 0; r < 16; ++r) { const float rl = RCPF(li_l[crow(r, hi)]);
#pragma unroll
        for (int d0 = 0; d0 < 4; ++d0) OT[crow(r, hi) * AT_OS + d0 * 32 + r32] = (h16)(o[d0][r] * rl); }
    WAVE_LDS_SYNC();
#pragma unroll
    for (int k = 0; k < 8; ++k) { const int ch = lane + 64 * k, row = ch >> 4, c = ch & 15; const int orow = wid * 32 + row;
        const h16x8 v = *(const LAS h16x8*)(OT + row * AT_OS + c * 8), g = *(const h16x8*)(Gb + (size_t)orow * INC + c * 8);
        h16x8 ov;
#pragma unroll
        for (int j = 0; j < 8; ++j) ov[j] = (h16)((float)v[j] * (float)g[j]);
        *(h16x8*)(Ob + (size_t)orow * W + c * 8) = ov; }
    __syncthreads();
}
constexpr int HGP_N = 8;
__device__ __forceinline__ void d_hgpost4(const Params& p, int l, int grp0, int stride, int ngroups, int lane) {
    const h16* OF = (const h16*)(p.ws + WS_OF); const h16* OB = (const h16*)(p.ws + WS_OB); const h16* Z = (const h16*)(p.ws + WS_Z);
    const int c8 = (lane & 15) * 8, sub = lane >> 4;
    const float* wn = p.in[I_ONORM] + (size_t)l * 128 + c8; const f32x4 w0 = *(const f32x4*)wn, w1 = *(const f32x4*)(wn + 4);
    h16x8 of[HGP_N], ob[HGP_N], gz[HGP_N];
#pragma unroll
    for (int k = 0; k < HGP_N; ++k) { const int grp = grp0 + k * stride; const int item = grp * 4 + sub; const int row = item / HGH, h = item % HGH;
        if (grp < ngroups) { const size_t o0 = (size_t)row * W + h * 128 + c8; of[k] = *(const h16x8*)(OF + o0); ob[k] = *(const h16x8*)(OB + o0); gz[k] = *(const h16x8*)(Z + (size_t)row * INC + C_HGG + h * 128 + c8); } }
#pragma unroll
    for (int k = 0; k < HGP_N; ++k) { const int grp = grp0 + k * stride; if (grp >= ngroups) continue; const int item = grp * 4 + sub; const int row = item / HGH, h = item % HGH;
        float a[8]; float ss = 0.f;
#pragma unroll
        for (int j = 0; j < 8; ++j) { a[j] = (float)of[k][j] + (float)ob[k][j]; ss += a[j] * a[j]; }
        ss += shfl_xor_l(ss, 8, lane); ss += shfl_xor_l(ss, 4, lane); ss += shfl_xor_l(ss, 2, lane); ss += shfl_xor_l(ss, 1, lane);
        const float rstd = rsqrtf(ss * (1.0f / 128.0f) + EPS);
        h16x8 o;
#pragma unroll
        for (int j = 0; j < 4; ++j) { o[j] = (h16)(a[j] * rstd * w0[j] * (float)gz[k][j]); o[4 + j] = (h16)(a[4 + j] * rstd * w1[j] * (float)gz[k][4 + j]); }
        *(h16x8*)((h16*)(p.ws + WS_OHG) + (size_t)row * W + h * 128 + c8) = o; }
}
__device__ __forceinline__ void s5_carry(const Params& p, int l, int tid_) {
    const size_t nth = (size_t)gridDim.x * NTHREADS;
    const float* PB = (const float*)(p.ws + WS_PB); h16* A3 = (h16*)(p.ws + WS_A3);
    for (size_t it = (size_t)blockIdx.x * NTHREADS + tid_; it < (size_t)S5G * (BATCH + DBATCH) * 2 * 64; it += nth) {
        const int pp = (int)(it & 63), dir = (int)(it >> 6) & 1, sq = (int)((it >> 7) % (BATCH + DBATCH)), g = (int)((it >> 7) / (BATCH + DBATCH));
        const bool smp = sq < DBATCH; const int b = smp ? sq : sq - DBATCH; const int T = smp ? DSEQ : SEQ, row0 = smp ? MP + b * DSEQ : b * SEQ, nb = T / 16, blk0 = row0 / 16;
        const f32x2 ab = ((const f32x2*)(p.ws + WS_ABAR))[(((size_t)l * 2 + dir) * S5G + g) * S5P + pp];
        float ar = ab[0], ai = ab[1];
#pragma unroll
        for (int k = 0; k < 4; ++k) { const float nr = ar * ar - ai * ai, t2 = ar * ai; ar = nr; ai = t2 + t2; }
        float sr = 0.f, si = 0.f;
        if (smp) { const size_t si0 = (((size_t)b * DEPTH + l) * 2 + dir) * S5G * S5P + (size_t)g * S5P + pp; sr = p.in[I_SR][si0]; si = p.in[I_SI][si0]; }
        const float* pb = PB + ((size_t)g * NBLK_P + blk0) * 256 + dir * 128 + pp; h16* a3 = A3 + ((size_t)g * NBLK_P + blk0) * 512 + 256 + dir * 128 + pp;
        for (int k0 = 0; k0 < nb; k0 += 8) { float pr[8], pi_[8];
#pragma unroll
            for (int k = 0; k < 8; ++k) { const int bb = dir ? nb - 1 - (k0 + k) : k0 + k; pr[k] = pb[(size_t)bb * 256]; pi_[k] = pb[(size_t)bb * 256 + 64]; }
#pragma unroll
            for (int k = 0; k < 8; ++k) { const int bb = dir ? nb - 1 - (k0 + k) : k0 + k; a3[(size_t)bb * 512] = (h16)sr; a3[(size_t)bb * 512 + 64] = (h16)si;
                const float nr = ar * sr - ai * si + pr[k], ni = ar * si + ai * sr + pi_[k]; sr = nr; si = ni; } }
        if (!smp) { const size_t so = (((size_t)b * DEPTH + l) * 2 + dir) * S5G * S5P + (size_t)g * S5P + pp; p.out[O_SR + so] = sr; p.out[O_SI + so] = si; }
    }
}
template <int PARTS> __device__ __forceinline__ void phase_attn(const Params& p, int l, LAS unsigned char* lds) {
    int tid_ = threadIdx.x; LAUNDER(tid_);
    const int lane = tid_ & 63, gw = blockIdx.x * NWAVES + (tid_ >> 6), nw = gridDim.x * NWAVES;
    constexpr int NU_S = DBATCH * AQH * (DSEQ / 256), NU_C = BATCH * AQH * (SEQ / 256);
    PSPIN_T0(8)
    if (PARTS & 1)
    for (int u = blockIdx.x; u < NU_S + NU_C; u += gridDim.x) {
        const bool smp = u < NU_S; const int uu = smp ? u : u - NU_S;
        const int T = smp ? DSEQ : SEQ, NK = smp ? KVLEN : SEQ;
        const int qb = uu % (T / 256), qh = (uu / (T / 256)) % AQH, b = uu / ((T / 256) * AQH), kh = qh / 4;
        const int row0 = (smp ? MP + b * DSEQ : b * SEQ) + qb * 256;
        const h16* Kb = (smp ? (const h16*)(p.ws + WS_KBS) : (const h16*)(p.ws + WS_KBC)) + (size_t)b * NK * KVW + kh * 128;
        const h16* VTb = (smp ? (const h16*)(p.ws + WS_VBS) : (const h16*)(p.ws + WS_VBC)) + (size_t)(b * AKVH + kh) * 128 * NK;
        attn_unit((const h16*)(p.ws + WS_AQ2) + (size_t)row0 * W + qh * 128, Kb, VTb, NK, (const h16*)(p.ws + WS_Z) + (size_t)row0 * INC + C_AG + qh * 128,
                  (h16*)(p.ws + WS_OAT) + (size_t)row0 * W + qh * 128, lds, p.ws);
    }
    constexpr int N_HP = M * HGH / 4;
    PSPIN_T1(8, p.ws)
    { PSPIN_T0(9)
    if (PARTS & 2)
    for (int it = gw; it < N_HP; it += HGP_N * nw) d_hgpost4(p, l, it, nw, N_HP, lane);
    PSPIN_T1(9, p.ws) }
    if (!(PARTS & 4)) return;
    { PSPIN_T0(7) s5_carry(p, l, tid_); PSPIN_T1(7, p.ws) }
}

constexpr int NPL = 8, PH_FINAL = 1 + DEPTH * NPL, N_PHASES = PH_FINAL + 1;

__global__ void __launch_bounds__(NTHREADS, 2) fwd_kernel(Params p) {
#ifdef HOST_SIM
    unsigned char* lds = sim::cur->blk->lds;
#else
    extern __shared__ __attribute__((aligned(16))) unsigned char lds_raw[];
    LAS unsigned char* lds = (LAS unsigned char*)lds_raw;
#endif
    const int lo = p.ph_lo, hi = p.ph_hi;
#ifndef HOST_SIM
    if (threadIdx.x < 4) ((LAS unsigned*)(lds + MISC_OFF))[threadIdx.x] = 0u;
    __syncthreads();
    XcdBarrier bar; bar.bar = (unsigned*)(p.ws + WS_BAR); bar.x = 0; bar.st = nullptr;
    if (hi - lo > 1) bar = xcd_barrier_post((unsigned*)(p.ws + WS_BAR), (volatile LAS unsigned*)(lds + MISC_OFF));
#else
    XcdBarrier bar{0};
#endif
#define IN(k) (lo <= (k) && (k) < hi)
#define SEAM(k) do { if (IN(k) && IN((k) + 1)) { PSPIN_T0(4) xcd_barrier(bar); PSPIN_T1(4, p.ws) } } while (0)

    unsigned char* ws = p.ws;
    const int G = gridDim.x, bid = blockIdx.x;
    if (IN(0)) { PSPINL_T0(28, lds) phase_prologue(p, lds); PSPINL_T1(28, lds, p.ws) if (PROBE_REP == 0) { xcd_barrier(bar); phase_prologue(p, lds); } } SEAM(0);
    for (int l = 0; l < DEPTH; ++l) {
        const int pb = 1 + l * NPL;
        if (IN(pb + 0)) { PSPINL_T0(20, lds) phase_norm(p, l); PSPINL_T1(20, lds, p.ws) if (PROBE_REP == 8) { xcd_barrier(bar); phase_norm(p, l); } } SEAM(pb + 0);
        if (IN(pb + 1)) {
            pg8::Gemm g{(const h16*)(ws + WS_H), (const h16*)(ws + WS_WIN) + (size_t)l * INC * D, 0, 0, M, INC, D, D, D};
            pg8::WholeRounds S; S.init(M, INC, G, bid);
            EpiIn E{(h16*)(ws + WS_Z), (float*)(ws + WS_LOGF), (const float*)(ws + WS_LB) + (size_t)l * W, (h16*)(ws + WS_A3)};
            PSPINL_T0(21, lds) pg8::gemm_phase<EpiIn, pg8::WholeRounds>(lds, g, S, E); PSPINL_T1(21, lds, p.ws)
            if (PROBE_REP == 1) { xcd_barrier(bar); pg8::gemm_phase<EpiIn, pg8::WholeRounds>(lds, g, S, E); }
        } SEAM(pb + 1);
        if (IN(pb + 2)) { PSPINL_T0(22, lds) phase_scans<7>(p, l, lds); PSPINL_T1(22, lds, p.ws) if (PROBE_REP == 2) { xcd_barrier(bar); phase_scans<7>(p, l, lds); } if (PROBE_REP == 21) { xcd_barrier(bar); phase_scans<1>(p, l, lds); } if (PROBE_REP == 22) { xcd_barrier(bar); phase_scans<2>(p, l, lds); } if (PROBE_REP == 23) { xcd_barrier(bar); phase_scans<4>(p, l, lds); } } SEAM(pb + 2);
        if (IN(pb + 3)) { PSPINL_T0(23, lds) phase_attn<7>(p, l, lds); PSPINL_T1(23, lds, p.ws) if (PROBE_REP == 3) { xcd_barrier(bar); phase_attn<7>(p, l, lds); } if (PROBE_REP == 31) { xcd_barrier(bar); phase_attn<1>(p, l, lds); } if (PROBE_REP == 32) { xcd_barrier(bar); phase_attn<2>(p, l, lds); } if (PROBE_REP == 33) { xcd_barrier(bar); phase_attn<4>(p, l, lds); } } SEAM(pb + 3);
        if (IN(pb + 4)) {
            pg8::Gemm g{(const h16*)(ws + WS_A3), (const h16*)(ws + WS_S5BY) + (size_t)l * S5G * 256 * 512, (size_t)NBLK_P * 512, (size_t)256 * 512, NBLK_P, 256, 512, 512, 512};
            pg8::GroupOrder S; S.init(G, bid);
            EpiS5Y E{(h16*)(ws + WS_YS)};
            PSPINL_T0(24, lds) pg8::gemm_phase<EpiS5Y, pg8::GroupOrder>(lds, g, S, E); PSPINL_T1(24, lds, p.ws)
            if (PROBE_REP == 4) { xcd_barrier(bar); pg8::gemm_phase<EpiS5Y, pg8::GroupOrder>(lds, g, S, E); }
        } SEAM(pb + 4);
        if (IN(pb + 5)) {
            pg8::Gemm g{(const h16*)(ws + WS_YS), (const h16*)(ws + WS_WGLU) + (size_t)l * W * W, 0, 0, M, W, W, W, W};
            pg8::StaticOrder S; S.init(M, W, G, bid);
            EpiGlu E{(const h16*)(ws + WS_YS), (const h16*)(ws + WS_Z), (h16*)(ws + WS_OS5)};
            PSPINL_T0(25, lds) pg8::gemm_phase<EpiGlu, pg8::StaticOrder>(lds, g, S, E); PSPINL_T1(25, lds, p.ws)
            if (PROBE_REP == 6) { xcd_barrier(bar); pg8::gemm_phase<EpiGlu, pg8::StaticOrder>(lds, g, S, E); }
        } SEAM(pb + 5);
        if (IN(pb + 6)) {
            const h16* wbr = (const h16*)(ws + WS_WBR) + (size_t)l * 3 * D * W;
            pg8::Gemm g{(const h16*)(ws + WS_OHG), wbr, (size_t)M * W, (size_t)D * W, M, D, W, W, W};
            pg8::MultiOrder<3> S; S.init(M, D, G, bid);
            EpiBr E{(const h16*)(ws + WS_Z), (h16*)(ws + WS_MG)};
            PSPINL_T0(26, lds) pg8::gemm_phase<EpiBr, pg8::MultiOrder<3>>(lds, g, S, E); PSPINL_T1(26, lds, p.ws)
            if (PROBE_REP == 5) { xcd_barrier(bar); pg8::gemm_phase<EpiBr, pg8::MultiOrder<3>>(lds, g, S, E); }
        } SEAM(pb + 6);
        if (IN(pb + 7)) {
            pg8::Gemm g{(const h16*)(ws + WS_MG), (const h16*)(ws + WS_WOUT) + (size_t)l * D * D, 0, 0, M, D, D, D, D};
            pg8::StaticOrder S; S.init(M, D, G, bid);
            EpiOut E{p.in[I_XP], p.in[I_XS], (h16*)(ws + WS_X), (const float*)(ws + WS_MOD) + (size_t)l * NMODR * 3 * D, l == 0};
            PSPINL_T0(27, lds) pg8::gemm_phase<EpiOut, pg8::StaticOrder>(lds, g, S, E); PSPINL_T1(27, lds, p.ws)
            if (PROBE_REP == 7 && l == 0) { xcd_barrier(bar); pg8::gemm_phase<EpiOut, pg8::StaticOrder>(lds, g, S, E); xcd_barrier(bar); pg8::gemm_phase<EpiOut, pg8::StaticOrder>(lds, g, S, E); xcd_barrier(bar); pg8::gemm_phase<EpiOut, pg8::StaticOrder>(lds, g, S, E); xcd_barrier(bar); pg8::gemm_phase<EpiOut, pg8::StaticOrder>(lds, g, S, E); }
        } SEAM(pb + 7);
    }
    if (IN(PH_FINAL)) { phase_final(p); }
#if !defined(HOST_SIM) && PROBE_SPIN
    if (blockIdx.x == PROBE_BLK && threadIdx.x == 0) { const unsigned T = __hip_atomic_load((unsigned*)p.ws + 64, __ATOMIC_RELAXED, __HIP_MEMORY_SCOPE_AGENT); const unsigned long long t0 = __builtin_amdgcn_s_memrealtime(); while (__builtin_amdgcn_s_memrealtime() - t0 < (unsigned long long)T) __builtin_amdgcn_s_sleep(8); }
#endif
#undef IN
#undef SEAM
}

#ifndef HOST_SIM
extern "C" void kernel_launch(void* const* d_in, const int* in_sizes, int n_in, void* d_out, int out_size, void* d_ws, size_t ws_size, hipStream_t stream) {
    static int grid = 0;
    if (grid == 0) {
        if (n_in != N_IN || (size_t)out_size != O_END || ws_size < WS_END) { grid = -1; return; }
        int dev = 0, cus = 0;
        if (hipGetDevice(&dev) != hipSuccess || hipDeviceGetAttribute(&cus, hipDeviceAttributeMultiprocessorCount, dev) != hipSuccess) { grid = -1; return; }
        if (hipFuncSetAttribute((const void*)fwd_kernel, hipFuncAttributeMaxDynamicSharedMemorySize, LDS_BYTES) != hipSuccess) { grid = -1; return; }
        int per_cu = 0; (void)hipOccupancyMaxActiveBlocksPerMultiprocessor(&per_cu, (const void*)fwd_kernel, NTHREADS, LDS_BYTES); (void)hipGetLastError();
        grid = cus;
    }
    if (grid < 0) return;
    (void)hipMemsetAsync((char*)d_ws + WS_BAR, 0, 16384, stream);
    Params p{};
    for (int i = 0; i < N_IN; ++i) p.in[i] = (const float*)d_in[i];
    p.out = (float*)d_out; p.ws = (unsigned char*)d_ws;
#if N_LAUNCH_MODE == 1
    p.ph_lo = 0; p.ph_hi = N_PHASES;
    hipLaunchKernelGGL(fwd_kernel, dim3(grid), dim3(NTHREADS), LDS_BYTES, stream, p);
#else
    for (int k = 0; k < N_PHASES; ++k) { p.ph_lo = k; p.ph_hi = k + 1; hipLaunchKernelGGL(fwd_kernel, dim3(grid), dim3(NTHREADS), LDS_BYTES, stream, p); }
#endif
}
#endif
```

```cpp
#ifndef HOST_SIM
#include <hip/hip_runtime.h>
#endif

#ifndef CFG_D
#define CFG_D 2048
#define CFG_BATCH 32
#define CFG_SEQ 256
#define CFG_DEPTH 4
#define CFG_DBATCH 8
#define CFG_DSEQ 1024
#define CFG_PAST 256
#endif
#ifndef PROBE_REP
#define PROBE_REP -1
#endif
#ifndef PROBE_SPIN
#define PROBE_SPIN 0
#endif
#ifndef PROBE_BLK
#define PROBE_BLK 0
#endif
#ifndef N_LAUNCH_MODE
#define N_LAUNCH_MODE 1
#endif

constexpr int D = CFG_D, BATCH = CFG_BATCH, SEQ = CFG_SEQ, DEPTH = CFG_DEPTH, DBATCH = CFG_DBATCH, DSEQ = CFG_DSEQ, PAST = CFG_PAST;
constexpr int W = D / 2;
constexpr int HGH = W / 128;
constexpr int AQH = W / 128, AKVH = AQH / 4, KVW = AKVH * 128;
constexpr int S5G = W / 16, S5P = 64;
constexpr int C_HQ = 0, C_HI = W, C_FF = 2 * W, C_FB = 3 * W, C_HGG = 4 * W, C_AQ = 5 * W, C_AK = 6 * W, C_AV = 6 * W + KVW, C_AG = 6 * W + 2 * KVW,
              C_SU = 7 * W + 2 * KVW, C_SG = 8 * W + 2 * KVW, C_MG = 9 * W + 2 * KVW, INC = C_MG + 3 * D;
constexpr int MP = BATCH * SEQ, MS = DBATCH * DSEQ, M = MP + MS;
constexpr int KVLEN = PAST + DSEQ;
constexpr int NMODR = 1 + DBATCH;
constexpr float EPS = 1e-6f;
constexpr int ZLD = INC;
static_assert(INC % 256 == 0 && MP % 256 == 0 && MS % 256 == 0 && W % 256 == 0, "tile shapes");

typedef _Float16 h16;
typedef h16 h16x8 __attribute__((ext_vector_type(8)));
typedef h16 h16x4 __attribute__((ext_vector_type(4)));
typedef h16 h16x2 __attribute__((ext_vector_type(2)));
typedef float f32x4 __attribute__((ext_vector_type(4)));
typedef __bf16 bf16;
typedef bf16 bf16x8 __attribute__((ext_vector_type(8)));
typedef bf16 bf16x4 __attribute__((ext_vector_type(4)));
typedef float f32x2 __attribute__((ext_vector_type(2)));
typedef float f32x16 __attribute__((ext_vector_type(16)));
typedef unsigned u32x4 __attribute__((ext_vector_type(4)));

constexpr size_t al256(size_t x) { return (x + 255) & ~(size_t)255; }
constexpr size_t WS_BAR = 0;
constexpr size_t WS_MOD = 16384;
constexpr size_t WS_LB = al256(WS_MOD + (size_t)DEPTH * NMODR * 3 * D * 4);
constexpr size_t WS_ABAR = al256(WS_LB + (size_t)2 * DEPTH * W * 4);
constexpr size_t WS_BBAR = al256(WS_ABAR + (size_t)DEPTH * 2 * S5G * S5P * 8);
constexpr size_t WS_S5T = al256(WS_BBAR + (size_t)DEPTH * 2 * S5G * S5P * 32 * 4);
constexpr size_t WS_S5C = al256(WS_S5T + (size_t)DEPTH * 2 * S5G * 256 * 48);
constexpr int NBLK = M / 16, NBLK_P = (NBLK + 255) / 256 * 256;
constexpr size_t WS_S5BY = al256(WS_S5C + (size_t)DEPTH * S5G * 256 * 16);
constexpr size_t WS_S5BG = al256(WS_S5BY + (size_t)DEPTH * S5G * 256 * 512 * 2);
constexpr size_t WS_A3 = al256(WS_S5BG + (size_t)DEPTH * S5G * 256 * 256 * 2);
constexpr size_t WS_PB = al256(WS_A3 + (size_t)S5G * NBLK_P * 512 * 2);
constexpr size_t WS_ROPE = al256(WS_PB + (size_t)S5G * NBLK_P * 256 * 4);
constexpr size_t WS_WIN = al256(WS_ROPE + (size_t)(DSEQ / 64 + 64) * 32 * 8);
constexpr size_t WS_WGLU = al256(WS_WIN + (size_t)DEPTH * INC * D * 2);
constexpr size_t WS_WBR = al256(WS_WGLU + (size_t)DEPTH * W * W * 2);
constexpr size_t WS_WOUT = al256(WS_WBR + (size_t)DEPTH * 3 * D * W * 2);
constexpr size_t WS_X = al256(WS_WOUT + (size_t)DEPTH * D * D * 2);
constexpr size_t WS_H = al256(WS_X + (size_t)M * D * 4);
constexpr size_t WS_Z = al256(WS_H + (size_t)M * D * 2);
constexpr size_t WS_LOGF = al256(WS_Z + (size_t)M * INC * 2);
constexpr size_t WS_AQ2 = al256(WS_LOGF + (size_t)M * 2 * W * 4);
constexpr size_t WS_KBC = al256(WS_AQ2 + (size_t)M * W * 2);
constexpr size_t WS_VBC = al256(WS_KBC + (size_t)MP * KVW * 2);
constexpr size_t WS_KBS = al256(WS_VBC + (size_t)MP * KVW * 2);
constexpr size_t WS_VBS = al256(WS_KBS + (size_t)DBATCH * KVLEN * KVW * 2);
constexpr size_t WS_OF = al256(WS_VBS + (size_t)DBATCH * KVLEN * KVW * 2);
constexpr size_t WS_OB = al256(WS_OF + (size_t)M * W * 4);
constexpr size_t WS_YF = al256(WS_OB + (size_t)M * W * 4);
constexpr size_t WS_YB = al256(WS_YF + (size_t)M * W * 4);
constexpr size_t WS_OHG = al256(WS_YB + (size_t)M * W * 4);
constexpr size_t WS_OAT = al256(WS_OHG + (size_t)M * W * 2);
constexpr size_t WS_OS5 = al256(WS_OAT + (size_t)M * W * 2);
constexpr size_t WS_YS = al256(WS_OS5 + (size_t)M * W * 2);
constexpr size_t WS_MG = al256(WS_YS + (size_t)M * W * 2);
static_assert(WS_OAT - WS_OHG == (size_t)M * W * 2 && WS_OS5 - WS_OAT == (size_t)M * W * 2, "branch operands must be equally spaced");
constexpr size_t WS_END = al256(WS_MG + (size_t)M * D * 2);

constexpr size_t O_Y = 0;
constexpr size_t O_CK = (size_t)M * D;
constexpr size_t O_CV = O_CK + (size_t)BATCH * DEPTH * SEQ * KVW;
constexpr size_t O_SH = O_CV + (size_t)BATCH * DEPTH * SEQ * KVW;
constexpr size_t O_SR = O_SH + (size_t)BATCH * DEPTH * 2 * HGH * 128 * 128;
constexpr size_t O_SI = O_SR + (size_t)BATCH * DEPTH * 2 * S5G * S5P;
constexpr size_t O_END = O_SI + (size_t)BATCH * DEPTH * 2 * S5G * S5P;

enum { I_XP = 0, I_XS, I_CK, I_CV, I_SH, I_SR, I_SI, I_C, I_CCTX, I_NORMW, I_WMOD, I_BMOD, I_WIN, I_LBL, I_ONORM, I_QNORM, I_KNORM,
       I_ARE, I_AIM, I_LDT, I_BRE, I_BIM, I_CRE, I_CIM, I_S5D, I_WGLU, I_WBRHG, I_WBRAT, I_WBRS5, I_WOUT, I_FNORM, N_IN };

struct Params { const float* in[N_IN]; float* out; unsigned char* ws; int ph_lo, ph_hi; };

constexpr int NTHREADS = 512, NWAVES = 8;
constexpr int STAGE_BYTES = 131072, LDS_BYTES = 147456, MISC_OFF = LDS_BYTES - 64;

#ifdef HOST_SIM
#define LAS
static inline void sim_glds16(const void* g, void* l) { memcpy((char*)l + sim::cur->lane * 16, g, 16); }
#define GLDS16(g, l) sim_glds16((const void*)(g), (void*)(l))
#define WAIT_V(n) ((void)0)
#define WAIT_L(n) ((void)0)
#define SBAR sim::block_sync()
#define SCHED ((void)0)
#define SETPRIO(x) ((void)0)
#define CFENCE ((void)0)
#define LAUNDER(x) ((void)0)
#define NT_STORE(v, p) (*(p) = (v))
#define PIN4(a, b, c, d) ((void)0)
#define MFMA16(a, b, c) sim::mfma16<1>(&(a), &(b), c)
#define MFMA16K16(a, b, c) sim::mfma16k16_f16(&(a), &(b), c)
static inline float readlane_f(float v, int l) { return sim::shfl<float>(v, l); }
#else
#define LAS __attribute__((address_space(3)))
#define GLDS16(g, l) __builtin_amdgcn_global_load_lds((const unsigned*)(g), (LAS unsigned*)(l), 16, 0, 0)
#define WAIT_V(n) asm volatile("s_waitcnt vmcnt(" #n ")" ::: "memory")
#define WAIT_L(n) asm volatile("s_waitcnt lgkmcnt(" #n ")" ::: "memory")
#define SBAR __builtin_amdgcn_s_barrier()
#define SCHED __builtin_amdgcn_sched_barrier(0)
#define SETPRIO(x) __builtin_amdgcn_s_setprio(x)
#define CFENCE asm volatile("" ::: "memory")
#define LAUNDER(x) asm volatile("" : "+v"(x))
#define NT_STORE(v, p) __builtin_nontemporal_store(v, p)
#define PIN4(a, b, c, d) asm volatile("" : "+v"(a), "+v"(b), "+v"(c), "+v"(d) :: "memory")
#define MFMA16(a, b, c) __builtin_amdgcn_mfma_f32_16x16x32_f16(a, b, c, 0, 0, 0)
#define MFMA16K16(a, b, c) __builtin_amdgcn_mfma_f32_16x16x16f16(a, b, c, 0, 0, 0)
__device__ __forceinline__ float readlane_f(float v, int l) { return __builtin_bit_cast(float, __builtin_amdgcn_readlane(__builtin_bit_cast(int, v), l)); }
#endif

#ifdef HOST_SIM
#define MFMA32(a, b, c) sim::mfma32<1>(&(a), &(b), c)
#define WAVE_LDS_SYNC() sim::wave_sync()
#define WAVE_ALL(p) sim_wave_all(p)
#define EXP2F(x) exp2f(x)
#define RCPF(x) (1.0f / (x))
#define LOG2F(x) log2f(x)
static inline void permlane32_swap_u(unsigned a, unsigned b, unsigned& ra, unsigned& rb) { sim_permlane32_swap(a, b, ra, rb); }
#else
#define MFMA32(a, b, c) __builtin_amdgcn_mfma_f32_32x32x16_f16(a, b, c, 0, 0, 0)
#define WAVE_LDS_SYNC() asm volatile("s_waitcnt lgkmcnt(0)" ::: "memory")
#define WAVE_ALL(p) (__all(p) != 0)
#define EXP2F(x) __builtin_amdgcn_exp2f(x)
#define RCPF(x) __builtin_amdgcn_rcpf(x)
#define LOG2F(x) __builtin_amdgcn_logf(x)
__device__ __forceinline__ void permlane32_swap_u(unsigned a, unsigned b, unsigned& ra, unsigned& rb) { auto r = __builtin_amdgcn_permlane32_swap(a, b, false, false); ra = r[0]; rb = r[1]; }
#endif
#if !defined(HOST_SIM) && PROBE_SPIN
#define PSPIN_T0(id) unsigned long long _pt0 = 0; if (PROBE_SPIN == (id) && blockIdx.x == PROBE_BLK && threadIdx.x == 0) _pt0 = __builtin_amdgcn_s_memrealtime();
#define PSPIN_T1(id, wsp) if (PROBE_SPIN == (id) && blockIdx.x == PROBE_BLK && threadIdx.x == 0) { const unsigned long long _d = __builtin_amdgcn_s_memrealtime() - _pt0; atomicAdd((unsigned*)(wsp) + 64, (unsigned)_d); }
#define PSPINL_T0(id, ldsp) if (PROBE_SPIN == (id) && blockIdx.x == PROBE_BLK && threadIdx.x == 0) { const unsigned long long _t = __builtin_amdgcn_s_memrealtime(); ((LAS unsigned*)((ldsp) + MISC_OFF + 16))[0] = (unsigned)_t; ((LAS unsigned*)((ldsp) + MISC_OFF + 16))[1] = (unsigned)(_t >> 32); }
#define PSPINL_T1(id, ldsp, wsp) if (PROBE_SPIN == (id) && blockIdx.x == PROBE_BLK && threadIdx.x == 0) { const unsigned long long _t0 = ((unsigned long long)((LAS unsigned*)((ldsp) + MISC_OFF + 16))[1] << 32) | ((LAS unsigned*)((ldsp) + MISC_OFF + 16))[0]; atomicAdd((unsigned*)(wsp) + 64, (unsigned)(__builtin_amdgcn_s_memrealtime() - _t0)); }
#else
#define PSPIN_T0(id)
#define PSPIN_T1(id, wsp)
#define PSPINL_T0(id, ldsp)
#define PSPINL_T1(id, ldsp, wsp)
#endif
__device__ __forceinline__ unsigned cvtpk_h(float lo, float hi) { h16x2 v; v[0] = (h16)lo; v[1] = (h16)hi; return __builtin_bit_cast(unsigned, v); }
__device__ __forceinline__ float sigm(float x) { return RCPF(1.0f + __expf(-x)); }
__device__ __forceinline__ float siluf(float x) { return x * sigm(x); }
__device__ __forceinline__ float geluf(float x) { const float u2 = x * (1.5957691216057308f + 0.07135481627f * x * x); return x * RCPF(1.0f + __expf(-u2)); }
#ifdef HOST_SIM
static inline float shfl_xor_l(float v, int m, int lane) { (void)lane; return __shfl_xor(v, m); }
static inline float shfl_l(float v, int src) { return __shfl(v, src); }
static inline float shfl_up_l(float v, int d, int lane) { (void)lane; return __shfl_up(v, d); }
#else
__device__ __forceinline__ float shfl_xor_l(float v, int m, int lane) { return __builtin_bit_cast(float, __builtin_amdgcn_ds_bpermute((lane ^ m) << 2, __builtin_bit_cast(int, v))); }
__device__ __forceinline__ float shfl_l(float v, int src) { return __builtin_bit_cast(float, __builtin_amdgcn_ds_bpermute(src << 2, __builtin_bit_cast(int, v))); }
__device__ __forceinline__ float shfl_up_l(float v, int d, int lane) { const float r = __builtin_bit_cast(float, __builtin_amdgcn_ds_bpermute((lane - d) << 2, __builtin_bit_cast(int, v))); return lane >= d ? r : v; }
#endif
__device__ __forceinline__ float wave_sum(float v, int lane) { v += shfl_xor_l(v, 32, lane); v += shfl_xor_l(v, 16, lane); v += shfl_xor_l(v, 8, lane); v += shfl_xor_l(v, 4, lane); v += shfl_xor_l(v, 2, lane); v += shfl_xor_l(v, 1, lane); return v; }

#ifndef HOST_SIM
#define XB_TMO      128
#define XB_XCNT(j)  (256  + 64 * (j))
#define XB_XSUB(j)  (1280 + 64 * (j))
#define XB_XGEN(j)  (2304 + 64 * (j))
#define XB_TOP      3328
#define XB_TOPGEN   3392
#define XCD_BAR_WORDS 3456
#define XB_SPIN_CAP (1u << 24)
__device__ __forceinline__ unsigned xb_ld(unsigned* p)              { return __hip_atomic_load(p, __ATOMIC_RELAXED, __HIP_MEMORY_SCOPE_AGENT); }
__device__ __forceinline__ unsigned xb_add(unsigned* p, unsigned v) { return __hip_atomic_fetch_add(p, v, __ATOMIC_RELAXED, __HIP_MEMORY_SCOPE_AGENT); }
__device__ __forceinline__ unsigned xb_xcc_id() { return (unsigned)__builtin_amdgcn_s_getreg((3 << 11) | 20) & 0xFu; }
#define XB_SPIN(cond, bar) do { unsigned _sp = 0; while (cond) { __builtin_amdgcn_s_sleep(1); \
    if ((++_sp & 255u) == 0u) { if (xb_ld(&(bar)[XB_TMO])) break; if (_sp > XB_SPIN_CAP) { atomicAdd(&(bar)[XB_TMO], 1u); break; } } } } while (0)
struct XcdBarrier { unsigned* bar; unsigned x; volatile LAS unsigned* st; };
__device__ __forceinline__ XcdBarrier xcd_barrier_post(unsigned* bar, volatile LAS unsigned* st) {
    XcdBarrier b; b.bar = bar; b.x = xb_xcc_id(); b.st = st;
    if (threadIdx.x == 0) (void)xb_add(&bar[XB_XCNT(b.x)], 1u);
    return b;
}
__device__ __forceinline__ void xcd_barrier_complete(unsigned* bar, unsigned x, unsigned& nloc, unsigned& nx) {
    const unsigned G = gridDim.x * gridDim.y * gridDim.z;
    unsigned sum, cnt, mine, sp = 0u;
    for (;;) {
        sum = 0u; cnt = 0u; mine = 0u;
#pragma unroll
        for (unsigned j = 0; j < 16; ++j) { const unsigned c = xb_ld(&bar[XB_XCNT(j)]); sum += c; cnt += (c > 0u) ? 1u : 0u; mine = (j == x) ? c : mine; }
        if (sum == G) break;
        __builtin_amdgcn_s_sleep(1);
        if ((++sp & 255u) == 0u) { if (xb_ld(&bar[XB_TMO])) break; if (sp > XB_SPIN_CAP) { atomicAdd(&bar[XB_TMO], 1u); break; } }
    }
    nloc = mine > 0u ? mine : 1u; nx = cnt > 0u ? cnt : 1u;
}
__device__ __forceinline__ void xcd_barrier(const XcdBarrier& b) {
    asm volatile("s_waitcnt vmcnt(0)" ::: "memory");
    __syncthreads();
    if (threadIdx.x == 0) {
        unsigned* bar = b.bar;
        __builtin_amdgcn_s_waitcnt(0);
        unsigned nloc = b.st[0], nx = b.st[1];
        if (nloc == 0u) { xcd_barrier_complete(bar, b.x, nloc, nx); b.st[0] = nloc; b.st[1] = nx; }
        const unsigned old = xb_add(&bar[XB_XSUB(b.x)], 1u);
        const unsigned gen = old / nloc;
        if (old + 1u == (gen + 1u) * nloc) {
            __builtin_amdgcn_fence(__ATOMIC_RELEASE, "agent");
            asm volatile("s_waitcnt vmcnt(0)" ::: "memory");
            const unsigned og = xb_add(&bar[XB_TOP], 1u);
            const unsigned tg = og / nx;
            if (og + 1u == (tg + 1u) * nx) xb_add(&bar[XB_TOPGEN], 1u);
            else XB_SPIN(xb_ld(&bar[XB_TOPGEN]) == tg, bar);
            __builtin_amdgcn_fence(__ATOMIC_ACQUIRE, "agent");
            xb_add(&bar[XB_XGEN(b.x)], 1u);
            asm volatile("s_waitcnt vmcnt(0)" ::: "memory");
        } else {
            XB_SPIN(xb_ld(&bar[XB_XGEN(b.x)]) == gen, bar);
            __builtin_amdgcn_fence(__ATOMIC_ACQUIRE, "agent");
            asm volatile("s_waitcnt vmcnt(0)" ::: "memory");
        }
    }
    __syncthreads();
}
#else
#define XCD_BAR_WORDS 3456
struct XcdBarrier { int dummy; };
static inline void xcd_barrier(const XcdBarrier&) { sim::grid_sync(); }
#endif

#ifdef HOST_SIM
#define PF_LOAD(g, l) ((void)(g))
#define LANE_ID(x) ((x) = sim::cur->lane)
#else
#define LANE_ID(x) asm volatile("v_mbcnt_lo_u32_b32 %0, -1, 0\n\tv_mbcnt_hi_u32_b32 %0, -1, %0" : "=v"(x))
#define PF_LOAD(g, l) __builtin_amdgcn_global_load_lds((const unsigned*)(g), (LAS unsigned*)(l), 4, 0, 0)
#endif
namespace pg8 {
constexpr int BM = 256, BK = 64, HALF = 128, HTB = HALF * BK * 2, NXCD = 8, WGM = 8;
__host__ __device__ __forceinline__ int lds_byte(int r, int c) { const int st = (r >> 4) * 2 + (c >> 5), rr = r & 15, cc = c & 31, ob = rr * 64 + cc * 2; return st * 1024 + (ob ^ (((ob >> 9) & 1) << 5)); }
__host__ __device__ __forceinline__ void stage_rc(int b, int& R, int& C) { const int st = b / 1024, sb = b % 1024, swz = sb ^ (((sb >> 9) & 1) << 5); R = (st >> 1) * 16 + swz / 64; C = (st & 1) * 32 + (swz % 64) / 2; }
__host__ __device__ __forceinline__ int perm32(int rho) { const int n = rho >> 4, i = rho & 15; return 8 * (i >> 2) + 4 * n + (i & 3); }
struct Unit { int pm, pn, sel; };
struct Gemm { const h16* A; const h16* Bt; size_t sa, sb; int M, N, K, lda, ldb;
    __device__ __forceinline__ const char* a(int s) const { return (const char*)(A + (size_t)s * sa); }
    __device__ __forceinline__ const char* b(int s) const { return (const char*)(Bt + (size_t)s * sb); } };
struct StaticOrder {
    int nM, nN, nwg, G, c;
    __host__ __device__ void init(int M_, int N_, int G_, int c_) { nM = M_ / BM; nN = N_ / BM; nwg = nM * nN; G = G_; c = c_; }
    __host__ __device__ bool next(int i, Unit& u) const {
        const long L = (long)i * G + c; if (L >= nwg) return false;
        int wgid = (int)L; { const int q = nwg / NXCD, r = nwg % NXCD, xcd = wgid % NXCD, off = wgid / NXCD; wgid = (xcd < r ? xcd * (q + 1) : r * (q + 1) + (xcd - r) * q) + off; }
        const int nig = WGM * nN, gid = wgid / nig, fm = gid * WGM, gsz = (nM - fm) < WGM ? (nM - fm) : WGM;
        u.pm = fm + ((wgid % nig) % gsz); u.pn = (wgid % nig) / gsz; u.sel = 0; return true;
    }
};
struct WholeRounds { StaticOrder S; int rounds;
    __host__ __device__ void init(int M_, int N_, int G_, int c_) { S.init(M_, N_, G_, c_); rounds = S.nwg / G_; if (rounds == 0) rounds = 1; }
    __host__ __device__ bool next(int i, Unit& u) const { return i < rounds && S.next(i, u); } };
struct LeftoverUnit { StaticOrder S; int round; bool mine;
    __host__ __device__ void init(int M_, int N_, int G_, int bid) { const int nwg = (M_ / BM) * (N_ / BM), R = nwg / G_ > 0 ? nwg / G_ : 1, left = nwg - R * G_; mine = left > 0 && bid >= G_ - left; S.init(M_, N_, G_, mine ? bid - (G_ - left) : 0); round = R; }
    __host__ __device__ bool next(int i, Unit& u) const { return mine && i == 0 && S.next(round, u); } };
template <int NSEL> struct MultiOrder {
    StaticOrder S;
    __host__ __device__ void init(int M_, int N_, int G_, int c_) { S.init(M_, N_, G_, c_); }
    __host__ __device__ bool next(int i, Unit& u) const { const bool ok = S.next(i / NSEL, u); u.sel = i % NSEL; return ok; }
};

struct GroupOrder {
    int G, c;
    __host__ __device__ void init(int G_, int c_) { G = G_; c = c_; }
    __host__ __device__ bool next(int i, Unit& u) const { const int L = i * G + c; if (L >= S5G * (NBLK_P / 256)) return false; u.sel = L / (NBLK_P / 256); u.pm = L % (NBLK_P / 256); u.pn = 0; return true; }
};
template <class Epi, class Sched>
__device__ __forceinline__ void gemm_phase(LAS unsigned char* lds, const Gemm g, const Sched& S, const Epi& E) {
    int tid = threadIdx.x; LAUNDER(tid);
    const int wid = __builtin_amdgcn_readfirstlane(tid >> 6), lane = tid & 63, wr = wid >> 2, wc = wid & 3, fr = lane & 15, fq = lane >> 4;
    const int K = g.K, nt = K / BK;
    unsigned voffA[2], voffB[2];
#pragma unroll
    for (int i = 0; i < 2; ++i) { int R, C; stage_rc(tid * 16 + i * 8192, R, C); const int Rb = Epi::PERM ? ((R & ~31) + perm32(R & 31)) : R;
        voffA[i] = (unsigned)(R * g.lda + C) * 2u; voffB[i] = (unsigned)(Rb * g.ldb + C) * 2u; }
    const size_t kstep = (size_t)(BK * 2);
    const size_t hstepA = (size_t)HALF * g.lda * 2, hstepB = (size_t)HALF * g.ldb * 2;
    const size_t tstepA = 2 * hstepA, tstepB = 2 * hstepB;
    const unsigned ldsw = (unsigned)wid * 1024u;
    const int aoff = lds_byte(wr * 64 + fr, fq * 8), boff = lds_byte(wc * 32 + fr, fq * 8);
#define PG8_SA(b, h) (((b) * 2 + (h)) * HTB)
#define PG8_SB(b, h) ((4 + (b) * 2 + (h)) * HTB)
#define PG8_STAGE(bufoff, gbase, voff) do { _Pragma("unroll") for (int _i = 0; _i < 2; ++_i) \
        GLDS16((const char*)(gbase) + (voff)[_i], lds + (bufoff) + ldsw + _i * 8192); } while (0)
#define PG8_LDA(dst, b, h) do { _Pragma("unroll") for (int m = 0; m < 4; ++m) _Pragma("unroll") for (int k = 0; k < 2; ++k) dst[m][k] = *(const LAS h16x8*)(lds + PG8_SA(b, h) + aoff + m * 2048 + k * 1024); } while (0)
#define PG8_LDB(dst, b, h) do { _Pragma("unroll") for (int n = 0; n < 2; ++n) _Pragma("unroll") for (int k = 0; k < 2; ++k) dst[n][k] = *(const LAS h16x8*)(lds + PG8_SB(b, h) + boff + n * 2048 + k * 1024); } while (0)
#define PG8_MMA(ai, bj, At, Bt) do { SETPRIO(1); _Pragma("unroll") for (int m = 0; m < 4; ++m) _Pragma("unroll") for (int n = 0; n < 2; ++n) _Pragma("unroll") for (int k = 0; k < 2; ++k) \
        acc[ai][bj][m][n] = MFMA16(Bt[n][k], At[m][k], acc[ai][bj][m][n]); SETPRIO(0); } while (0)
    Unit cur, nxt; int ui = 0;
    if (!S.next(0, cur)) return;
    f32x4 acc[2][2][4][2];
#if defined(HOST_SIM) && defined(SIM_FAST_GEMM)
    for (;; ++ui) {
        if (!S.next(ui, cur)) break;
        const h16* Ap = (const h16*)g.a(cur.sel); const h16* Bp = (const h16*)g.b(cur.sel);
        for (int ai = 0; ai < 2; ++ai) for (int bj = 0; bj < 2; ++bj) for (int m = 0; m < 4; ++m) for (int n = 0; n < 2; ++n) for (int j = 0; j < 4; ++j) {
            const int row = cur.pm * 256 + ai * 128 + wr * 64 + m * 16 + fr;
            const int col = cur.pn * 256 + bj * 128 + wc * 32 + (Epi::PERM ? 8 * fq + 4 * n + j : 16 * n + 4 * fq + j);
            float sacc = 0.f; for (int k = 0; k < K; ++k) sacc += (float)Ap[(size_t)row * g.lda + k] * (float)Bp[(size_t)col * g.ldb + k];
            acc[ai][bj][m][n][j] = (Epi::CHAIN && cur.sel > 0 ? acc[ai][bj][m][n][j] : 0.f) + sacc; }
        if constexpr (Epi::CHAIN) (void)E.chain(acc, cur, wr, wc, fr, fq); else E(acc, cur, wr, wc, fr, fq);
    }
    (void)nxt; (void)voffA; (void)voffB; (void)aoff; (void)boff; (void)ldsw; (void)kstep; (void)tstepA; (void)tstepB; (void)nt;
    return;
#endif
#pragma unroll
    for (int a = 0; a < 2; ++a)
#pragma unroll
        for (int b = 0; b < 2; ++b)
#pragma unroll
            for (int m = 0; m < 4; ++m)
#pragma unroll
                for (int n = 0; n < 2; ++n) acc[a][b][m][n] = (f32x4){0.f, 0.f, 0.f, 0.f};
    h16x8 At[4][2], B0[2][2], B1[2][2];
    const char* cA = g.a(cur.sel) + (size_t)cur.pm * tstepA; const char* cB = g.b(cur.sel) + (size_t)cur.pn * tstepB;
    PG8_STAGE(PG8_SB(0, 0), cB, voffB); PG8_STAGE(PG8_SA(0, 0), cA, voffA); PG8_STAGE(PG8_SB(0, 1), cB + hstepB, voffB); PG8_STAGE(PG8_SA(0, 1), cA + hstepA, voffA);
    if (wr == 1) SBAR;
    WAIT_V(4); SBAR;
    PG8_STAGE(PG8_SB(1, 0), cB + kstep, voffB); PG8_STAGE(PG8_SA(1, 0), cA + kstep, voffA); PG8_STAGE(PG8_SB(1, 1), cB + hstepB + kstep, voffB);
    WAIT_V(6); SBAR;
    for (;;) {
        const bool has_next = S.next(ui + 1, nxt);
        const char* nA = has_next ? g.a(nxt.sel) + (size_t)nxt.pm * tstepA : cA; const char* nB = has_next ? g.b(nxt.sel) + (size_t)nxt.pn * tstepB : cB;
        for (int t = 0; t < nt; t += 2) {
            if constexpr (Epi::PFI > 0) { const int it = (nt - 2 - t) >> 1;
                if (it < Epi::PFI && E.pf_on(it, wid)) { unsigned ln = 0; LANE_ID(ln); PF_LOAD(E.pf_base(cur, it) + E.pf_voff(it, (wid & 3) * 64 + (int)ln, wid >> 2), lds + STAGE_BYTES + wid * 256); } }
            const bool last = (t == nt - 2);
            const char* a1 = cA + (size_t)(t + 1) * kstep;
            const char* a2 = last ? nA : cA + (size_t)(t + 2) * kstep; const char* b2 = last ? nB : cB + (size_t)(t + 2) * kstep;
            const char* a3 = a2 + kstep; const char* b3 = b2 + kstep;
            PG8_LDB(B0, 0, 0); SCHED; PG8_LDA(At, 0, 0); PG8_STAGE(PG8_SA(1, 1), a1 + hstepA, voffA);
            WAIT_L(8); SBAR; WAIT_L(0); PG8_MMA(0, 0, At, B0); SBAR; SCHED;
            PG8_LDB(B1, 0, 1); PG8_STAGE(PG8_SB(0, 0), b2, voffB);
            SBAR; WAIT_L(0); PG8_MMA(0, 1, At, B1); SBAR;
            PG8_LDA(At, 0, 1); PG8_STAGE(PG8_SA(0, 0), a2, voffA);
            SBAR; WAIT_L(0); PG8_MMA(1, 0, At, B0); SBAR; SCHED;
            PG8_STAGE(PG8_SB(0, 1), b2 + hstepB, voffB);
            WAIT_V(6); SBAR; PG8_MMA(1, 1, At, B1); SBAR;
            PG8_LDB(B0, 1, 0); SCHED; PG8_LDA(At, 1, 0); PG8_STAGE(PG8_SA(0, 1), a2 + hstepA, voffA);
            WAIT_L(8); SBAR; WAIT_L(0); PG8_MMA(0, 0, At, B0); SBAR; SCHED;
            PG8_LDB(B1, 1, 1); PG8_STAGE(PG8_SB(1, 0), b3, voffB);
            SBAR; WAIT_L(0); PG8_MMA(0, 1, At, B1); SBAR;
            PG8_LDA(At, 1, 1); PG8_STAGE(PG8_SA(1, 0), a3, voffA);
            SBAR; WAIT_L(0); PG8_MMA(1, 0, At, B0); SBAR; SCHED;
            PG8_STAGE(PG8_SB(1, 1), b3 + hstepB, voffB);
            WAIT_V(6); SBAR; PG8_MMA(1, 1, At, B1); SBAR;
        }
        bool zero_acc = true;
        if constexpr (Epi::CHAIN) zero_acc = E.chain(acc, cur, wr, wc, fr, fq); else E(acc, cur, wr, wc, fr, fq);
        if (!has_next) break;
        if (zero_acc) {
#pragma unroll
        for (int a = 0; a < 2; ++a)
#pragma unroll
            for (int b = 0; b < 2; ++b)
#pragma unroll
                for (int m = 0; m < 4; ++m)
#pragma unroll
                    for (int n = 0; n < 2; ++n) acc[a][b][m][n] = (f32x4){0.f, 0.f, 0.f, 0.f};
        }
        cur = nxt; cA = nA; cB = nB; ++ui;
    }
    WAIT_V(0);
    if (wr == 0) SBAR;
    SBAR;
#undef PG8_SA
#undef PG8_SB
#undef PG8_STAGE
#undef PG8_LDA
#undef PG8_LDB
#undef PG8_MMA
}
}

__device__ __forceinline__ int mod_row(int row) { return row < MP ? 0 : 1 + (row - MP) / DSEQ; }

static_assert(D == 2 * W, "mixed-tile column grouping");
__host__ __device__ __forceinline__ int mix_tile(int colt) {
    if (colt >= C_MG) return (colt - C_MG) >> 8;
    if (colt >= C_SG) return 3 * D / 256 + W / 256 + ((colt - C_SG) >> 8);
    if (colt >= C_HGG && colt < C_AQ) return 3 * D / 256 + ((colt - C_HGG) >> 8);
    return -1;
}
__host__ __device__ __forceinline__ int win_src_col(int nd) {
    const int T = mix_tile(nd & ~255); if (T < 0) return nd;
    const int n = nd & 255, slot = ((n >> 7) << 1) | ((n >> 2) & 1), cb = 64 * T + ((n >> 5) & 3) * 16 + ((n >> 3) & 3) * 4 + (n & 3);
    return slot < 3 ? C_MG + slot * D + cb : (cb < W ? C_HGG + cb : C_SG + cb - W);
}
struct EpiIn {
    static constexpr bool PERM = true, CHAIN = false; static constexpr int PFI = 0;
    h16* Z; float* LOGF; const float* LB; h16* A3;
    __device__ __forceinline__ void operator()(const f32x4 (&acc)[2][2][4][2], const pg8::Unit& u, int wr, int wc, int fr, int fq) const {
        const int colt = u.pn * 256;
        int kind;
        if (colt < 2 * W) kind = 0; else if (colt < 4 * W) kind = 1; else if (colt < 5 * W) kind = 2; else if (colt < C_AG) kind = 0; else if (colt < C_SU) kind = 2;
        else if (colt < C_SG) kind = 0; else if (colt < C_MG) kind = 2; else kind = 3;
        const int row0 = u.pm * 256 + wr * 64 + fr;
        const int T = mix_tile(colt);
        if (T >= 0) {
            const int cb = 64 * T + wc * 16 + fq * 4, cs = cb < W ? C_HGG + cb : C_SG + cb - W;
            constexpr float EMAX = 16777216.f, HMAX = 65504.f;
#pragma unroll
            for (int ai = 0; ai < 2; ++ai)
#pragma unroll
                for (int m = 0; m < 4; ++m) {
                    h16* zr = Z + (size_t)(row0 + ai * 128 + m * 16) * INC;
                    h16x4 r0, r1, r2, sv;
#pragma unroll
                    for (int j = 0; j < 4; ++j) {
                        const float a0 = 1.0f + fminf(__expf(-acc[ai][0][m][0][j]), EMAX), a1 = 1.0f + fminf(__expf(-acc[ai][0][m][1][j]), EMAX), a2 = 1.0f + fminf(__expf(-acc[ai][1][m][0][j]), EMAX);
                        const float i0 = RCPF(a0), i1 = RCPF(a1), i2 = RCPF(a2);
                        r0[j] = (h16)fminf(a1 * i0, HMAX); r1[j] = (h16)fminf(a2 * i1, HMAX); r2[j] = (h16)i2; sv[j] = (h16)siluf(acc[ai][1][m][1][j]);
                    }
                    *(h16x4*)(zr + C_MG + cb) = r0; *(h16x4*)(zr + C_MG + D + cb) = r1; *(h16x4*)(zr + C_MG + 2 * D + cb) = r2; *(h16x4*)(zr + cs) = sv;
                }
            return;
        }
        if (kind == 1) {
            const int dir = colt >= 3 * W ? 1 : 0;
#pragma unroll
            for (int bj = 0; bj < 2; ++bj) {
                const int c0 = colt + bj * 128 + wc * 32 + 8 * fq;
                const float* lbp = LB + (size_t)dir * DEPTH * W + (c0 - (2 + dir) * W);
                const f32x4 l0 = *(const f32x4*)lbp, l1 = *(const f32x4*)(lbp + 4);
#pragma unroll
                for (int ai = 0; ai < 2; ++ai)
#pragma unroll
                    for (int m = 0; m < 4; ++m) {
                        const int row = row0 + ai * 128 + m * 16;
                        f32x4 o0, o1;
#pragma unroll
                        for (int j = 0; j < 4; ++j) { o0[j] = l0[j] + (1.0f - l0[j]) * sigm(acc[ai][bj][m][0][j]); o1[j] = l1[j] + (1.0f - l1[j]) * sigm(acc[ai][bj][m][1][j]); }
                        float* dst = LOGF + (size_t)row * (2 * W) + (c0 - 2 * W);
                        *(f32x4*)dst = o0; *(f32x4*)(dst + 4) = o1;
                    }
            }
            return;
        }
#pragma unroll
        for (int ai = 0; ai < 2; ++ai)
#pragma unroll
            for (int m = 0; m < 4; ++m) {
                const int row = row0 + ai * 128 + m * 16;
#pragma unroll
                for (int bj = 0; bj < 2; ++bj) {
                    const int c0 = colt + bj * 128 + wc * 32 + 8 * fq;
                    h16x8 o;
#pragma unroll
                    for (int j = 0; j < 4; ++j) {
                        float a = acc[ai][bj][m][0][j], b = acc[ai][bj][m][1][j];
                        if (kind == 2) { a = siluf(a); b = siluf(b); } else if (kind == 3) { a = sigm(a); b = sigm(b); }
                        o[j] = (h16)a; o[4 + j] = (h16)b;
                    }
                    if (colt >= C_HI && colt < C_FF) { bf16x8 ob;
#pragma unroll
                        for (int j = 0; j < 4; ++j) { ob[j] = (bf16)acc[ai][bj][m][0][j]; ob[4 + j] = (bf16)acc[ai][bj][m][1][j]; }
                        *(bf16x8*)((bf16*)Z + (size_t)row * INC + c0) = ob; }
                    else if (colt >= C_SU && colt < C_SG) { const int cg = c0 - C_SU; *(h16x8*)(A3 + ((size_t)(cg >> 4) * NBLK_P + (row >> 4)) * 512 + (row & 15) * 16 + (cg & 15)) = o; }
                    else *(h16x8*)(Z + (size_t)row * INC + c0) = o;
                }
            }
    }
};
struct EpiS5P {
    static constexpr bool PERM = false, CHAIN = false; static constexpr int PFI = 0;
    float* PB;
    __device__ __forceinline__ void operator()(const f32x4 (&acc)[2][2][4][2], const pg8::Unit& u, int wr, int wc, int fr, int fq) const {
        const int row0 = u.pm * 256 + wr * 64 + fr;
#pragma unroll
        for (int ai = 0; ai < 2; ++ai)
#pragma unroll
            for (int m = 0; m < 4; ++m) { const int row = row0 + ai * 128 + m * 16; if (row >= NBLK) continue;
#pragma unroll
                for (int bj = 0; bj < 2; ++bj)
#pragma unroll
                    for (int n = 0; n < 2; ++n) *(f32x4*)(PB + ((size_t)u.sel * NBLK_P + row) * 256 + bj * 128 + wc * 32 + 16 * n + 4 * fq) = acc[ai][bj][m][n]; }
    }
};
struct EpiS5Y {
    static constexpr bool PERM = true, CHAIN = false; static constexpr int PFI = 0;
    h16* YS;
    __device__ __forceinline__ void operator()(const f32x4 (&acc)[2][2][4][2], const pg8::Unit& u, int wr, int wc, int fr, int fq) const {
        const int row0 = u.pm * 256 + wr * 64 + fr, g = u.sel;
#pragma unroll
        for (int ai = 0; ai < 2; ++ai)
#pragma unroll
            for (int m = 0; m < 4; ++m)
#pragma unroll
                for (int bj = 0; bj < 2; ++bj) { const int blk = row0 + ai * 128 + m * 16, n0 = bj * 128 + wc * 32 + 8 * fq; if (blk >= NBLK) continue;
                    h16x8 o;
#pragma unroll
                    for (int j = 0; j < 4; ++j) { o[j] = (h16)geluf(acc[ai][bj][m][0][j]); o[4 + j] = (h16)geluf(acc[ai][bj][m][1][j]); }
                    *(h16x8*)(YS + ((size_t)blk * 16 + (n0 >> 4)) * W + g * 16 + (n0 & 15)) = o; }
    }
};
struct EpiGlu {
    static constexpr bool PERM = true, CHAIN = false; static constexpr int PFI = 0;
    __device__ __forceinline__ bool pf_on(int, int) const { return true; }
    __device__ __forceinline__ const char* pf_base(const pg8::Unit& u, int it) const { return (it >> 1) ? (const char*)(Z + (size_t)u.pm * 256 * INC + C_SG + u.pn * 256) : (const char*)(YS + (size_t)u.pm * 256 * W + u.pn * 256); }
    __device__ __forceinline__ unsigned pf_voff(int it, int l256, int hi) const { const int L = (it & 1) * 512 + hi * 256 + l256; return (unsigned)((L >> 2) * ((it >> 1) ? INC : W) + (L & 3) * 64) * 2u; }
    const h16* YS; const h16* Z; h16* OS5;
    __device__ __forceinline__ void operator()(const f32x4 (&acc)[2][2][4][2], const pg8::Unit& u, int wr, int wc, int fr, int fq) const {
        const int colt = u.pn * 256, row0 = u.pm * 256 + wr * 64 + fr;
#pragma unroll
        for (int ai = 0; ai < 2; ++ai) {
            h16x8 ys[4][2], sg[4][2];
#pragma unroll
            for (int m = 0; m < 4; ++m)
#pragma unroll
                for (int bj = 0; bj < 2; ++bj) { const int row = row0 + ai * 128 + m * 16, c0 = colt + bj * 128 + wc * 32 + 8 * fq;
                    ys[m][bj] = *(const h16x8*)(YS + (size_t)row * W + c0); sg[m][bj] = *(const h16x8*)(Z + (size_t)row * INC + C_SG + c0); }
#pragma unroll
            for (int m = 0; m < 4; ++m)
#pragma unroll
                for (int bj = 0; bj < 2; ++bj) { const int row = row0 + ai * 128 + m * 16, c0 = colt + bj * 128 + wc * 32 + 8 * fq;
                    h16x8 o;
#pragma unroll
                    for (int j = 0; j < 4; ++j) { o[j] = (h16)((float)ys[m][bj][j] * sigm(acc[ai][bj][m][0][j]) * (float)sg[m][bj][j]); o[4 + j] = (h16)((float)ys[m][bj][4 + j] * sigm(acc[ai][bj][m][1][j]) * (float)sg[m][bj][4 + j]); }
                    *(h16x8*)(OS5 + (size_t)row * W + c0) = o; }
            CFENCE;
        }
    }
};
struct EpiBr {
    static constexpr bool PERM = true, CHAIN = true; static constexpr int PFI = 4;
    __device__ __forceinline__ bool pf_on(int it, int wid) const { return (wid >> 2) == (it & 1); }
    __device__ __forceinline__ const char* pf_base(const pg8::Unit& u, int) const { return (const char*)(Z + (size_t)u.pm * 256 * INC + C_MG + (size_t)u.sel * D + u.pn * 256); }
    __device__ __forceinline__ unsigned pf_voff(int it, int l256, int) const { const int L = it * 256 + l256; return (unsigned)((L >> 2) * INC + (L & 3) * 64) * 2u; }
    const h16* Z; h16* MG;
    __device__ __forceinline__ bool chain(f32x4 (&acc)[2][2][4][2], const pg8::Unit& u, int wr, int wc, int fr, int fq) const {
        const int colt = u.pn * 256, row0 = u.pm * 256 + wr * 64 + fr, b = u.sel;
        h16x8 gn[2][4][2];
#pragma unroll
        for (int ai = 0; ai < 2; ++ai)
#pragma unroll
            for (int m = 0; m < 4; ++m)
#pragma unroll
                for (int bj = 0; bj < 2; ++bj) { const int row = row0 + ai * 128 + m * 16, c0 = colt + bj * 128 + wc * 32 + 8 * fq;
                    gn[ai][m][bj] = *(const h16x8*)(Z + (size_t)row * INC + C_MG + (size_t)b * D + c0); }
#pragma unroll
        for (int ai = 0; ai < 2; ++ai) {
#pragma unroll
            for (int m = 0; m < 4; ++m)
#pragma unroll
                for (int bj = 0; bj < 2; ++bj) {
#pragma unroll
                    for (int j = 0; j < 4; ++j) { acc[ai][bj][m][0][j] *= (float)gn[ai][m][bj][j]; acc[ai][bj][m][1][j] *= (float)gn[ai][m][bj][4 + j]; }
                    if (b == 2) { const int row = row0 + ai * 128 + m * 16, c0 = colt + bj * 128 + wc * 32 + 8 * fq; h16x8 o;
#pragma unroll
                        for (int j = 0; j < 4; ++j) { o[j] = (h16)acc[ai][bj][m][0][j]; o[4 + j] = (h16)acc[ai][bj][m][1][j]; }
                        *(h16x8*)(MG + (size_t)row * D + c0) = o; } }
            CFENCE;
        }
        return b == 2;
    }
};
struct EpiOut {
    static constexpr bool PERM = true, CHAIN = false; static constexpr int PFI = 0;
    __device__ __forceinline__ bool pf_on(int it, int wid) const { return !first && (wid >> 2) == (it & 1); }
    __device__ __forceinline__ const char* pf_base(const pg8::Unit& u, int) const { return (const char*)(X + (size_t)u.pm * 256 * D + u.pn * 256); }
    __device__ __forceinline__ unsigned pf_voff(int it, int l256, int) const { const int L = it * 256 + l256; return (unsigned)((L >> 2) * D + (L & 3) * 64) * 2u; }
    const float* XP; const float* XS; h16* X; const float* MOD; bool first;
    __device__ __forceinline__ void operator()(const f32x4 (&acc)[2][2][4][2], const pg8::Unit& u, int wr, int wc, int fr, int fq) const {
        const int colt = u.pn * 256, row0 = u.pm * 256 + wr * 64 + fr;
        const float* gate = MOD + (size_t)mod_row(u.pm * 256) * 3 * D + 2 * D;
        f32x4 gv[2][2];
#pragma unroll
        for (int bj = 0; bj < 2; ++bj)
#pragma unroll
            for (int n = 0; n < 2; ++n) gv[bj][n] = *(const f32x4*)(gate + colt + bj * 128 + wc * 32 + 8 * fq + 4 * n);
#pragma unroll
        for (int ai = 0; ai < 2; ++ai) {
            h16x8 xh[4][2];
            if (first) {
#pragma unroll
                for (int m = 0; m < 4; ++m) { const int row = row0 + ai * 128 + m * 16; const float* xin = row < MP ? XP + (size_t)row * D : XS + (size_t)(row - MP) * D;
#pragma unroll
                    for (int bj = 0; bj < 2; ++bj) { const f32x4 a = *(const f32x4*)(xin + colt + bj * 128 + wc * 32 + 8 * fq), b = *(const f32x4*)(xin + colt + bj * 128 + wc * 32 + 8 * fq + 4);
#pragma unroll
                        for (int j = 0; j < 4; ++j) { xh[m][bj][j] = (h16)a[j]; xh[m][bj][4 + j] = (h16)b[j]; } } }
            } else {
#pragma unroll
                for (int m = 0; m < 4; ++m)
#pragma unroll
                    for (int bj = 0; bj < 2; ++bj) xh[m][bj] = *(const h16x8*)(X + (size_t)(row0 + ai * 128 + m * 16) * D + colt + bj * 128 + wc * 32 + 8 * fq);
            }
#pragma unroll
            for (int m = 0; m < 4; ++m) { const int row = row0 + ai * 128 + m * 16;
#pragma unroll
                for (int bj = 0; bj < 2; ++bj) { h16x8 o;
#pragma unroll
                    for (int j = 0; j < 4; ++j) { o[j] = (h16)((float)xh[m][bj][j] + gv[bj][0][j] * acc[ai][bj][m][0][j]); o[4 + j] = (h16)((float)xh[m][bj][4 + j] + gv[bj][1][j] * acc[ai][bj][m][1][j]); }
                    *(h16x8*)(X + (size_t)row * D + colt + bj * 128 + wc * 32 + 8 * fq) = o; } }
            CFENCE;
        }
    }
};

template <bool WMAP = false>
__device__ __forceinline__ void transpose_cvt(LAS float* tile, const float* src, h16* dst, int K, int N, int bid, int G) {
    constexpr int LD = 129;
    const int nkt = K / 64, nnt = N / 128, tid = threadIdx.x;
    for (int t = bid; t < nkt * nnt; t += G) {
        const int kt = t / nnt, ntile = t % nnt;
        float v[16];
#pragma unroll
        for (int i = 0; i < 16; ++i) { const int idx = tid + i * 512, k = idx >> 7, n = idx & 127; v[i] = src[(size_t)(kt * 64 + k) * N + (WMAP ? win_src_col(ntile * 128 + n) : ntile * 128 + n)]; }
#pragma unroll
        for (int i = 0; i < 16; ++i) { const int idx = tid + i * 512, k = idx >> 7, n = idx & 127; tile[k * LD + n] = v[i]; }
        __syncthreads();
#pragma unroll
        for (int i = 0; i < 2; ++i) { const int id = tid + i * 512, n = id & 127, kc = id >> 7; h16x8 o;
#pragma unroll
            for (int j = 0; j < 8; ++j) o[j] = (h16)tile[(kc * 8 + j) * LD + n];
            *(h16x8*)(dst + (size_t)(ntile * 128 + n) * K + kt * 64 + kc * 8) = o; }
        __syncthreads();
    }
}
__device__ __forceinline__ void s5_build(const Params& p, int item, LAS unsigned char* lds) {
    const int tid = threadIdx.x, l = item / S5G, g = item % S5G;
    LAS f32x2* POW = (LAS f32x2*)lds;
    LAS f32x2* BBL = POW + 2 * 17 * 64;
    LAS f32x2* CCL = BBL + 2 * 64 * 16;
    LAS float* KT = (LAS float*)(CCL + 16 * 64);
    if (tid < 128) { const int dir = tid >> 6, pp = tid & 63; const size_t i = (((size_t)l * 2 + dir) * S5G + g) * S5P + pp;
        const float are = p.in[I_ARE][i], aim = p.in[I_AIM][i], dt = __expf(p.in[I_LDT][((size_t)l * 2 + dir) * S5G + g]);
        const float mag = expf(are * dt), abr = mag * cosf(aim * dt), abi = mag * sinf(aim * dt);
        const float den = are * are + aim * aim, nre = abr - 1.0f; const float cre = (nre * are + abi * aim) / den, cim = (abi * are - nre * aim) / den;
        float pr = 1.0f, pi_ = 0.0f;
        for (int k = 0; k <= 16; ++k) { POW[(dir * 17 + k) * 64 + pp] = (f32x2){pr, pi_}; const float nr = pr * abr - pi_ * abi, ni = pr * abi + pi_ * abr; pr = nr; pi_ = ni; }
        for (int c = 0; c < 16; ++c) { const float br = p.in[I_BRE][i * 16 + c], bi = p.in[I_BIM][i * 16 + c]; BBL[(dir * 64 + pp) * 16 + c] = (f32x2){cre * br - cim * bi, cre * bi + cim * br}; } }
    for (int i = tid; i < 16 * 64; i += NTHREADS) { const size_t ci = ((size_t)l * S5G + g) * 16 * S5P + i; CCL[i] = (f32x2){p.in[I_CRE][ci], p.in[I_CIM][ci]}; }
    __syncthreads();
    {
        const int dir = tid >> 8, lag = (tid >> 4) & 15, c = tid & 15; float acc[16];
#pragma unroll
        for (int cp = 0; cp < 16; ++cp) acc[cp] = 0.f;
        for (int pp = 0; pp < 64; ++pp) { const f32x2 cc = CCL[c * 64 + pp], aw = POW[(dir * 17 + lag) * 64 + pp];
            const float mr = cc[0] * aw[0] - cc[1] * aw[1], mi = cc[0] * aw[1] + cc[1] * aw[0];
            const LAS f32x4* bb4 = (const LAS f32x4*)(BBL + (dir * 64 + pp) * 16);
#pragma unroll
            for (int k = 0; k < 8; ++k) { const f32x4 b2 = bb4[k]; acc[2 * k] += mr * b2[0] - mi * b2[1]; acc[2 * k + 1] += mr * b2[2] - mi * b2[3]; } }
#pragma unroll
        for (int cp = 0; cp < 16; ++cp) KT[(dir * 16 + lag) * 256 + c * 16 + cp] = acc[cp];
    }
    __syncthreads();
    h16* BY = (h16*)(p.ws + WS_S5BY) + ((size_t)l * S5G + g) * 256 * 512; h16* BG = (h16*)(p.ws + WS_S5BG) + ((size_t)l * S5G + g) * 256 * 256;
    for (int ch = tid; ch < 256 * 64; ch += NTHREADS) { const int n = ch >> 6, k0 = (ch & 63) * 8, j = n >> 4, c = n & 15; h16x8 o;
#pragma unroll
        for (int q = 0; q < 8; ++q) { const int k = k0 + q; float v;
            if (k < 256) { const int jp = k >> 4, cp = k & 15; v = (jp <= j ? KT[(0 * 16 + (j - jp)) * 256 + c * 16 + cp] : 0.f) + (jp >= j ? KT[(1 * 16 + (jp - j)) * 256 + c * 16 + cp] : 0.f);
                if (jp == j && cp == c) v += p.in[I_S5D][(size_t)l * W + g * 16 + c]; }
            else { const int kk = k - 256, dir = kk >> 7, im = (kk >> 6) & 1, pp = kk & 63; const f32x2 cc = CCL[c * 64 + pp], aw = POW[(dir * 17 + (dir ? 16 - j : j + 1)) * 64 + pp];
                v = im ? -(cc[0] * aw[1] + cc[1] * aw[0]) : (cc[0] * aw[0] - cc[1] * aw[1]); }
            o[q] = (h16)v; }
        *(h16x8*)(BY + (size_t)n * 512 + k0) = o; }
    for (int ch = tid; ch < 256 * 32; ch += NTHREADS) { const int n = ch >> 5, k0 = (ch & 31) * 8, dir = n >> 7, im = (n >> 6) & 1, pp = n & 63; h16x8 o;
#pragma unroll
        for (int q = 0; q < 8; ++q) { const int k = k0 + q, jp = k >> 4, cp = k & 15; const f32x2 aw = POW[(dir * 17 + (dir ? jp : 15 - jp)) * 64 + pp], bb = BBL[(dir * 64 + pp) * 16 + cp];
            o[q] = (h16)(im ? (aw[0] * bb[1] + aw[1] * bb[0]) : (aw[0] * bb[0] - aw[1] * bb[1])); }
        *(h16x8*)(BG + (size_t)n * 256 + k0) = o; }
    __syncthreads();
}
__device__ __forceinline__ void phase_prologue(const Params& p, LAS unsigned char* lds) {
    const int tid = threadIdx.x, bid = blockIdx.x, G = gridDim.x;
    unsigned char* ws = p.ws;
    {
        const int nitems = DEPTH * (3 * D / 128);
        if (bid < nitems) {
            LAS float* sc = (LAS float*)lds;
            LAS float* red = sc + NMODR * D;
            for (int i = tid; i < NMODR * D; i += NTHREADS) { const int r = i / D, k = i % D; const float c = r == 0 ? p.in[I_CCTX][k] : p.in[I_C][(size_t)(r - 1) * D + k]; sc[i] = siluf(c); }
            __syncthreads();
            for (int it = bid; it < nitems; it += G) {
                const int l = it / (3 * D / 128), j = (it % (3 * D / 128)) * 128 + (tid & 127), kg = tid >> 7;
                float a[NMODR];
#pragma unroll
                for (int r = 0; r < NMODR; ++r) a[r] = 0.f;
                const float* wp = p.in[I_WMOD] + (size_t)l * D * 3 * D + j;
                for (int k = kg * (D / 4); k < (kg + 1) * (D / 4); k += 32) { float w8[32];
#pragma unroll
                    for (int kk = 0; kk < 32; ++kk) w8[kk] = wp[(size_t)(k + kk) * 3 * D];
#pragma unroll
                    for (int kk = 0; kk < 32; ++kk)
#pragma unroll
                        for (int r = 0; r < NMODR; ++r) a[r] += sc[r * D + k + kk] * w8[kk]; }
#pragma unroll
                for (int r = 0; r < NMODR; ++r) red[(kg * NMODR + r) * 128 + (tid & 127)] = a[r];
                __syncthreads();
                for (int i = tid; i < NMODR * 128; i += NTHREADS) { const int r = i / 128, jj = i % 128; const int jcol = (it % (3 * D / 128)) * 128 + jj;
                    const float s = red[(0 * NMODR + r) * 128 + jj] + red[(1 * NMODR + r) * 128 + jj] + red[(2 * NMODR + r) * 128 + jj] + red[(3 * NMODR + r) * 128 + jj];
                    ((float*)(ws + WS_MOD))[((size_t)l * NMODR + r) * 3 * D + jcol] = s + p.in[I_BMOD][(size_t)l * 3 * D + jcol]; }
                __syncthreads();
            }
        }
        __syncthreads();
    }
    for (int i = bid * NTHREADS + tid; i < 2 * W; i += G * NTHREADS) {
        const int dir = i / W, w = i % W; const float* lg = p.in[I_LBL] + (size_t)dir * DEPTH * W + w;
        float mx = -1e30f; for (int l = 0; l < DEPTH; ++l) mx = fmaxf(mx, lg[(size_t)l * W]);
        float den = 0.f; for (int l = 0; l < DEPTH; ++l) den += __expf(lg[(size_t)l * W] - mx);
        float cs = 0.f, first = 0.f;
        for (int l = 0; l < DEPTH; ++l) { cs += __expf(lg[(size_t)l * W] - mx) / den; if (l == 0) first = cs; ((float*)(ws + WS_LB))[((size_t)dir * DEPTH + l) * W + w] = cs - first; }
    }
    for (int i = bid * NTHREADS + tid; i < DEPTH * 2 * S5G * S5P; i += G * NTHREADS) {
        const int gidx = i / S5P;
        const float are = p.in[I_ARE][i], aim = p.in[I_AIM][i], dt = __expf(p.in[I_LDT][gidx]);
        const float mag = expf(are * dt), abr = mag * cosf(aim * dt), abi = mag * sinf(aim * dt);
        const float den = are * are + aim * aim, nre = abr - 1.0f;
        const float cre = (nre * are + abi * aim) / den, cim = (abi * are - nre * aim) / den;
        ((f32x2*)(ws + WS_ABAR))[i] = (f32x2){abr, abi};
        h16* bb = (h16*)(ws + WS_BBAR) + (size_t)i * 32;
        for (int c = 0; c < 16; ++c) { const float br = p.in[I_BRE][(size_t)i * 16 + c], bi = p.in[I_BIM][(size_t)i * 16 + c]; bb[c] = (h16)(cre * br - cim * bi); bb[16 + c] = (h16)(cre * bi + cim * br); }
    }
    __syncthreads();
    for (int it = bid; it < DEPTH * S5G; it += G) s5_build(p, it, lds);
    for (int i = bid * NTHREADS + tid; i < (DSEQ / 64 + 64) * 32; i += G * NTHREADS) {
        const int pos = i / 32, j = i % 32; const float inv = exp2f(-(float)j * (13.287712379549449f / 32.0f));
        const float ang = (float)(pos < DSEQ / 64 ? pos : pos - DSEQ / 64) * inv;
        ((f32x2*)(ws + WS_ROPE))[i] = (f32x2){cosf(ang), sinf(ang)};
    }
    LAS float* tile = (LAS float*)lds;
    for (int l = 0; l < DEPTH; ++l) {
        transpose_cvt<true>(tile, p.in[I_WIN] + (size_t)l * D * INC, (h16*)(ws + WS_WIN) + (size_t)l * INC * D, D, INC, bid, G);
        transpose_cvt(tile, p.in[I_WGLU] + (size_t)l * W * W, (h16*)(ws + WS_WGLU) + (size_t)l * W * W, W, W, bid, G);
        transpose_cvt(tile, p.in[I_WBRHG] + (size_t)l * W * D, (h16*)(ws + WS_WBR) + (size_t)(l * 3 + 0) * D * W, W, D, bid, G);
        transpose_cvt(tile, p.in[I_WBRAT] + (size_t)l * W * D, (h16*)(ws + WS_WBR) + (size_t)(l * 3 + 1) * D * W, W, D, bid, G);
        transpose_cvt(tile, p.in[I_WBRS5] + (size_t)l * W * D, (h16*)(ws + WS_WBR) + (size_t)(l * 3 + 2) * D * W, W, D, bid, G);
        transpose_cvt(tile, p.in[I_WOUT] + (size_t)l * D * D, (h16*)(ws + WS_WOUT) + (size_t)l * D * D, D, D, bid, G);
    }
}

__device__ __forceinline__ void phase_norm(const Params& p, int l) {
    int tid_ = threadIdx.x; LAUNDER(tid_);
    const int lane = tid_ & 63, gw = blockIdx.x * NWAVES + (tid_ >> 6), nw = gridDim.x * NWAVES;
    const float* nwt = p.in[I_NORMW] + (size_t)l * D;
    const float* MOD = (const float*)(p.ws + WS_MOD) + (size_t)l * NMODR * 3 * D;
    h16* H = (h16*)(p.ws + WS_H);
    if (l > 0) {
        const h16* X = (const h16*)(p.ws + WS_X);
        for (int row = gw; row < M; row += nw) {
            h16x8 v[D / 512]; float ss = 0.f;
#pragma unroll
            for (int i = 0; i < D / 512; ++i) { v[i] = *(const h16x8*)(X + (size_t)row * D + i * 512 + lane * 8);
#pragma unroll
                for (int j = 0; j < 8; ++j) ss += (float)v[i][j] * (float)v[i][j]; }
            ss = wave_sum(ss, lane);
            const float rstd = rsqrtf(ss / (float)D + EPS);
            const float* md = MOD + (size_t)mod_row(row) * 3 * D;
#pragma unroll
            for (int i = 0; i < D / 512; ++i) { const int c = i * 512 + lane * 8; h16x8 o;
#pragma unroll
                for (int n = 0; n < 2; ++n) { const f32x4 wv = *(const f32x4*)(nwt + c + 4 * n), sh = *(const f32x4*)(md + c + 4 * n), scl = *(const f32x4*)(md + D + c + 4 * n);
#pragma unroll
                    for (int j = 0; j < 4; ++j) o[4 * n + j] = (h16)((float)v[i][4 * n + j] * rstd * wv[j] * (1.0f + scl[j]) + sh[j]); }
                *(h16x8*)(H + (size_t)row * D + c) = o; }
        }
        return;
    }
    for (int row = gw; row < M; row += nw) {
        const float* x = row < MP ? p.in[I_XP] + (size_t)row * D : p.in[I_XS] + (size_t)(row - MP) * D;
        f32x4 v[D / 256]; float ss = 0.f;
#pragma unroll
        for (int i = 0; i < D / 256; ++i) { v[i] = *(const f32x4*)(x + i * 256 + lane * 4); ss += v[i][0] * v[i][0] + v[i][1] * v[i][1] + v[i][2] * v[i][2] + v[i][3] * v[i][3]; }
        ss = wave_sum(ss, lane);
        const float rstd = rsqrtf(ss / (float)D + EPS);
        const float* md = MOD + (size_t)mod_row(row) * 3 * D;
#pragma unroll
        for (int i = 0; i < D / 256; ++i) { const int c = i * 256 + lane * 4; const f32x4 wv = *(const f32x4*)(nwt + c), sh = *(const f32x4*)(md + c), scl = *(const f32x4*)(md + D + c);
            h16x4 o;
#pragma unroll
            for (int j = 0; j < 4; ++j) o[j] = (h16)(v[i][j] * rstd * wv[j] * (1.0f + scl[j]) + sh[j]);
            *(h16x4*)(H + (size_t)row * D + c) = o; }
    }
}
__device__ __forceinline__ void phase_final(const Params& p) {
    int tid_ = threadIdx.x; LAUNDER(tid_);
    const int lane = tid_ & 63, gw = blockIdx.x * NWAVES + (tid_ >> 6), nw = gridDim.x * NWAVES;
    const float* fw = p.in[I_FNORM];
    const h16* X = (const h16*)(p.ws + WS_X);
    for (int row = gw; row < M; row += nw) {
        h16x8 v[D / 512]; float ss = 0.f;
#pragma unroll
        for (int i = 0; i < D / 512; ++i) { v[i] = *(const h16x8*)(X + (size_t)row * D + i * 512 + lane * 8);
#pragma unroll
            for (int j = 0; j < 8; ++j) ss += (float)v[i][j] * (float)v[i][j]; }
        ss = wave_sum(ss, lane);
        const float rstd = rsqrtf(ss / (float)D + EPS);
#pragma unroll
        for (int i = 0; i < D / 512; ++i) { const int c = i * 512 + lane * 8;
#pragma unroll
            for (int n = 0; n < 2; ++n) { const f32x4 wv = *(const f32x4*)(fw + c + 4 * n); f32x4 o;
#pragma unroll
                for (int j = 0; j < 4; ++j) o[j] = (float)v[i][4 * n + j] * rstd * wv[j];
                *(f32x4*)(p.out + O_Y + (size_t)row * D + c + 4 * n) = o; } }
    }
}

constexpr int PV_LS = 264;
__device__ __forceinline__ void prep_vt_store(LAS h16* VL, h16* VTrow0, int NKs, int pos0, int tid) {
#pragma unroll
    for (int i = 0; i < KVW * 8 / NTHREADS; ++i) { const int id = tid + NTHREADS * i, dk = id >> 3, tc = id & 7; h16x8 o;
#pragma unroll
        for (int j = 0; j < 8; ++j) o[j] = VL[(tc * 8 + j) * PV_LS + dk];
        *(h16x8*)(VTrow0 + (size_t)dk * NKs + pos0 + tc * 8) = o; }
}
__device__ __forceinline__ void prep_tile(const Params& p, int l, int tile, LAS unsigned char* lds) {
    int tid = threadIdx.x; LAUNDER(tid);
    const int w = tid >> 6, lane = tid & 63;
    LAS h16* VL = (LAS h16*)lds;
    constexpr int NT_REAL = M / 64;
    if (tile >= NT_REAL) {
        const int ct = tile - NT_REAL, b = ct / (PAST / 64), pos0 = (ct % (PAST / 64)) * 64;
        const float* ck = p.in[I_CK] + (((size_t)b * DEPTH + l) * PAST + pos0) * KVW; const float* cv = p.in[I_CV] + (((size_t)b * DEPTH + l) * PAST + pos0) * KVW;
        h16* kd = (h16*)(p.ws + WS_KBS) + ((size_t)b * KVLEN + pos0) * KVW;
#pragma unroll
        for (int i = 0; i < 64 * KVW / 8 / NTHREADS; ++i) { const int id = tid + NTHREADS * i, row = id / (KVW / 8), c = id % (KVW / 8);
            const f32x4 k0 = *(const f32x4*)(ck + (size_t)row * KVW + c * 8), k1 = *(const f32x4*)(ck + (size_t)row * KVW + c * 8 + 4);
            const f32x4 v0 = *(const f32x4*)(cv + (size_t)row * KVW + c * 8), v1 = *(const f32x4*)(cv + (size_t)row * KVW + c * 8 + 4);
            h16x8 ko, vo;
#pragma unroll
            for (int j = 0; j < 4; ++j) { ko[j] = (h16)k0[j]; ko[4 + j] = (h16)k1[j]; vo[j] = (h16)v0[j]; vo[4 + j] = (h16)v1[j]; }
            *(h16x8*)(kd + (size_t)row * KVW + c * 8) = ko; *(LAS h16x8*)(VL + row * PV_LS + c * 8) = vo; }
        __syncthreads();
        prep_vt_store(VL, (h16*)(p.ws + WS_VBS) + (size_t)b * KVW * KVLEN, KVLEN, pos0, tid);
        __syncthreads();
        return;
    }
    const int r0 = tile * 64; const bool smp = r0 >= MP;
    const int b = smp ? (r0 - MP) / DSEQ : r0 / SEQ, t0 = smp ? (r0 - MP) % DSEQ : r0 % SEQ;
    const h16* Z = (const h16*)(p.ws + WS_Z);
#pragma unroll
    for (int i = 0; i < 64 * KVW / 8 / NTHREADS; ++i) { const int id = tid + NTHREADS * i, row = id / (KVW / 8), c = id % (KVW / 8);
        const h16x8 v = *(const h16x8*)(Z + (size_t)(r0 + row) * INC + C_AV + c * 8);
        *(LAS h16x8*)(VL + row * PV_LS + c * 8) = v;
        if (!smp) { float* cvo = p.out + O_CV + (((size_t)b * DEPTH + l) * SEQ + t0 + row) * KVW + c * 8; f32x4 a, bq;
#pragma unroll
            for (int j = 0; j < 4; ++j) { a[j] = (float)v[j]; bq[j] = (float)v[4 + j]; }
            *(f32x4*)cvo = a; *(f32x4*)(cvo + 4) = bq; } }
    __syncthreads();
    if (smp) prep_vt_store(VL, (h16*)(p.ws + WS_VBS) + (size_t)b * KVW * KVLEN, KVLEN, PAST + t0, tid);
    else prep_vt_store(VL, (h16*)(p.ws + WS_VBC) + (size_t)b * KVW * SEQ, SEQ, t0, tid);
    constexpr int NH = AQH + AKVH, NGRP = 64 * NH / 4, PQN = 4;
    const int c8 = (lane & 15) * 8, sub = lane >> 4;
    const f32x4 wq0 = *(const f32x4*)(p.in[I_QNORM] + (size_t)l * 128 + c8), wq1 = *(const f32x4*)(p.in[I_QNORM] + (size_t)l * 128 + c8 + 4);
    const f32x4 wk0 = *(const f32x4*)(p.in[I_KNORM] + (size_t)l * 128 + c8), wk1 = *(const f32x4*)(p.in[I_KNORM] + (size_t)l * 128 + c8 + 4);
    const int cp8 = c8 ^ 32;
    const f32x4 wqp0 = *(const f32x4*)(p.in[I_QNORM] + (size_t)l * 128 + cp8), wqp1 = *(const f32x4*)(p.in[I_QNORM] + (size_t)l * 128 + cp8 + 4);
    const f32x4 wkp0 = *(const f32x4*)(p.in[I_KNORM] + (size_t)l * 128 + cp8), wkp1 = *(const f32x4*)(p.in[I_KNORM] + (size_t)l * 128 + cp8 + 4);
    const f32x2* ROPE = (const f32x2*)(p.ws + WS_ROPE);
    for (int g0 = w; g0 < NGRP; g0 += PQN * NWAVES) {
        h16x8 xr[PQN]; f32x4 rt[PQN][4];
#pragma unroll
        for (int k = 0; k < PQN; ++k) { const int grp = g0 + k * NWAVES; if (grp >= NGRP) continue; const int it = grp * 4 + sub; const int row = it / NH, hh = it % NH; const bool isq = hh < AQH;
            xr[k] = *(const h16x8*)(Z + (size_t)(r0 + row) * INC + (isq ? C_AQ + hh * 128 : C_AK + (hh - AQH) * 128) + c8);
            if (smp) { const int t = t0 + row; const int pos = c8 < 64 ? t / 64 : DSEQ / 64 + (t % 64); const f32x4* rp = (const f32x4*)(ROPE + pos * 32 + (c8 & 31));
#pragma unroll
                for (int q = 0; q < 4; ++q) rt[k][q] = rp[q]; } }
#pragma unroll
        for (int k = 0; k < PQN; ++k) { const int grp = g0 + k * NWAVES; if (grp >= NGRP) continue; const int it = grp * 4 + sub; const int row = it / NH, hh = it % NH; const bool isq = hh < AQH; const int t = t0 + row;
            float x[8]; float ss = 0.f;
#pragma unroll
            for (int j = 0; j < 8; ++j) { x[j] = (float)xr[k][j]; ss += x[j] * x[j]; }
            ss += shfl_xor_l(ss, 8, lane); ss += shfl_xor_l(ss, 4, lane); ss += shfl_xor_l(ss, 2, lane); ss += shfl_xor_l(ss, 1, lane);
            const float rstd = rsqrtf(ss * (1.0f / 128.0f) + EPS);
            float a[8];
#pragma unroll
            for (int j = 0; j < 4; ++j) { a[j] = x[j] * rstd * (isq ? wq0[j] : wk0[j]); a[4 + j] = x[4 + j] * rstd * (isq ? wq1[j] : wk1[j]); }
            if (!isq && !smp) { float* cko = p.out + O_CK + (((size_t)b * DEPTH + l) * SEQ + t) * KVW + (hh - AQH) * 128 + c8; *(f32x4*)cko = (f32x4){a[0], a[1], a[2], a[3]}; *(f32x4*)(cko + 4) = (f32x4){a[4], a[5], a[6], a[7]}; }
            if (smp) { const h16x2 x01 = {xr[k][0], xr[k][1]}, x23 = {xr[k][2], xr[k][3]}, x45 = {xr[k][4], xr[k][5]}, x67 = {xr[k][6], xr[k][7]};
                const float pf0 = shfl_xor_l(__builtin_bit_cast(float, x01), 4, lane), pf1 = shfl_xor_l(__builtin_bit_cast(float, x23), 4, lane), pf2 = shfl_xor_l(__builtin_bit_cast(float, x45), 4, lane), pf3 = shfl_xor_l(__builtin_bit_cast(float, x67), 4, lane);
                const u32x4 pw = {__builtin_bit_cast(unsigned, pf0), __builtin_bit_cast(unsigned, pf1), __builtin_bit_cast(unsigned, pf2), __builtin_bit_cast(unsigned, pf3)};
                const h16x8 pr = __builtin_bit_cast(h16x8, pw); const bool lo = (lane & 4) == 0;
#pragma unroll
                for (int j = 0; j < 8; ++j) { const float pn = (float)pr[j] * rstd * (isq ? (j < 4 ? wqp0[j] : wqp1[j - 4]) : (j < 4 ? wkp0[j] : wkp1[j - 4]));
                    const float cs = rt[k][j >> 1][(j & 1) * 2], sn = rt[k][j >> 1][(j & 1) * 2 + 1]; a[j] = lo ? a[j] * cs - pn * sn : a[j] * cs + pn * sn; } }
            h16x8 o;
            if (isq) { const float sc = 0.08838834764831845f;
#pragma unroll
                for (int j = 0; j < 8; ++j) o[j] = (h16)(a[j] * sc);
                *(h16x8*)((h16*)(p.ws + WS_AQ2) + (size_t)(r0 + row) * W + hh * 128 + c8) = o; }
            else {
#pragma unroll
                for (int j = 0; j < 8; ++j) o[j] = (h16)a[j];
                *(h16x8*)((smp ? (h16*)(p.ws + WS_KBS) + ((size_t)b * KVLEN + PAST + t) * KVW : (h16*)(p.ws + WS_KBC) + ((size_t)b * SEQ + t) * KVW) + (hh - AQH) * 128 + c8) = o; } }
    }
    __syncthreads();
}
#ifdef HOST_SIM
#define MFMA16B(a, b, c) sim::mfma16<0>(&(a), &(b), c)
#else
#define MFMA16B(a, b, c) __builtin_amdgcn_mfma_f32_16x16x32_bf16(a, b, c, 0, 0, 0)
#endif
constexpr int HS_QK = 136, HS_T = 40;
constexpr int HG_SET = 2 * 32 * HS_QK * 2 + 2 * 128 * HS_T * 2 + 32 * HS_T * 2;
constexpr int HG_QH = 0, HG_KH = HG_QH + 32 * HS_QK * 2, HG_KHT = HG_KH + 32 * HS_QK * 2, HG_VT = HG_KHT + 128 * HS_T * 2, HG_P = HG_VT + 128 * HS_T * 2,
              HG_SST = 2 * HG_SET, HG_END = HG_SST + 128 * HS_QK * 2;
static_assert(HG_END <= STAGE_BYTES && HG_SET % 16 == 0, "hgrn LDS");
__device__ __forceinline__ void hgrn_item(const Params& p, int l, int sq, int h, int dir, LAS unsigned char* lds) {
    int tid = threadIdx.x; LAUNDER(tid);
    const int w = tid >> 6, lane = tid & 63, lr = lane & 15, lq = lane >> 4;
    const bool smp = sq < DBATCH; const int b = smp ? sq : sq - DBATCH;
    const int T = smp ? DSEQ : SEQ, row0 = smp ? MP + b * DSEQ : b * SEQ, NC = T / 32;
    const h16* Z = (const h16*)(p.ws + WS_Z); const float* LOGF = (const float*)(p.ws + WS_LOGF);
    h16* O = (h16*)(p.ws + (dir ? WS_OB : WS_OF));
    LAS bf16* SST = (LAS bf16*)(lds + HG_SST);
    const int dcol = 16 * w + lr;
    f32x4 S[8];
    if (smp) { const float* s0 = p.in[I_SH] + ((((size_t)b * DEPTH + l) * 2 + dir) * HGH + h) * 128 * 128;
#pragma unroll
        for (int vt = 0; vt < 8; ++vt)
#pragma unroll
            for (int i = 0; i < 4; ++i) S[vt][i] = s0[(size_t)(16 * w + 4 * lq + i) * 128 + 16 * vt + lr]; }
    else {
#pragma unroll
        for (int vt = 0; vt < 8; ++vt) S[vt] = (f32x4){0.f, 0.f, 0.f, 0.f}; }
    const unsigned voffz = (unsigned)(((dir ? 31 - 8 * lq : 8 * lq) * INC + h * 128 + dcol) * 2);
    const unsigned voffl = (unsigned)(((dir ? 31 - 8 * lq : 8 * lq) * 2 * W + dir * W + h * 128 + dcol) * 4);
    const unsigned voffo = (unsigned)(((dir ? 31 - 4 * lq : 4 * lq) * W + h * 128 + 16 * w + lr) * 2);
    const long sgn = dir ? -1 : 1;
    float lfX[8]; h16 qvX[8]; bf16 vvX[8];
#define HG_LOAD(S_, c) do { const int cc_ = (c) < NC ? (c) : NC - 1; const int rlo = dir ? row0 + T - 32 * cc_ - 32 : row0 + 32 * cc_; const char* zb = (const char*)Z + (size_t)rlo * INC * 2; const char* lb = (const char*)LOGF + (size_t)rlo * 2 * W * 4; \
        _Pragma("unroll") for (int i = 0; i < 8; ++i) { const char* zi_ = zb + sgn * i * (long)(INC * 2); const char* li_ = lb + sgn * i * (long)(2 * W * 4); \
            lf##S_[i] = *(const float*)(li_ + voffl); qv##S_[i] = *(const h16*)(zi_ + C_HQ * 2 + voffz); vv##S_[i] = *(const bf16*)(zi_ + C_HI * 2 + voffz); } } while (0)
#define HG_IMAGES(S_, st, EBL) do { \
        LAS bf16* QH_ = (LAS bf16*)(lds + (st) * HG_SET + HG_QH); LAS bf16* KH_ = (LAS bf16*)(lds + (st) * HG_SET + HG_KH); LAS bf16* KHT_ = (LAS bf16*)(lds + (st) * HG_SET + HG_KHT); LAS bf16* VT_ = (LAS bf16*)(lds + (st) * HG_SET + HG_VT); \
        float pc[8]; float run = 1.f;                                     \
        _Pragma("unroll") for (int i = 0; i < 8; ++i) { run *= lf##S_[i]; pc[i] = run; } \
        const float t0 = shfl_l(run, lr), t1 = shfl_l(run, lr + 16), t2 = shfl_l(run, lr + 32), t3 = shfl_l(run, lr + 48); \
        const float pre = (lq > 0 ? t0 : 1.f) * (lq > 1 ? t1 : 1.f) * (lq > 2 ? t2 : 1.f), pl = (t0 * t1) * (t2 * t3);     \
        const float qs = pre * RCPF(pl);                                  \
        bf16x8 kht, vtv; \
        _Pragma("unroll") for (int i = 0; i < 8; ++i) { const float e = qs * pc[i]; const float kk = (1.0f - lf##S_[i]) * RCPF(e), qq = (float)qv##S_[i] * e; \
            const int t = 8 * lq + i; QH_[t * HS_QK + dcol] = (bf16)qq; KH_[t * HS_QK + dcol] = (bf16)kk; kht[i] = (bf16)kk; vtv[i] = vv##S_[i]; } \
        *(LAS bf16x8*)(KHT_ + dcol * HS_T + 8 * lq) = kht; \
        *(LAS bf16x8*)(VT_ + dcol * HS_T + 8 * lq) = vtv; \
        EBL = pl; } while (0)
#define HG_CHUNK(c, SN_) do { const int st = (c) & 1; PSPIN_T0(13) \
        LAS bf16* QH = (LAS bf16*)(lds + st * HG_SET + HG_QH); LAS bf16* KH = (LAS bf16*)(lds + st * HG_SET + HG_KH); LAS bf16* KHT = (LAS bf16*)(lds + st * HG_SET + HG_KHT); \
        LAS bf16* VT = (LAS bf16*)(lds + st * HG_SET + HG_VT); LAS bf16* PP = (LAS bf16*)(lds + st * HG_SET + HG_P); \
        _Pragma("unroll") for (int i = 0; i < 4; ++i) { const float e = shfl_l(ebl, 4 * lq + i); \
            _Pragma("unroll") for (int vt = 0; vt < 8; ++vt) S[vt][i] *= e; } \
        _Pragma("unroll") for (int vt = 0; vt < 8; ++vt) { bf16x4 sv; sv[0] = (bf16)S[vt][0]; sv[1] = (bf16)S[vt][1]; sv[2] = (bf16)S[vt][2]; sv[3] = (bf16)S[vt][3]; \
            *(LAS bf16x4*)(SST + (16 * vt + lr) * HS_QK + 16 * w + 4 * lq) = sv; } \
        __syncthreads(); PSPIN_T1(13, p.ws) { PSPIN_T0(14) \
        f32x4 oi[2] = {(f32x4){0.f, 0.f, 0.f, 0.f}, (f32x4){0.f, 0.f, 0.f, 0.f}}; \
        _Pragma("unroll") for (int ks = 0; ks < 4; ++ks) { const bf16x8 bfr = *(const LAS bf16x8*)(SST + (16 * w + lr) * HS_QK + 32 * ks + 8 * lq); \
            _Pragma("unroll") for (int ti = 0; ti < 2; ++ti) { const bf16x8 afr = *(const LAS bf16x8*)(QH + (16 * ti + lr) * HS_QK + 32 * ks + 8 * lq); oi[ti] = MFMA16B(afr, bfr, oi[ti]); } } \
        if (w < 3) { const int ti = (w + 1) >> 1, si = w >> 1; \
            f32x4 sc = (f32x4){0.f, 0.f, 0.f, 0.f}; \
            _Pragma("unroll") for (int ks = 0; ks < 4; ++ks) { const bf16x8 afr = *(const LAS bf16x8*)(QH + (16 * ti + lr) * HS_QK + 32 * ks + 8 * lq), bfr = *(const LAS bf16x8*)(KH + (16 * si + lr) * HS_QK + 32 * ks + 8 * lq); \
                sc = MFMA16B(afr, bfr, sc); } \
            _Pragma("unroll") for (int i = 0; i < 4; ++i) { const int t = 16 * ti + 4 * lq + i, s_ = 16 * si + lr; PP[t * HS_T + s_] = (bf16)(s_ <= t ? sc[i] : 0.f); } \
        } else if (w == 3) { \
            _Pragma("unroll") for (int i = 0; i < 4; ++i) PP[(4 * lq + i) * HS_T + 16 + lr] = (bf16)0.f; \
        } \
        { const bf16x8 afr = *(const LAS bf16x8*)(KHT + (16 * w + lr) * HS_T + 8 * lq); \
          _Pragma("unroll") for (int vt = 0; vt < 8; ++vt) { const bf16x8 bfr = *(const LAS bf16x8*)(VT + (16 * vt + lr) * HS_T + 8 * lq); S[vt] = MFMA16B(afr, bfr, S[vt]); } } \
        if ((c) + 1 < NC) { HG_IMAGES(SN_, st ^ 1, ebl); HG_LOAD(SN_, (c) + 2); }        \
        __syncthreads(); PSPIN_T1(14, p.ws) { PSPIN_T0(15) \
        { const bf16x8 bfr = *(const LAS bf16x8*)(VT + (16 * w + lr) * HS_T + 8 * lq); \
          _Pragma("unroll") for (int ti = 0; ti < 2; ++ti) { const bf16x8 afr = *(const LAS bf16x8*)(PP + (16 * ti + lr) * HS_T + 8 * lq); oi[ti] = MFMA16B(afr, bfr, oi[ti]); } } \
        { const int rlo = dir ? row0 + T - 32 * (c) - 32 : row0 + 32 * (c); char* ob = (char*)O + (size_t)rlo * W * 2; \
          _Pragma("unroll") for (int ti = 0; ti < 2; ++ti) \
            _Pragma("unroll") for (int i = 0; i < 4; ++i) *(h16*)(ob + sgn * (16 * ti + i) * (long)(W * 2) + voffo) = (h16)oi[ti][i]; } \
        PSPIN_T1(15, p.ws) } } \
    } while (0)
    float ebl;
    HG_LOAD(X, 0); HG_IMAGES(X, 0, ebl); HG_LOAD(X, 1);
    for (int c = 0; c < NC; ++c) { HG_CHUNK(c, X); }
#undef HG_LOAD
#undef HG_IMAGES
#undef HG_CHUNK
    if (!smp) { float* so = p.out + O_SH + ((((size_t)b * DEPTH + l) * 2 + dir) * HGH + h) * 128 * 128;
#pragma unroll
        for (int vt = 0; vt < 8; ++vt)
#pragma unroll
            for (int i = 0; i < 4; ++i) so[(size_t)(16 * w + 4 * lq + i) * 128 + 16 * vt + lr] = S[vt][i]; }
    __syncthreads();
}
template <int PARTS> __device__ __forceinline__ void phase_scans(const Params& p, int l, LAS unsigned char* lds) {
    int tid_ = threadIdx.x; LAUNDER(tid_);
    const int lane = tid_ & 63, gw = blockIdx.x * NWAVES + (tid_ >> 6), nw = gridDim.x * NWAVES;
    { PSPIN_T0(10)
    if (PARTS & 1) {
        const int G = gridDim.x, bid = blockIdx.x;
        constexpr int NL = DBATCH * HGH * 2, NS = BATCH * HGH * 2, NWG1 = (M / 256) * (INC / 256);
        const int R1 = NWG1 / G > 0 ? NWG1 / G : 1, left = NWG1 - R1 * G;
        {
            pg8::Gemm g{(const h16*)(p.ws + WS_H), (const h16*)(p.ws + WS_WIN) + (size_t)l * INC * D, 0, 0, M, INC, D, D, D};
            pg8::LeftoverUnit S; S.init(M, INC, G, bid);
            EpiIn E{(h16*)(p.ws + WS_Z), (float*)(p.ws + WS_LOGF), (const float*)(p.ws + WS_LB) + (size_t)l * W, (h16*)(p.ws + WS_A3)};
            pg8::gemm_phase<EpiIn, pg8::LeftoverUnit>(lds, g, S, E);
            __syncthreads();
        }
        for (int it = bid; it < NL; it += G) hgrn_item(p, l, it / (HGH * 2), (it >> 1) % HGH, it & 1, lds);
        if (NL < G && left == G - NL && NS >= G) {
            constexpr int PER = NS / (NL > 0 ? NL : 1);
            const int NS_A = (PER - 2) / 2 > 0 ? (PER - 2) / 2 : 0, NS_B = PER - NS_A;
            if (bid < NL) { for (int k = 0; k < NS_A; ++k) { const int it = bid * NS_A + k; hgrn_item(p, l, DBATCH + it / (HGH * 2), (it >> 1) % HGH, it & 1, lds); } }
            else { for (int k = 0; k < NS_B; ++k) { const int it = NL * NS_A + (bid - NL) * NS_B + k; if (it < NS) hgrn_item(p, l, DBATCH + it / (HGH * 2), (it >> 1) % HGH, it & 1, lds); } }
        }
        else if (NL < G) { if (bid >= NL) for (int it = bid - NL; it < NS; it += G - NL) hgrn_item(p, l, DBATCH + it / (HGH * 2), (it >> 1) % HGH, it & 1, lds); }
        else { for (int it = bid; it < NS; it += G) hgrn_item(p, l, DBATCH + it / (HGH * 2), (it >> 1) % HGH, it & 1, lds); }
    }
    PSPIN_T1(10, p.ws) }
    { PSPIN_T0(11)
    if (PARTS & 2) {
        __syncthreads();
        pg8::Gemm gm{(const h16*)(p.ws + WS_A3), (const h16*)(p.ws + WS_S5BG) + (size_t)l * S5G * 256 * 256, (size_t)NBLK_P * 512, (size_t)256 * 256, NBLK_P, 256, 256, 512, 256};
        pg8::GroupOrder S; S.init((int)gridDim.x, (int)blockIdx.x);
        EpiS5P E{(float*)(p.ws + WS_PB)};
        pg8::gemm_phase<EpiS5P, pg8::GroupOrder>(lds, gm, S, E);
    }
    PSPIN_T1(11, p.ws) }
    { PSPIN_T0(12)
    if (PARTS & 4) { __syncthreads(); for (int t = blockIdx.x; t < M / 64 + DBATCH * PAST / 64; t += gridDim.x) prep_tile(p, l, t, lds); }
    PSPIN_T1(12, p.ws) }
}

__device__ __forceinline__ int crow(int r, int hi) { return (r & 3) + 8 * (r >> 2) + 4 * hi; }
constexpr int AT_K = 0, AT_V = 32768, AT_OS = 136, AT_WS = 8 * 32 * AT_OS * 2;
__device__ __forceinline__ void attn_unit(const h16* Qb, const h16* Kb, const h16* VTb, int NK, const h16* Gb, h16* Ob, LAS unsigned char* lds, unsigned char* PS_WS) {
    int tid = threadIdx.x; LAUNDER(tid);
    const int wid = tid >> 6, lane = tid & 63, r32 = lane & 31, hi = lane >> 5;
    LAS float* wsf = (LAS float*)(lds + AT_WS) + wid * 64; LAS float* al_l = wsf; LAS float* li_l = wsf + 32;
    constexpr float C = 1.4426950408889634f;
    float m_reg = -1e30f, l_reg = 0.f;
    f32x16 o[4];
#pragma unroll
    for (int d = 0; d < 4; ++d)
#pragma unroll
        for (int r = 0; r < 16; ++r) o[d][r] = 0.f;
    h16x8 qr[8];
    { const h16* Qw = Qb + (size_t)(wid * 32 + r32) * W + hi * 8;
#pragma unroll
      for (int d0 = 0; d0 < 8; ++d0) qr[d0] = *(const h16x8*)(Qw + d0 * 16); }
    const int kr_ = tid >> 4, kc_ = tid & 15, vr_ = tid >> 3, vc_ = tid & 7;
    const int kst0 = kr_ * 256 + ((kc_ * 16) ^ ((kr_ & 15) << 4)), kst1 = (kr_ + 32) * 256 + ((kc_ * 16) ^ (((kr_ + 32) & 15) << 4));
    const int vst0 = vr_ * 128 + ((vc_ * 16) ^ (((vr_ >> 1) & 7) << 4)), vst1 = (vr_ + 64) * 128 + ((vc_ * 16) ^ ((((vr_ + 64) >> 1) & 7) << 4));
    const h16* kg0 = Kb + (size_t)kr_ * KVW + kc_ * 8; const h16* kg1 = Kb + (size_t)(kr_ + 32) * KVW + kc_ * 8;
    const h16* vg0 = VTb + (size_t)vr_ * NK + vc_ * 8; const h16* vg1 = VTb + (size_t)(vr_ + 64) * NK + vc_ * 8;
    const int NT = NK / 64;
    h16x8 kaA = *(const h16x8*)kg0, kbA = *(const h16x8*)kg1, vaA = *(const h16x8*)vg0, vbA = *(const h16x8*)vg1;
    *(LAS h16x8*)(lds + AT_K + kst0) = kaA; *(LAS h16x8*)(lds + AT_K + kst1) = kbA; *(LAS h16x8*)(lds + AT_V + vst0) = vaA; *(LAS h16x8*)(lds + AT_V + vst1) = vbA;
    h16x8 kaB, kbB, vaB, vbB;
#define AT_GLOAD(S, t) do { ka##S = *(const h16x8*)(kg0 + (size_t)(t) * 64 * KVW); kb##S = *(const h16x8*)(kg1 + (size_t)(t) * 64 * KVW); va##S = *(const h16x8*)(vg0 + (t) * 64); vb##S = *(const h16x8*)(vg1 + (t) * 64); } while (0)
#define AT_LWRITE(S, nb) do { *(LAS h16x8*)(lds + AT_K + (nb) + kst0) = ka##S; *(LAS h16x8*)(lds + AT_K + (nb) + kst1) = kb##S; *(LAS h16x8*)(lds + AT_V + (nb) + vst0) = va##S; *(LAS h16x8*)(lds + AT_V + (nb) + vst1) = vb##S; } while (0)
    AT_GLOAD(A, 1); AT_GLOAD(B, (2 < NT ? 2 : 1));
    __syncthreads();
    PSPIN_T0(1)
#define AT_TILE(j, S) do { \
        const int buf = (j) & 1; \
        const LAS unsigned char* Kl = lds + AT_K + buf * 16384; const LAS unsigned char* Vl = lds + AT_V + buf * 16384; \
        f32x16 p0, p1; \
        _Pragma("unroll") for (int r = 0; r < 16; ++r) { p0[r] = 0.f; p1[r] = 0.f; } \
        _Pragma("unroll") for (int d0 = 0; d0 < 8; ++d0) { const int cb = (d0 * 16 + hi * 8) * 2; \
            const h16x8 b0 = *(const LAS h16x8*)(Kl + r32 * 256 + (cb ^ ((r32 & 15) << 4))); \
            const h16x8 b1 = *(const LAS h16x8*)(Kl + (32 + r32) * 256 + (cb ^ ((r32 & 15) << 4))); \
            p0 = MFMA32(b0, qr[d0], p0); p1 = MFMA32(b1, qr[d0], p1); } \
        float pmax = p0[0]; \
        _Pragma("unroll") for (int r = 1; r < 16; ++r) pmax = fmaxf(pmax, p0[r]); \
        _Pragma("unroll") for (int r = 0; r < 16; ++r) pmax = fmaxf(pmax, p1[r]); \
        { unsigned ra, rb; permlane32_swap_u(__builtin_bit_cast(unsigned, pmax), __builtin_bit_cast(unsigned, pmax), ra, rb); pmax = fmaxf(__builtin_bit_cast(float, ra), __builtin_bit_cast(float, rb)); } \
        const bool keep = WAVE_ALL(pmax - m_reg <= 8.0f);             \
        const float mn = keep ? m_reg : fmaxf(m_reg, pmax), alpha = keep ? 1.0f : EXP2F((m_reg - mn) * C), mnC = -mn * C; m_reg = mn; \
        float ps = 0.f; \
        _Pragma("unroll") for (int r = 0; r < 16; ++r) { p0[r] = EXP2F(fmaf(p0[r], C, mnC)); p1[r] = EXP2F(fmaf(p1[r], C, mnC)); ps += p0[r] + p1[r]; } \
        { unsigned ra, rb; permlane32_swap_u(__builtin_bit_cast(unsigned, ps), __builtin_bit_cast(unsigned, ps), ra, rb); ps = __builtin_bit_cast(float, ra) + __builtin_bit_cast(float, rb); } \
        l_reg = l_reg * alpha + ps; \
        if (!keep) { if (hi == 0) al_l[r32] = alpha; \
        WAVE_LDS_SYNC(); \
        _Pragma("unroll") for (int r = 0; r < 16; ++r) { const float a = al_l[crow(r, hi)]; \
            _Pragma("unroll") for (int d = 0; d < 4; ++d) o[d][r] *= a; } \
        WAVE_LDS_SYNC(); } \
        h16x8 pa[4]; \
        PK4(p0, 0, pa[0]); PK4(p0, 8, pa[1]); PK4(p1, 0, pa[2]); PK4(p1, 8, pa[3]); \
        _Pragma("unroll") for (int d0 = 0; d0 < 4; ++d0) { const int vrow = d0 * 32 + r32; \
            _Pragma("unroll") for (int ks = 0; ks < 4; ++ks) { const int cb = (ks * 16 + hi * 8) * 2; \
                const h16x8 vf = *(const LAS h16x8*)(Vl + vrow * 128 + (cb ^ (((vrow >> 1) & 7) << 4))); \
                o[d0] = MFMA32(pa[ks], vf, o[d0]); } } \
        if ((j) + 1 < NT) AT_LWRITE(S, (buf ^ 1) * 16384); \
        if ((j) + 3 < NT) AT_GLOAD(S, (j) + 3); \
        __syncthreads(); \
    } while (0)
#define PK4(P, BASE, OUT) do { const unsigned a0 = cvtpk_h(P[BASE + 0], P[BASE + 1]), a1 = cvtpk_h(P[BASE + 2], P[BASE + 3]), b0_ = cvtpk_h(P[BASE + 4], P[BASE + 5]), b1_ = cvtpk_h(P[BASE + 6], P[BASE + 7]); \
        unsigned r00, r01, r10, r11; permlane32_swap_u(a0, b0_, r00, r01); permlane32_swap_u(a1, b1_, r10, r11); u32x4 w_ = {r00, r10, r01, r11}; OUT = __builtin_bit_cast(h16x8, w_); } while (0)
    for (int j = 0; j < NT; j += 2) { AT_TILE(j, A); AT_TILE(j + 1, B); }
#undef PK4
#undef AT_TILE
#undef AT_GLOAD
#undef AT_LWRITE
    PSPIN_T1(1, PS_WS)
    if (hi == 0) li_l[r32] = l_reg;
    WAVE_LDS_SYNC();
    LAS h16* OT = (LAS h16*)(lds + wid * (32 * AT_OS * 2));
#pragma unroll
    for (int r = 0; r < 16; ++r) { const float rl = RCPF(li_l[crow(r, hi)]);
#pragma unroll
        for (int d0 = 0; d0 < 4; ++d0) OT[crow(r, hi) * AT_OS + d0 * 32 + r32] = (h16)(o[d0][r] * rl); }
    WAVE_LDS_SYNC();
#pragma unroll
    for (int k = 0; k < 8; ++k) { const int ch = lane + 64 * k, row = ch >> 4, c = ch & 15; const int orow = wid * 32 + row;
        const h16x8 v = *(const LAS h16x8*)(OT + row * AT_OS + c * 8), g = *(const h16x8*)(Gb + (size_t)orow * INC + c * 8);
        h16x8 ov;
#pragma unroll
        for (int j = 0; j < 8; ++j) ov[j] = (h16)((float)v[j] * (float)g[j]);
        *(h16x8*)(Ob + (size_t)orow * W + c * 8) = ov; }
    __syncthreads();
}
constexpr int HGP_N = 4;
__device__ __forceinline__ void d_hgpost4(const Params& p, int l, int grp0, int stride, int ngroups, int lane) {
    const h16* OF = (const h16*)(p.ws + WS_OF); const h16* OB = (const h16*)(p.ws + WS_OB); const h16* Z = (const h16*)(p.ws + WS_Z);
    const int c8 = (lane & 15) * 8, sub = lane >> 4;
    const float* wn = p.in[I_ONORM] + (size_t)l * 128 + c8; const f32x4 w0 = *(const f32x4*)wn, w1 = *(const f32x4*)(wn + 4);
    h16x8 of[HGP_N], ob[HGP_N], gz[HGP_N];
#pragma unroll
    for (int k = 0; k < HGP_N; ++k) { const int grp = grp0 + k * stride; const int item = grp * 4 + sub; const int row = item / HGH, h = item % HGH;
        if (grp < ngroups) { const size_t o0 = (size_t)row * W + h * 128 + c8; of[k] = *(const h16x8*)(OF + o0); ob[k] = *(const h16x8*)(OB + o0); gz[k] = *(const h16x8*)(Z + (size_t)row * INC + C_HGG + h * 128 + c8); } }
#pragma unroll
    for (int k = 0; k < HGP_N; ++k) { const int grp = grp0 + k * stride; if (grp >= ngroups) continue; const int item = grp * 4 + sub; const int row = item / HGH, h = item % HGH;
        float a[8]; float ss = 0.f;
#pragma unroll
        for (int j = 0; j < 8; ++j) { a[j] = (float)of[k][j] + (float)ob[k][j]; ss += a[j] * a[j]; }
        ss += shfl_xor_l(ss, 8, lane); ss += shfl_xor_l(ss, 4, lane); ss += shfl_xor_l(ss, 2, lane); ss += shfl_xor_l(ss, 1, lane);
        const float rstd = rsqrtf(ss * (1.0f / 128.0f) + EPS);
        h16x8 o;
#pragma unroll
        for (int j = 0; j < 4; ++j) { o[j] = (h16)(a[j] * rstd * w0[j] * (float)gz[k][j]); o[4 + j] = (h16)(a[4 + j] * rstd * w1[j] * (float)gz[k][4 + j]); }
        *(h16x8*)((h16*)(p.ws + WS_OHG) + (size_t)row * W + h * 128 + c8) = o; }
}
__device__ __forceinline__ void s5_carry(const Params& p, int l, int tid_) {
    const size_t nth = (size_t)gridDim.x * NTHREADS;
    const float* PB = (const float*)(p.ws + WS_PB); h16* A3 = (h16*)(p.ws + WS_A3);
    for (size_t it = (size_t)blockIdx.x * NTHREADS + tid_; it < (size_t)S5G * (BATCH + DBATCH) * 2 * 64; it += nth) {
        const int pp = (int)(it & 63), dir = (int)(it >> 6) & 1, sq = (int)((it >> 7) % (BATCH + DBATCH)), g = (int)((it >> 7) / (BATCH + DBATCH));
        const bool smp = sq < DBATCH; const int b = smp ? sq : sq - DBATCH; const int T = smp ? DSEQ : SEQ, row0 = smp ? MP + b * DSEQ : b * SEQ, nb = T / 16, blk0 = row0 / 16;
        const f32x2 ab = ((const f32x2*)(p.ws + WS_ABAR))[(((size_t)l * 2 + dir) * S5G + g) * S5P + pp];
        float ar = ab[0], ai = ab[1];
#pragma unroll
        for (int k = 0; k < 4; ++k) { const float nr = ar * ar - ai * ai, ni = 2.0f * ar * ai; ar = nr; ai = ni; }
        float sr = 0.f, si = 0.f;
        if (smp) { const size_t si0 = (((size_t)b * DEPTH + l) * 2 + dir) * S5G * S5P + (size_t)g * S5P + pp; sr = p.in[I_SR][si0]; si = p.in[I_SI][si0]; }
        const float* pb = PB + ((size_t)g * NBLK_P + blk0) * 256 + dir * 128 + pp; h16* a3 = A3 + ((size_t)g * NBLK_P + blk0) * 512 + 256 + dir * 128 + pp;
        for (int k0 = 0; k0 < nb; k0 += 8) { float pr[8], pi_[8];
#pragma unroll
            for (int k = 0; k < 8; ++k) { const int bb = dir ? nb - 1 - (k0 + k) : k0 + k; pr[k] = pb[(size_t)bb * 256]; pi_[k] = pb[(size_t)bb * 256 + 64]; }
#pragma unroll
            for (int k = 0; k < 8; ++k) { const int bb = dir ? nb - 1 - (k0 + k) : k0 + k; a3[(size_t)bb * 512] = (h16)sr; a3[(size_t)bb * 512 + 64] = (h16)si;
                const float nr = ar * sr - ai * si + pr[k], ni = ar * si + ai * sr + pi_[k]; sr = nr; si = ni; } }
        if (!smp) { const size_t so = (((size_t)b * DEPTH + l) * 2 + dir) * S5G * S5P + (size_t)g * S5P + pp; p.out[O_SR + so] = sr; p.out[O_SI + so] = si; }
    }
}
template <int PARTS> __device__ __forceinline__ void phase_attn(const Params& p, int l, LAS unsigned char* lds) {
    int tid_ = threadIdx.x; LAUNDER(tid_);
    const int lane = tid_ & 63, gw = blockIdx.x * NWAVES + (tid_ >> 6), nw = gridDim.x * NWAVES;
    constexpr int NU_S = DBATCH * AQH * (DSEQ / 256), NU_C = BATCH * AQH * (SEQ / 256);
    PSPIN_T0(8)
    if (PARTS & 1)
    for (int u = blockIdx.x; u < NU_S + NU_C; u += gridDim.x) {
        const bool smp = u < NU_S; const int uu = smp ? u : u - NU_S;
        const int T = smp ? DSEQ : SEQ, NK = smp ? KVLEN : SEQ;
        const int qb = uu % (T / 256), qh = (uu / (T / 256)) % AQH, b = uu / ((T / 256) * AQH), kh = qh / 4;
        const int row0 = (smp ? MP + b * DSEQ : b * SEQ) + qb * 256;
        const h16* Kb = (smp ? (const h16*)(p.ws + WS_KBS) : (const h16*)(p.ws + WS_KBC)) + (size_t)b * NK * KVW + kh * 128;
        const h16* VTb = (smp ? (const h16*)(p.ws + WS_VBS) : (const h16*)(p.ws + WS_VBC)) + (size_t)(b * AKVH + kh) * 128 * NK;
        attn_unit((const h16*)(p.ws + WS_AQ2) + (size_t)row0 * W + qh * 128, Kb, VTb, NK, (const h16*)(p.ws + WS_Z) + (size_t)row0 * INC + C_AG + qh * 128,
                  (h16*)(p.ws + WS_OAT) + (size_t)row0 * W + qh * 128, lds, p.ws);
    }
    constexpr int N_HP = M * HGH / 4;
    PSPIN_T1(8, p.ws)
    { PSPIN_T0(9)
    if (PARTS & 2)
    for (int it = gw; it < N_HP; it += HGP_N * nw) d_hgpost4(p, l, it, nw, N_HP, lane);
    PSPIN_T1(9, p.ws) }
    if (!(PARTS & 4)) return;
    { PSPIN_T0(7) s5_carry(p, l, tid_); PSPIN_T1(7, p.ws) }
}

constexpr int NPL = 8, PH_FINAL = 1 + DEPTH * NPL, N_PHASES = PH_FINAL + 1;

__global__ void __launch_bounds__(NTHREADS, 2) fwd_kernel(Params p) {
#ifdef HOST_SIM
    unsigned char* lds = sim::cur->blk->lds;
#else
    extern __shared__ __attribute__((aligned(16))) unsigned char lds_raw[];
    LAS unsigned char* lds = (LAS unsigned char*)lds_raw;
#endif
    const int lo = p.ph_lo, hi = p.ph_hi;
#ifndef HOST_SIM
    if (threadIdx.x < 4) ((LAS unsigned*)(lds + MISC_OFF))[threadIdx.x] = 0u;
    __syncthreads();
    XcdBarrier bar; bar.bar = (unsigned*)(p.ws + WS_BAR); bar.x = 0; bar.st = nullptr;
    if (hi - lo > 1) bar = xcd_barrier_post((unsigned*)(p.ws + WS_BAR), (volatile LAS unsigned*)(lds + MISC_OFF));
#else
    XcdBarrier bar{0};
#endif
#define IN(k) (lo <= (k) && (k) < hi)
#define SEAM(k) do { if (IN(k) && IN((k) + 1)) { PSPIN_T0(4) xcd_barrier(bar); PSPIN_T1(4, p.ws) } } while (0)

    unsigned char* ws = p.ws;
    const int G = gridDim.x, bid = blockIdx.x;
    if (IN(0)) { PSPINL_T0(28, lds) phase_prologue(p, lds); PSPINL_T1(28, lds, p.ws) if (PROBE_REP == 0) { xcd_barrier(bar); phase_prologue(p, lds); } } SEAM(0);
    for (int l = 0; l < DEPTH; ++l) {
        const int pb = 1 + l * NPL;
        if (IN(pb + 0)) { PSPINL_T0(20, lds) phase_norm(p, l); PSPINL_T1(20, lds, p.ws) if (PROBE_REP == 8) { xcd_barrier(bar); phase_norm(p, l); } } SEAM(pb + 0);
        if (IN(pb + 1)) {
            pg8::Gemm g{(const h16*)(ws + WS_H), (const h16*)(ws + WS_WIN) + (size_t)l * INC * D, 0, 0, M, INC, D, D, D};
            pg8::WholeRounds S; S.init(M, INC, G, bid);
            EpiIn E{(h16*)(ws + WS_Z), (float*)(ws + WS_LOGF), (const float*)(ws + WS_LB) + (size_t)l * W, (h16*)(ws + WS_A3)};
            PSPINL_T0(21, lds) pg8::gemm_phase<EpiIn, pg8::WholeRounds>(lds, g, S, E); PSPINL_T1(21, lds, p.ws)
            if (PROBE_REP == 1) { xcd_barrier(bar); pg8::gemm_phase<EpiIn, pg8::WholeRounds>(lds, g, S, E); }
        } SEAM(pb + 1);
        if (IN(pb + 2)) { PSPINL_T0(22, lds) phase_scans<7>(p, l, lds); PSPINL_T1(22, lds, p.ws) if (PROBE_REP == 2) { xcd_barrier(bar); phase_scans<7>(p, l, lds); } if (PROBE_REP == 21) { xcd_barrier(bar); phase_scans<1>(p, l, lds); } if (PROBE_REP == 22) { xcd_barrier(bar); phase_scans<2>(p, l, lds); } if (PROBE_REP == 23) { xcd_barrier(bar); phase_scans<4>(p, l, lds); } } SEAM(pb + 2);
        if (IN(pb + 3)) { PSPINL_T0(23, lds) phase_attn<7>(p, l, lds); PSPINL_T1(23, lds, p.ws) if (PROBE_REP == 3) { xcd_barrier(bar); phase_attn<7>(p, l, lds); } if (PROBE_REP == 31) { xcd_barrier(bar); phase_attn<1>(p, l, lds); } if (PROBE_REP == 32) { xcd_barrier(bar); phase_attn<2>(p, l, lds); } if (PROBE_REP == 33) { xcd_barrier(bar); phase_attn<4>(p, l, lds); } } SEAM(pb + 3);
        if (IN(pb + 4)) {
            pg8::Gemm g{(const h16*)(ws + WS_A3), (const h16*)(ws + WS_S5BY) + (size_t)l * S5G * 256 * 512, (size_t)NBLK_P * 512, (size_t)256 * 512, NBLK_P, 256, 512, 512, 512};
            pg8::GroupOrder S; S.init(G, bid);
            EpiS5Y E{(h16*)(ws + WS_YS)};
            PSPINL_T0(24, lds) pg8::gemm_phase<EpiS5Y, pg8::GroupOrder>(lds, g, S, E); PSPINL_T1(24, lds, p.ws)
            if (PROBE_REP == 4) { xcd_barrier(bar); pg8::gemm_phase<EpiS5Y, pg8::GroupOrder>(lds, g, S, E); }
        } SEAM(pb + 4);
        if (IN(pb + 5)) {
            pg8::Gemm g{(const h16*)(ws + WS_YS), (const h16*)(ws + WS_WGLU) + (size_t)l * W * W, 0, 0, M, W, W, W, W};
            pg8::StaticOrder S; S.init(M, W, G, bid);
            EpiGlu E{(const h16*)(ws + WS_YS), (const h16*)(ws + WS_Z), (h16*)(ws + WS_OS5)};
            PSPINL_T0(25, lds) pg8::gemm_phase<EpiGlu, pg8::StaticOrder>(lds, g, S, E); PSPINL_T1(25, lds, p.ws)
            if (PROBE_REP == 6) { xcd_barrier(bar); pg8::gemm_phase<EpiGlu, pg8::StaticOrder>(lds, g, S, E); }
        } SEAM(pb + 5);
        if (IN(pb + 6)) {
            const h16* wbr = (const h16*)(ws + WS_WBR) + (size_t)l * 3 * D * W;
            pg8::Gemm g{(const h16*)(ws + WS_OHG), wbr, (size_t)M * W, (size_t)D * W, M, D, W, W, W};
            pg8::MultiOrder<3> S; S.init(M, D, G, bid);
            EpiBr E{(const h16*)(ws + WS_Z), (h16*)(ws + WS_MG)};
            PSPINL_T0(26, lds) pg8::gemm_phase<EpiBr, pg8::MultiOrder<3>>(lds, g, S, E); PSPINL_T1(26, lds, p.ws)
            if (PROBE_REP == 5) { xcd_barrier(bar); pg8::gemm_phase<EpiBr, pg8::MultiOrder<3>>(lds, g, S, E); }
        } SEAM(pb + 6);
        if (IN(pb + 7)) {
            pg8::Gemm g{(const h16*)(ws + WS_MG), (const h16*)(ws + WS_WOUT) + (size_t)l * D * D, 0, 0, M, D, D, D, D};
            pg8::StaticOrder S; S.init(M, D, G, bid);
            EpiOut E{p.in[I_XP], p.in[I_XS], (h16*)(ws + WS_X), (const float*)(ws + WS_MOD) + (size_t)l * NMODR * 3 * D, l == 0};
            PSPINL_T0(27, lds) pg8::gemm_phase<EpiOut, pg8::StaticOrder>(lds, g, S, E); PSPINL_T1(27, lds, p.ws)
            if (PROBE_REP == 7 && l == 0) { xcd_barrier(bar); pg8::gemm_phase<EpiOut, pg8::StaticOrder>(lds, g, S, E); xcd_barrier(bar); pg8::gemm_phase<EpiOut, pg8::StaticOrder>(lds, g, S, E); xcd_barrier(bar); pg8::gemm_phase<EpiOut, pg8::StaticOrder>(lds, g, S, E); xcd_barrier(bar); pg8::gemm_phase<EpiOut, pg8::StaticOrder>(lds, g, S, E); }
        } SEAM(pb + 7);
    }
    if (IN(PH_FINAL)) { phase_final(p); }
#if !defined(HOST_SIM) && PROBE_SPIN
    if (blockIdx.x == PROBE_BLK && threadIdx.x == 0) { const unsigned T = __hip_atomic_load((unsigned*)p.ws + 64, __ATOMIC_RELAXED, __HIP_MEMORY_SCOPE_AGENT); const unsigned long long t0 = __builtin_amdgcn_s_memrealtime(); while (__builtin_amdgcn_s_memrealtime() - t0 < (unsigned long long)T) __builtin_amdgcn_s_sleep(8); }
#endif
#undef IN
#undef SEAM
}

#ifndef HOST_SIM
extern "C" void kernel_launch(void* const* d_in, const int* in_sizes, int n_in, void* d_out, int out_size, void* d_ws, size_t ws_size, hipStream_t stream) {
    static int grid = 0;
    if (grid == 0) {
        if (n_in != N_IN || (size_t)out_size != O_END || ws_size < WS_END) { grid = -1; return; }
        int dev = 0, cus = 0;
        if (hipGetDevice(&dev) != hipSuccess || hipDeviceGetAttribute(&cus, hipDeviceAttributeMultiprocessorCount, dev) != hipSuccess) { grid = -1; return; }
        if (hipFuncSetAttribute((const void*)fwd_kernel, hipFuncAttributeMaxDynamicSharedMemorySize, LDS_BYTES) != hipSuccess) { grid = -1; return; }
        int per_cu = 0; (void)hipOccupancyMaxActiveBlocksPerMultiprocessor(&per_cu, (const void*)fwd_kernel, NTHREADS, LDS_BYTES); (void)hipGetLastError();
        grid = cus;
    }
    if (grid < 0) return;
    (void)hipMemsetAsync((char*)d_ws + WS_BAR, 0, 16384, stream);
    Params p{};
    for (int i = 0; i < N_IN; ++i) p.in[i] = (const float*)d_in[i];
    p.out = (float*)d_out; p.ws = (unsigned char*)d_ws;
#if N_LAUNCH_MODE == 1
    p.ph_lo = 0; p.ph_hi = N_PHASES;
    hipLaunchKernelGGL(fwd_kernel, dim3(grid), dim3(NTHREADS), LDS_BYTES, stream, p);
#else
    for (int k = 0; k < N_PHASES; ++k) { p.ph_lo = k; p.ph_hi = k + 1; hipLaunchKernelGGL(fwd_kernel, dim3(grid), dim3(NTHREADS), LDS_BYTES, stream, p); }
#endif
}
#endif
```
